# Optimizing an MI355X kernel written in HIP

```python
import math
import jax, jax.numpy as jnp
from jax import lax
import numpy as np

D_MODEL = 1024
BATCH = 16
SEQ = 2048
DEPTH = 2

N_META = 16
N_EVEN = (DEPTH + 1) // 2
N_ODD = DEPTH // 2

LRU_WIDTH = D_MODEL // 2
LRU_HEADS = 4
LRU_HEAD_DIM = LRU_WIDTH // LRU_HEADS
CONV_WIDTH = 4
LRU_C = 8.0

MLA_HEADS = 8
MLA_NOPE = 64
MLA_ROPE = 32
MLA_V = 64
MLA_Q_RANK = D_MODEL // 4
MLA_KV_RANK = D_MODEL // 8
ATTN_BLOCK = 128

EVEN_IN = 2 * LRU_WIDTH + MLA_Q_RANK + MLA_KV_RANK + MLA_ROPE
EVEN_MIX = LRU_WIDTH + MLA_HEADS * MLA_V

RET_HEADS = 4
RET_QK_DIM = D_MODEL // RET_HEADS
RET_V_DIM = 2 * RET_QK_DIM
RET_CHUNK = 128
RET_IN = 2 * RET_HEADS * RET_QK_DIM + 2 * RET_HEADS * RET_V_DIM
RET_MIX = RET_HEADS * RET_V_DIM

D_FF = 4 * D_MODEL
ROPE_BASE = 10000.0
DN_ALPHA = (2 * DEPTH) ** 0.25
DN_BETA = (8 * DEPTH) ** -0.25
EPS = 1e-5
NEG_INF = -1e30

kernel_name = 'hybrid_rglru_mla_retention_deepnorm'


def _layernorm(x, g, b):
    xf = x.astype(jnp.float32)
    mu = jnp.mean(xf, axis=-1, keepdims=True)
    xc = xf - mu
    var = jnp.mean(jnp.square(xc), axis=-1, keepdims=True)
    return (xc * lax.rsqrt(var + EPS) * g + b).astype(x.dtype)


def _rmsnorm(x, g):
    xf = x.astype(jnp.float32)
    y = xf * lax.rsqrt(jnp.mean(jnp.square(xf), axis=-1, keepdims=True) + EPS)
    return (y * g).astype(x.dtype)


def _rope(x, pos):
    half = x.shape[-1] // 2
    inv = ROPE_BASE ** (-jnp.arange(half, dtype=jnp.float32) / half)
    ang = pos.astype(jnp.float32)[:, None] * inv[None, :]
    cos = jnp.cos(ang)[None, :, None, :].astype(x.dtype)
    sin = jnp.sin(ang)[None, :, None, :].astype(x.dtype)
    x1, x2 = x[..., :half], x[..., half:]
    return jnp.concatenate([x1 * cos - x2 * sin, x1 * sin + x2 * cos], axis=-1)


def _lru_combine(c1, c2):
    a1, b1 = c1
    a2, b2 = c2
    return a1 * a2, a2 * b1 + b2


def _rglru_group(p_gate, p_rec, conv_w, conv_b, w_rg_a, b_rg_a, w_rg_x, b_rg_x, lru_lambda):
    B, T, _ = p_rec.shape
    xc = lax.conv_general_dilated(
        p_rec, conv_w[:, None, :], window_strides=(1,), padding=[(CONV_WIDTH - 1, 0)],
        dimension_numbers=('NWC', 'WIO', 'NWC'), feature_group_count=LRU_WIDTH) + conv_b
    xh = xc.reshape(B, T, LRU_HEADS, LRU_HEAD_DIM)
    r = jax.nn.sigmoid(jnp.einsum('bthi,hij->bthj', xh, w_rg_a).reshape(B, T, LRU_WIDTH) + b_rg_a)
    i = jax.nn.sigmoid(jnp.einsum('bthi,hij->bthj', xh, w_rg_x).reshape(B, T, LRU_WIDTH) + b_rg_x)
    log_a = (-LRU_C * r * jax.nn.softplus(-lru_lambda)).astype(jnp.float32)
    a = jnp.exp(log_a)
    mult = jnp.sqrt(-jnp.expm1(2.0 * log_a))
    b = mult * (i * xc).astype(jnp.float32)
    _, h = lax.associative_scan(_lru_combine, (a, b), axis=1)
    return h.astype(p_rec.dtype) * jax.nn.gelu(p_gate)


def _attend(qb, qpos, k, v, kpos):
    scale = qb.shape[-1] ** -0.5
    s = jnp.einsum('bqhd,bkhd->bhqk', qb, k).astype(jnp.float32) * scale
    mask = kpos[None, :] <= qpos[:, None]
    s = jnp.where(mask[None, None], s, NEG_INF)
    p = jax.nn.softmax(s, axis=-1).astype(v.dtype)
    return jnp.einsum('bhqk,bkhd->bqhd', p, v)


def _causal_attention(q, k, v, pos):
    B, T, H, d = q.shape
    dv = v.shape[-1]
    out_meta = _attend(q[:, :N_META], pos[:N_META], k[:, :N_META], v[:, :N_META], pos[:N_META])
    nb = (T - N_META) // ATTN_BLOCK
    qr = q[:, N_META:].reshape(B, nb, ATTN_BLOCK, H, d).swapaxes(0, 1)
    pr = pos[N_META:].reshape(nb, ATTN_BLOCK)
    out_r = lax.map(lambda a: _attend(a[0], a[1], k, v, pos), (qr, pr))
    out_r = out_r.swapaxes(0, 1).reshape(B, T - N_META, H, dv)
    return jnp.concatenate([out_meta, out_r], axis=1)


def _mla_group(p_q, p_kv, p_kpe, pos, q_norm_g, w_uq, kv_norm_g, w_ukv):
    B, T, _ = p_q.shape
    q = (_rmsnorm(p_q, q_norm_g) @ w_uq).reshape(B, T, MLA_HEADS, MLA_NOPE + MLA_ROPE)
    q_nope, q_pe = q[..., :MLA_NOPE], _rope(q[..., MLA_NOPE:], pos)
    kv = (_rmsnorm(p_kv, kv_norm_g) @ w_ukv).reshape(B, T, MLA_HEADS, MLA_NOPE + MLA_V)
    k_nope, v = kv[..., :MLA_NOPE], kv[..., MLA_NOPE:]
    k_pe = _rope(p_kpe[:, :, None, :], pos)
    q = jnp.concatenate([q_nope, q_pe], axis=-1)
    k = jnp.concatenate([k_nope, jnp.broadcast_to(k_pe, (B, T, MLA_HEADS, MLA_ROPE))], axis=-1)
    o = _causal_attention(q, k, v, pos)
    return o.reshape(B, T, MLA_HEADS * MLA_V)


def _even_mixer(x, pos, w_in, conv_w, conv_b, w_rg_a, b_rg_a, w_rg_x, b_rg_x, lru_lambda,
                q_norm_g, w_uq, kv_norm_g, w_ukv, w_out):
    p = x @ w_in
    cuts = [LRU_WIDTH, 2 * LRU_WIDTH, 2 * LRU_WIDTH + MLA_Q_RANK,
            2 * LRU_WIDTH + MLA_Q_RANK + MLA_KV_RANK]
    p_gate, p_rec, p_q, p_kv, p_kpe = jnp.split(p, cuts, axis=-1)
    y_rec = _rglru_group(p_gate, p_rec, conv_w, conv_b, w_rg_a, b_rg_a, w_rg_x, b_rg_x, lru_lambda)
    y_att = _mla_group(p_q, p_kv, p_kpe, pos, q_norm_g, w_uq, kv_norm_g, w_ukv)
    return jnp.concatenate([y_rec, y_att], axis=-1) @ w_out


def _retention_chunk(q, k, v, s_prev, log_gamma):
    dt = q.dtype
    c = q.shape[2]
    idx = jnp.arange(c, dtype=jnp.float32)
    diff = idx[:, None] - idx[None, :]
    decay = jnp.where(diff >= 0, jnp.exp(log_gamma[:, None, None] * jnp.maximum(diff, 0.0)), 0.0).astype(dt)
    q_decay = jnp.exp(log_gamma[:, None] * (idx + 1.0))[None, :, :, None].astype(dt)
    k_decay = jnp.exp(log_gamma[:, None] * (c - 1.0 - idx))[None, :, :, None].astype(dt)
    chunk_decay = jnp.exp(log_gamma * c)[None, :, None, None].astype(dt)
    scores = jnp.einsum('bhid,bhjd->bhij', q, k) * decay
    o = jnp.einsum('bhij,bhjv->bhiv', scores, v) + q_decay * jnp.einsum('bhid,bhdv->bhiv', q, s_prev)
    s_new = chunk_decay * s_prev + jnp.einsum('bhjd,bhjv->bhdv', k * k_decay, v)
    return o, s_new


def _odd_mixer(x, pos, w_in, w_out):
    B, T, _ = x.shape
    qk = RET_HEADS * RET_QK_DIM
    p = x @ w_in
    q, k, v, g = jnp.split(p, [qk, 2 * qk, 2 * qk + RET_MIX], axis=-1)
    q = _rope(q.reshape(B, T, RET_HEADS, RET_QK_DIM), pos)
    k = _rope(k.reshape(B, T, RET_HEADS, RET_QK_DIM), pos) * (RET_QK_DIM ** -0.5)
    v = v.reshape(B, T, RET_HEADS, RET_V_DIM)
    q, k, v = (t.transpose(0, 2, 1, 3) for t in (q, k, v))
    log_gamma = jnp.log(1.0 - 2.0 ** (-5.0 - jnp.arange(RET_HEADS, dtype=jnp.float32)))
    s0 = jnp.zeros((B, RET_HEADS, RET_QK_DIM, RET_V_DIM), dtype=q.dtype)
    o_meta, s = _retention_chunk(q[:, :, :N_META], k[:, :, :N_META], v[:, :, :N_META], s0, log_gamma)
    nc = (T - N_META) // RET_CHUNK

    def to_chunks(t):
        return t[:, :, N_META:].reshape(B, RET_HEADS, nc, RET_CHUNK, t.shape[-1]).transpose(2, 0, 1, 3, 4)

    def body(state, qkv):
        qc, kc, vc = qkv
        o, state = _retention_chunk(qc, kc, vc, state, log_gamma)
        return state, o

    _, o_r = lax.scan(body, s, (to_chunks(q), to_chunks(k), to_chunks(v)))
    o_r = o_r.transpose(1, 2, 0, 3, 4).reshape(B, RET_HEADS, T - N_META, RET_V_DIM)
    o = jnp.concatenate([o_meta, o_r], axis=2)
    of = o.astype(jnp.float32)
    o = (of * lax.rsqrt(jnp.mean(jnp.square(of), axis=-1, keepdims=True) + EPS)).astype(x.dtype)
    y = o.transpose(0, 2, 1, 3).reshape(B, T, RET_MIX)
    return (jax.nn.silu(g) * y) @ w_out


def setup_inputs(seed: int = 0) -> dict:
    key = jax.random.key(seed)
    ks = iter(jax.random.split(key, 40))
    f32 = jnp.float32

    def nrm(shape, scale):
        return jax.random.normal(next(ks), shape, f32) * scale

    u = jax.random.uniform(next(ks), (N_EVEN, LRU_WIDTH), f32, minval=0.9, maxval=0.999)
    a_base = u ** (1.0 / LRU_C)
    lru_lambda = jnp.log(a_base) - jnp.log1p(-a_base)
    return {
        'x': nrm((BATCH, SEQ, D_MODEL), 1.0),
        'meta_tokens': nrm((N_META, D_MODEL), 1.0),
        'ev_w_in': nrm((N_EVEN, D_MODEL, EVEN_IN), D_MODEL ** -0.5),
        'ev_conv_w': nrm((N_EVEN, CONV_WIDTH, LRU_WIDTH), CONV_WIDTH ** -0.5),
        'ev_conv_b': nrm((N_EVEN, LRU_WIDTH), 0.02),
        'ev_w_rg_a': nrm((N_EVEN, LRU_HEADS, LRU_HEAD_DIM, LRU_HEAD_DIM), LRU_HEAD_DIM ** -0.5),
        'ev_b_rg_a': nrm((N_EVEN, LRU_WIDTH), 0.02),
        'ev_w_rg_x': nrm((N_EVEN, LRU_HEADS, LRU_HEAD_DIM, LRU_HEAD_DIM), LRU_HEAD_DIM ** -0.5),
        'ev_b_rg_x': nrm((N_EVEN, LRU_WIDTH), 0.02),
        'ev_lru_lambda': lru_lambda,
        'ev_q_norm_g': 1.0 + nrm((N_EVEN, MLA_Q_RANK), 0.02),
        'ev_w_uq': nrm((N_EVEN, MLA_Q_RANK, MLA_HEADS * (MLA_NOPE + MLA_ROPE)), MLA_Q_RANK ** -0.5),
        'ev_kv_norm_g': 1.0 + nrm((N_EVEN, MLA_KV_RANK), 0.02),
        'ev_w_ukv': nrm((N_EVEN, MLA_KV_RANK, MLA_HEADS * (MLA_NOPE + MLA_V)), MLA_KV_RANK ** -0.5),
        'ev_w_out': nrm((N_EVEN, EVEN_MIX, D_MODEL), DN_BETA * EVEN_MIX ** -0.5),
        'od_w_in': nrm((N_ODD, D_MODEL, RET_IN), D_MODEL ** -0.5),
        'od_w_out': nrm((N_ODD, RET_MIX, D_MODEL), DN_BETA * RET_MIX ** -0.5),
        'ln_mix_g': 1.0 + nrm((DEPTH, D_MODEL), 0.02),
        'ln_mix_b': nrm((DEPTH, D_MODEL), 0.02),
        'mlp_w1': nrm((DEPTH, D_MODEL, D_FF), D_MODEL ** -0.5),
        'mlp_w2': nrm((DEPTH, D_FF, D_MODEL), DN_BETA * D_FF ** -0.5),
        'ln_mlp_g': 1.0 + nrm((DEPTH, D_MODEL), 0.02),
        'ln_mlp_b': nrm((DEPTH, D_MODEL), 0.02),
    }


def reference(x, meta_tokens, ev_w_in, ev_conv_w, ev_conv_b, ev_w_rg_a, ev_b_rg_a, ev_w_rg_x,
              ev_b_rg_x, ev_lru_lambda, ev_q_norm_g, ev_w_uq, ev_kv_norm_g, ev_w_ukv, ev_w_out,
              od_w_in, od_w_out, ln_mix_g, ln_mix_b, mlp_w1, mlp_w2, ln_mlp_g, ln_mlp_b):
    B = x.shape[0]
    meta = jnp.broadcast_to(meta_tokens[None].astype(x.dtype), (B, N_META, D_MODEL))
    h = jnp.concatenate([meta, x], axis=1)
    pos = jnp.arange(h.shape[1], dtype=jnp.int32)
    for l in range(DEPTH):
        if l % 2 == 0:
            e = l // 2
            mix = _even_mixer(h, pos, ev_w_in[e], ev_conv_w[e], ev_conv_b[e], ev_w_rg_a[e], ev_b_rg_a[e],
                              ev_w_rg_x[e], ev_b_rg_x[e], ev_lru_lambda[e], ev_q_norm_g[e], ev_w_uq[e],
                              ev_kv_norm_g[e], ev_w_ukv[e], ev_w_out[e])
        else:
            o = l // 2
            mix = _odd_mixer(h, pos, od_w_in[o], od_w_out[o])
        h = _layernorm(DN_ALPHA * h + mix, ln_mix_g[l], ln_mix_b[l])
        f = jnp.square(jax.nn.relu(h @ mlp_w1[l])) @ mlp_w2[l]
        h = _layernorm(DN_ALPHA * h + f, ln_mlp_g[l], ln_mlp_b[l])
    return h[:, N_META:]
```

```cpp
#include <hip/hip_runtime.h>
#include <hip/hip_cooperative_groups.h>
#include <stdint.h>
#include <stdio.h>
namespace cg = cooperative_groups;

#ifndef FAST_GEMM
#define FAST_GEMM 1
#endif
#ifndef N_LAUNCH_MODE
#define N_LAUNCH_MODE 0
#endif

#define LAS __attribute__((address_space(3)))
typedef unsigned short bf16_t;
typedef short bf16x8 __attribute__((ext_vector_type(8)));
typedef float f32x4 __attribute__((ext_vector_type(4)));
typedef float f32x2 __attribute__((ext_vector_type(2)));
typedef unsigned u32x4 __attribute__((ext_vector_type(4)));
typedef unsigned u32x2 __attribute__((ext_vector_type(2)));
typedef __bf16 bf16x2_t __attribute__((ext_vector_type(2)));

constexpr int DM = 1024, NBATCH = 16, SEQ = 2048, NMETA = 16, TT = SEQ + NMETA;
constexpr int MR = NBATCH * SEQ;
constexpr int MP = MR + 256;
constexpr int LRUW = 512, EVEN_IN = 1440, N_IN0 = 1536, QRANK = 256, KVRANK = 128;
constexpr int MLA_H = 8, QKD = 96, VD = 64, NQ = MLA_H * QKD  , NV = MLA_H * VD  ;
constexpr int FF = 4096, N_IN1 = 6144, RET_H = 4, RDK = 256, RDV = 512, RMIX = 2048;
constexpr float LN_EPS = 1e-5f;
constexpr float DN_ALPHA = 1.41421356237309515f;
constexpr float QSCALE = 0.10206207261596575f * 1.4426950408889634f;

constexpr size_t KB = 1024, MB = 1024 * 1024;
constexpr size_t OFF_CTL = 0;
constexpr size_t SZ_CTL = 64 * KB;
constexpr size_t OFF_ROPE0C = OFF_CTL + SZ_CTL;
constexpr size_t OFF_ROPE0S = OFF_ROPE0C + 132 * KB;
constexpr size_t OFF_ROPE1C = OFF_ROPE0S + 132 * KB;
constexpr size_t OFF_ROPE1S = OFF_ROPE1C + 1056 * KB;
constexpr size_t OFF_CCH = OFF_ROPE1S + 1056 * KB;
constexpr size_t OFF_C12 = OFF_CCH + 4 * KB;
constexpr size_t OFF_SSQQ = OFF_C12 + 128 * KB;
constexpr size_t OFF_SSQKV = OFF_SSQQ + 528 * KB;
constexpr size_t OFF_STATA = OFF_SSQKV + 528 * KB;
constexpr size_t OFF_STATB = OFF_STATA + (size_t)MP * 128;
constexpr size_t OFF_ZMETA = OFF_STATB + (size_t)MP * 128;
constexpr size_t OFF_ABMETA = OFF_ZMETA + MB;
constexpr size_t OFF_CARRY = OFF_ABMETA + MB;
constexpr size_t OFF_OSQ = OFF_CARRY + MB;
constexpr size_t OFF_W = 18 * MB;
static_assert(OFF_OSQ + (size_t)MP * 64 <= OFF_W, "small buffers");
constexpr size_t OFF_WIN1 = OFF_W;
constexpr size_t OFF_WOUT1 = OFF_WIN1 + (size_t)6144 * 1024 * 2;
constexpr size_t OFF_W1_1 = OFF_WOUT1 + (size_t)2048 * 1024 * 2;
constexpr size_t OFF_W2_1 = OFF_W1_1 + (size_t)4096 * 1024 * 2;
constexpr size_t OFF_BIG = 50 * MB;
static_assert(OFF_W2_1 + (size_t)4096 * 1024 * 2 <= OFF_BIG, "weights");
constexpr size_t SZ_ROW1K = (size_t)MP * 1024 * 2;
constexpr size_t OFF_XB = OFF_BIG;
constexpr size_t OFF_MIX = OFF_XB;
constexpr size_t OFF_P0 = OFF_XB + SZ_ROW1K;
constexpr size_t OFF_XC = OFF_P0 + (size_t)MP * 1536 * 2;
constexpr size_t OFF_Q = OFF_XC + (size_t)MP * 512 * 2;
constexpr size_t OFF_K = OFF_Q + (size_t)MP * 768 * 2;
constexpr size_t OFF_V = OFF_K + (size_t)MP * 768 * 2;
constexpr size_t OFF_HID = OFF_BIG;
constexpr size_t OFF_Q1 = OFF_BIG;
constexpr size_t OFF_K1 = OFF_Q1 + SZ_ROW1K;
constexpr size_t OFF_V1 = OFF_K1 + SZ_ROW1K;
constexpr size_t OFF_G1 = OFF_V1 + 2 * SZ_ROW1K;
constexpr size_t OFF_W0 = 415 * MB;
constexpr size_t OFF_WIN0 = OFF_W0;
constexpr size_t OFF_WGATE = OFF_WIN0 + (size_t)N_IN0 * 1024 * 2;
constexpr size_t OFF_WUQ = OFF_WGATE + 1024 * 128 * 2;
constexpr size_t OFF_WUKV = OFF_WUQ + 768 * 256 * 2;
constexpr size_t OFF_WOUT0 = OFF_WUKV + 1024 * 128 * 2;
constexpr size_t OFF_W1_0 = OFF_WOUT0 + 1024 * 1024 * 2;
constexpr size_t OFF_W2_0 = OFF_W1_0 + (size_t)4096 * 1024 * 2;
constexpr size_t OFF_ZB = 438 * MB;
constexpr size_t WS_END = 504 * MB;
static_assert(OFF_V + (size_t)MP * 512 * 2 <= OFF_W0 && OFF_HID + (size_t)MP * 4096 * 2 <= OFF_W0 && OFF_G1 + 2 * SZ_ROW1K <= OFF_ZB && OFF_W2_0 + (size_t)4096 * 1024 * 2 <= OFF_ZB && OFF_ZB + SZ_ROW1K <= WS_END, "ws map");

struct Params { const float* in[23]; float* out; unsigned char* ws; long long ph_lo, ph_hi; double inv0[16]; double inv1[128]; };

__device__ __forceinline__ int opaque_tid() { int t = threadIdx.x; asm volatile("" : "+v"(t)); return t; }
__device__ __forceinline__ float bf2f(unsigned v) { return __uint_as_float(v << 16); }
__device__ __forceinline__ unsigned pk2(float lo, float hi) { f32x2 v = {lo, hi}; bf16x2_t b = __builtin_convertvector(v, bf16x2_t); return __builtin_bit_cast(unsigned, b); }
__device__ __forceinline__ u32x2 pk4(f32x4 v) { u32x2 r; r.x = pk2(v[0], v[1]); r.y = pk2(v[2], v[3]); return r; }
__device__ __forceinline__ f32x4 unpk4(u32x2 w) { return (f32x4){bf2f(w.x & 0xffffu), bf2f(w.x >> 16), bf2f(w.y & 0xffffu), bf2f(w.y >> 16)}; }
__device__ __forceinline__ float bfround(float x) { return bf2f(pk2(x, 0.f) & 0xffffu); }
__device__ __forceinline__ float wave_sum(float v) {
#pragma unroll
    for (int o = 1; o < 64; o <<= 1) v += __shfl_xor(v, o);
    return v;
}
__device__ __forceinline__ float wave_max(float v) {
#pragma unroll
    for (int o = 1; o < 64; o <<= 1) v = fmaxf(v, __shfl_xor(v, o));
    return v;
}
__device__ __forceinline__ float sigmoidf_(float x) { return 1.f / (1.f + __expf(-x)); }
__device__ __forceinline__ float gelu_tanh(float x) { const float u = 0.7978845608028654f * (x + 0.044715f * x * x * x); const float t = 1.f - 2.f / (1.f + __expf(2.f * u)); return 0.5f * x * (1.f + t); }
__device__ __forceinline__ int row_pos(int row) { return row < MR ? NMETA + (row & (SEQ - 1)) : (row - MR); }

struct Ctx {
    const float* const* in; float* out; unsigned char* ws;
    __device__ __forceinline__ bf16_t* b16(size_t off) const { return (bf16_t*)(ws + off); }
    __device__ __forceinline__ float* f32(size_t off) const { return (float*)(ws + off); }
    __device__ __forceinline__ float* zrow(int row) const { return row < MR ? out + (size_t)row * DM : f32(OFF_ZMETA) + (size_t)(row - MR) * DM; }
    __device__ __forceinline__ float* arow(int row) const { return row < MR ? out + (size_t)row * LRUW : f32(OFF_ABMETA) + (size_t)(row - MR) * LRUW; }
    __device__ __forceinline__ float* brow(int row) const { return row < MR ? out + (size_t)MR * LRUW + (size_t)row * LRUW : f32(OFF_ABMETA) + 256 * LRUW + (size_t)(row - MR) * LRUW; }
};

struct Gemm { const bf16_t* A; const bf16_t* Bt; int M, N, K, lda, ldb, a_pn_off; };

__device__ __forceinline__ void row_stats(const float* st, int row, int fq, float& mean, float& rstd) {
    const f32x4* p = (const f32x4*)(st + (size_t)row * 32 + fq * 8);
    const f32x4 a = p[0], b = p[1];
    float s1 = a[0] + a[2] + b[0] + b[2], s2 = a[1] + a[3] + b[1] + b[3];
    s1 += __shfl_xor(s1, 16); s2 += __shfl_xor(s2, 16); s1 += __shfl_xor(s1, 32); s2 += __shfl_xor(s2, 32);
    mean = s1 * (1.f / DM); const float var = fmaxf(s2 * (1.f / DM) - mean * mean, 0.f); rstd = rsqrtf(var + LN_EPS);
}
__device__ __forceinline__ void put_stats(float* st, int row, int pn, int q0, const f32x4 (&v)[2][2]) {
    float s1 = 0.f, s2 = 0.f;
#pragma unroll
    for (int bj = 0; bj < 2; ++bj)
#pragma unroll
        for (int n = 0; n < 2; ++n)
#pragma unroll
            for (int e = 0; e < 4; ++e) { s1 += v[bj][n][e]; s2 += v[bj][n][e] * v[bj][n][e]; }
    s1 += __shfl_xor(s1, 16); s2 += __shfl_xor(s2, 16); s1 += __shfl_xor(s1, 32); s2 += __shfl_xor(s2, 32);
    if (((q0 >> 2) & 7) == 0) *(f32x2*)(st + (size_t)row * 32 + (pn * 4 + (q0 >> 5)) * 2) = (f32x2){s1, s2};
}

struct EpiIn0 {
    bf16_t* p0; float* ssq_q; float* ssq_kv;
    __device__ __forceinline__ void apply(int row, int pn, int q0, f32x4 (&v)[2][2]) const {
        bf16_t* base = p0 + (size_t)row * N_IN0 + 256 * pn + q0;
#pragma unroll
        for (int bj = 0; bj < 2; ++bj)
#pragma unroll
            for (int n = 0; n < 2; ++n) *(u32x2*)(base + 128 * bj + 16 * n) = pk4(v[bj][n]);
        if (pn == 4 || pn == 5) {
            float s = 0.f;
#pragma unroll
            for (int n = 0; n < 2; ++n)
#pragma unroll
                for (int e = 0; e < 4; ++e) { s += v[0][n][e] * v[0][n][e]; if (pn == 4) s += v[1][n][e] * v[1][n][e]; }
            s += __shfl_xor(s, 16); s += __shfl_xor(s, 32);
            if (((q0 >> 2) & 7) == 0) (pn == 4 ? ssq_q : ssq_kv)[(size_t)row * 4 + (q0 >> 5)] = s;
        }
    }
};
struct EpiQup {
    bf16_t* Q; const float* ssq_q; const float* rc; const float* rs;
    __device__ __forceinline__ void apply(int row, int pn, int q0, f32x4 (&v)[2][2]) const {
        const f32x4 sq = *(const f32x4*)(ssq_q + (size_t)row * 4);
        const float r = rsqrtf((sq[0] + sq[1] + sq[2] + sq[3]) * (1.f / QRANK) + LN_EPS) * QSCALE;
        const int fq = (q0 >> 2) & 7, wc = q0 >> 5, pos = row_pos(row);
#pragma unroll
        for (int bj = 0; bj < 2; ++bj) {
            f32x4 x1 = v[bj][0] * r, x2 = v[bj][1] * r;
            const int G = 8 * pn + 4 * bj + wc;
            if ((G % 3) == 2) {
                const f32x4 c = *(const f32x4*)(rc + pos * 16 + 4 * fq), s = *(const f32x4*)(rs + pos * 16 + 4 * fq);
                const f32x4 y1 = x1 * c - x2 * s, y2 = x1 * s + x2 * c; x1 = y1; x2 = y2;
            }
            bf16_t* base = Q + (size_t)row * NQ + 256 * pn + 128 * bj + q0;
            *(u32x2*)(base) = pk4(x1); *(u32x2*)(base + 16) = pk4(x2);
        }
    }
};
struct EpiKVup {
    bf16_t* K; bf16_t* V; const float* ssq_kv;
    __device__ __forceinline__ void apply(int row, int pn, int q0, f32x4 (&v)[2][2]) const {
        const f32x4 sq = *(const f32x4*)(ssq_kv + (size_t)row * 4);
        const float r = rsqrtf((sq[0] + sq[1] + sq[2] + sq[3]) * (1.f / KVRANK) + LN_EPS);
        const int wc = q0 >> 5;
#pragma unroll
        for (int bj = 0; bj < 2; ++bj) {
            const int head = 2 * pn + bj;
#pragma unroll
            for (int n = 0; n < 2; ++n) {
                const int within = q0 + 16 * n;
                bf16_t* dst = (wc < 2) ? K + (size_t)row * NQ + head * QKD + within : V + (size_t)row * NV + head * VD + (within - 64);
                *(u32x2*)dst = pk4(v[bj][n] * r);
            }
        }
    }
};
struct EpiGate {
    Ctx c; const bf16_t* xc; const float* cch; const float* ba; const float* bx;
    __device__ __forceinline__ void apply(int row, int pn, int q0, f32x4 (&v)[2][2]) const {
        float* ar = c.arow(row); float* br = c.brow(row);
#pragma unroll
        for (int n = 0; n < 2; ++n) {
            const int ch = 128 * pn + q0 + 16 * n;
            const f32x4 cc = *(const f32x4*)(cch + ch), va = *(const f32x4*)(ba + ch), vx = *(const f32x4*)(bx + ch);
            const f32x4 xv = unpk4(*(const u32x2*)(xc + (size_t)row * LRUW + ch));
            f32x4 oa, ob;
#pragma unroll
            for (int e = 0; e < 4; ++e) {
                const float r = sigmoidf_(v[0][n][e] + va[e]), ig = sigmoidf_(v[1][n][e] + vx[e]);
                const float la = cc[e] * r, x = 2.f * la;
                const float em = x * (1.f + x * (0.5f + x * (1.f / 6 + x * (1.f / 24 + x * (1.f / 120 + x * (1.f / 720 + x * (1.f / 5040)))))));
                oa[e] = __expf(la); ob[e] = sqrtf(fmaxf(-em, 0.f)) * (ig * xv[e]);
            }
            *(f32x4*)(ar + ch) = oa; *(f32x4*)(br + ch) = ob;
        }
    }
};
template <int MODE, bool LAST> struct EpiRes {
    Ctx c; bf16_t* zb; const float* st_in; float* st_out; const float* g; const float* b; const float* x; const float* meta;
    __device__ __forceinline__ void apply(int row, int pn, int q0, f32x4 (&v)[2][2]) const {
        float* zr = c.zrow(row);
        float mean = 0.f, rstd = 0.f;
        if (MODE == 1) row_stats(st_in, row, (q0 >> 2) & 7, mean, rstd);
#pragma unroll
        for (int bj = 0; bj < 2; ++bj)
#pragma unroll
            for (int n = 0; n < 2; ++n) {
                const int col = 256 * pn + 128 * bj + q0 + 16 * n;
                f32x4 h;
                if (MODE == 1) { const f32x4 z = *(const f32x4*)(zr + col); h = (z - mean) * rstd * *(const f32x4*)(g + col) + *(const f32x4*)(b + col); }
                else { h = row < MR ? *(const f32x4*)(x + (size_t)row * DM + col) : (row < MR + NMETA ? *(const f32x4*)(meta + (size_t)(row - MR) * DM + col) : (f32x4){0.f, 0.f, 0.f, 0.f}); }
                v[bj][n] = h * DN_ALPHA + v[bj][n];
                *(f32x4*)(zr + col) = v[bj][n];
                if (!LAST) *(u32x2*)(zb + (size_t)row * DM + col) = pk4(v[bj][n]);
            }
        if (!LAST) put_stats(st_out, row, pn, q0, v);
    }
};
struct EpiMlpUp {
    bf16_t* hid; const float* st_in; const float* c1; const float* c2;
    __device__ __forceinline__ void apply(int row, int pn, int q0, f32x4 (&v)[2][2]) const {
        float mean, rstd; row_stats(st_in, row, (q0 >> 2) & 7, mean, rstd);
#pragma unroll
        for (int bj = 0; bj < 2; ++bj)
#pragma unroll
            for (int n = 0; n < 2; ++n) {
                const int col = 256 * pn + 128 * bj + q0 + 16 * n;
                f32x4 u = (v[bj][n] - *(const f32x4*)(c1 + col) * mean) * rstd + *(const f32x4*)(c2 + col);
#pragma unroll
                for (int e = 0; e < 4; ++e) { const float r = fmaxf(u[e], 0.f); u[e] = r * r; }
                *(u32x2*)(hid + (size_t)row * FF + col) = pk4(u);
            }
    }
};
struct EpiIn1 {
    bf16_t* q1; bf16_t* k1; bf16_t* v1; bf16_t* g1; const float* st_in; const float* c1; const float* c2; const float* rc; const float* rs;
    __device__ __forceinline__ void apply(int row, int pn, int q0, f32x4 (&v)[2][2]) const {
        float mean, rstd; row_stats(st_in, row, (q0 >> 2) & 7, mean, rstd);
#pragma unroll
        for (int bj = 0; bj < 2; ++bj)
#pragma unroll
            for (int n = 0; n < 2; ++n) { const int col = 256 * pn + 128 * bj + q0 + 16 * n; v[bj][n] = (v[bj][n] - *(const f32x4*)(c1 + col) * mean) * rstd + *(const f32x4*)(c2 + col); }
        if (pn < 8) {
            const int pos = row_pos(row); const float sc = pn < 4 ? 1.f : 0.0625f;
            bf16_t* dst = (pn < 4 ? q1 : k1) + (size_t)row * 1024 + 256 * (pn & 3) + q0;
#pragma unroll
            for (int n = 0; n < 2; ++n) {
                const int j = q0 + 16 * n;
                const f32x4 cs = *(const f32x4*)(rc + pos * 128 + j) * sc, sn = *(const f32x4*)(rs + pos * 128 + j) * sc;
                const f32x4 y1 = v[0][n] * cs - v[1][n] * sn, y2 = v[0][n] * sn + v[1][n] * cs;
                *(u32x2*)(dst + 16 * n) = pk4(y1); *(u32x2*)(dst + 128 + 16 * n) = pk4(y2);
            }
        } else {
            const bool isg = pn >= 16;
            bf16_t* dst = (isg ? g1 : v1) + (size_t)row * RMIX + 256 * (isg ? pn - 16 : pn - 8) + q0;
#pragma unroll
            for (int bj = 0; bj < 2; ++bj)
#pragma unroll
                for (int n = 0; n < 2; ++n) {
                    f32x4 u = v[bj][n];
                    if (isg) {
#pragma unroll
                        for (int e = 0; e < 4; ++e) u[e] = u[e] * sigmoidf_(u[e]);
                    }
                    *(u32x2*)(dst + 128 * bj + 16 * n) = pk4(u);
                }
        }
    }
};

template <class Epi>
__device__ __forceinline__ void gemm_naive(const Gemm g, const Epi& E, int bid, int nb) {
    const int tid = opaque_tid(), wid = tid >> 6, lane = tid & 63, fr = lane & 15, fq = lane >> 4;
    const int nN = g.N / 256, units = (g.M / 256) * nN;
    for (long item = (long)bid * 8 + wid; item < (long)units * 64; item += (long)nb * 8) {
        const int unit = (int)(item >> 6), sub = (int)(item & 63), pm = unit / nN, pn = unit % nN, mg = sub >> 2, wc = sub & 3;
        const int row0 = 256 * pm + 16 * mg;
        const bf16_t* ap = g.A + (size_t)pn * g.a_pn_off + (size_t)(row0 + fr) * g.lda + 8 * fq;
        const bf16_t* bp = g.Bt + (size_t)(256 * pn + 32 * wc + fr) * g.ldb + 8 * fq;
        f32x4 acc[2][2];
#pragma unroll
        for (int bj = 0; bj < 2; ++bj)
#pragma unroll
            for (int n = 0; n < 2; ++n) acc[bj][n] = (f32x4){0.f, 0.f, 0.f, 0.f};
        for (int k0 = 0; k0 < g.K; k0 += 32) {
            const bf16x8 a = *(const bf16x8*)(ap + k0);
#pragma unroll
            for (int bj = 0; bj < 2; ++bj)
#pragma unroll
                for (int n = 0; n < 2; ++n) {
                    const bf16x8 b = *(const bf16x8*)(bp + (size_t)(128 * bj + 16 * n) * g.ldb + k0);
                    acc[bj][n] = __builtin_amdgcn_mfma_f32_16x16x32_bf16(b, a, acc[bj][n], 0, 0, 0);
                }
        }
        E.apply(row0 + fr, pn, 32 * wc + 4 * fq, acc);
    }
}

namespace pg8 {
constexpr int BM = 256, BK = 64, HALF = 128, HTB = HALF * BK * 2  , STAGE_BYTES = 8 * HTB, NXCD = 8, WGM = 8;
__host__ __device__ __forceinline__ int lds_byte(int r, int c) { const int st = (r >> 4) * 2 + (c >> 5), rr = r & 15, cc = c & 31, ob = rr * 64 + cc * 2; return st * 1024 + (ob ^ (((ob >> 9) & 1) << 5)); }
__host__ __device__ __forceinline__ void stage_rc(int b, int& R, int& C) { const int st = b / 1024, sb = b % 1024, swz = sb ^ (((sb >> 9) & 1) << 5); R = (st >> 1) * 16 + swz / 64; C = (st & 1) * 32 + (swz % 64) / 2; }
struct Unit { int pm, pn; };
struct StaticOrder {
    int nM, nN, nwg, G, c;
    __host__ __device__ void init(int M, int N, int G_, int c_) { nM = M / BM; nN = N / BM; nwg = nM * nN; G = G_; c = c_; }
    __host__ __device__ bool next(int i, Unit& u) const {
        const long L = (long)i * G + c; if (L >= nwg) return false;
        int wgid = (int)L; { const int q = nwg / NXCD, r = nwg % NXCD, xcd = wgid % NXCD, off = wgid / NXCD; wgid = (xcd < r ? xcd * (q + 1) : r * (q + 1) + (xcd - r) * q) + off; }
        const int nig = WGM * nN, gid = wgid / nig, fm = gid * WGM, gsz = (nM - fm) < WGM ? (nM - fm) : WGM;
        u.pm = fm + ((wgid % nig) % gsz); u.pn = (wgid % nig) / gsz; return true;
    }
};
template <class E> struct PgEpi {
    E e;
    __device__ __forceinline__ void operator()(const f32x4 (&acc)[2][2][4][2], const Unit& u, int wr, int wc, int fr, int fq) const {
#pragma unroll
        for (int ai = 0; ai < 2; ++ai)
#pragma unroll
            for (int m = 0; m < 4; ++m) {
                f32x4 v[2][2] = {{acc[ai][0][m][0], acc[ai][0][m][1]}, {acc[ai][1][m][0], acc[ai][1][m][1]}};
                e.apply(u.pm * BM + ai * HALF + wr * 64 + m * 16 + fr, u.pn, wc * 32 + 4 * fq, v);
                asm volatile("" ::: "memory");
            }
    }
};
template <class Epi>
__device__ __forceinline__ void gemm_phase(LAS unsigned char* lds, const Gemm g, const StaticOrder& S, const Epi& E) {
    const int tid = opaque_tid(), wid = __builtin_amdgcn_readfirstlane(tid >> 6), lane = tid & 63, wr = wid >> 2, wc = wid & 3, fr = lane & 15, fq = lane >> 4;
    int Ko = g.K; asm volatile("" : "+s"(Ko));
    const int K = Ko, nt = K / BK;
    unsigned voffA[2], voffB[2];
#pragma unroll
    for (int i = 0; i < 2; ++i) { int R, C; stage_rc(tid * 16 + i * 8192, R, C); voffA[i] = (unsigned)(R * g.lda + C) * 2u; voffB[i] = (unsigned)(R * g.ldb + C) * 2u; }
    const size_t kstep = (size_t)(BK * 2);
    const size_t hstepA = (size_t)HALF * g.lda * 2, hstepB = (size_t)HALF * g.ldb * 2;
    const size_t tstepA = 2 * hstepA, tstepB = 2 * hstepB;
    const size_t pnA = (size_t)g.a_pn_off * 2;
    const unsigned ldsw = (unsigned)wid * 1024u;
    const int aoff = lds_byte(wr * 64 + fr, fq * 8), boff = lds_byte(wc * 32 + fr, fq * 8);
#define PG8_SA(b, h) (((b) * 2 + (h)) * HTB)
#define PG8_SB(b, h) ((4 + (b) * 2 + (h)) * HTB)
#define PG8_STAGE(bufoff, gbase, voff) do { _Pragma("unroll") for (int _i = 0; _i < 2; ++_i) \
        __builtin_amdgcn_global_load_lds((const unsigned*)((const char*)(gbase) + (voff)[_i]), (LAS unsigned*)(lds + (bufoff) + ldsw + _i * 8192), 16, 0, 0); } while (0)
#define PG8_LDA(dst, b, h) do { _Pragma("unroll") for (int m = 0; m < 4; ++m) _Pragma("unroll") for (int k = 0; k < 2; ++k) dst[m][k] = *(const LAS bf16x8*)(lds + PG8_SA(b, h) + aoff + m * 2048 + k * 1024); } while (0)
#define PG8_LDB(dst, b, h) do { _Pragma("unroll") for (int n = 0; n < 2; ++n) _Pragma("unroll") for (int k = 0; k < 2; ++k) dst[n][k] = *(const LAS bf16x8*)(lds + PG8_SB(b, h) + boff + n * 2048 + k * 1024); } while (0)
#define PG8_MMA(ai, bj, At, Bt) do { __builtin_amdgcn_s_setprio(1); _Pragma("unroll") for (int m = 0; m < 4; ++m) _Pragma("unroll") for (int n = 0; n < 2; ++n) _Pragma("unroll") for (int k = 0; k < 2; ++k) \
        acc[ai][bj][m][n] = __builtin_amdgcn_mfma_f32_16x16x32_bf16(Bt[n][k], At[m][k], acc[ai][bj][m][n], 0, 0, 0); __builtin_amdgcn_s_setprio(0); } while (0)
#define PG8_WAIT_V(n) asm volatile("s_waitcnt vmcnt(" #n ")" ::: "memory")
#define PG8_WAIT_L(n) asm volatile("s_waitcnt lgkmcnt(" #n ")" ::: "memory")
#define PG8_BAR __builtin_amdgcn_s_barrier()
#define PG8_SCHED __builtin_amdgcn_sched_barrier(0)
    Unit cur, nxt; int ui = 0;
    if (!S.next(0, cur)) return;
    f32x4 acc[2][2][4][2];
#pragma unroll
    for (int a = 0; a < 2; ++a)
#pragma unroll
        for (int b = 0; b < 2; ++b)
#pragma unroll
            for (int m = 0; m < 4; ++m)
#pragma unroll
                for (int n = 0; n < 2; ++n) acc[a][b][m][n] = (f32x4){0.f, 0.f, 0.f, 0.f};
    bf16x8 At[4][2], B0[2][2], B1[2][2];
    const char* cA = (const char*)g.A + (size_t)cur.pn * pnA + (size_t)cur.pm * tstepA; const char* cB = (const char*)g.Bt + (size_t)cur.pn * tstepB;
    PG8_STAGE(PG8_SB(0, 0), cB, voffB); PG8_STAGE(PG8_SB(0, 1), cB + hstepB, voffB); PG8_STAGE(PG8_SA(0, 0), cA, voffA); PG8_STAGE(PG8_SA(0, 1), cA + hstepA, voffA);
    if (wr == 1) PG8_BAR;
    PG8_WAIT_V(2); PG8_BAR;
    PG8_STAGE(PG8_SB(1, 0), cB + kstep, voffB); PG8_STAGE(PG8_SA(1, 0), cA + kstep, voffA); PG8_STAGE(PG8_SB(1, 1), cB + hstepB + kstep, voffB);
    PG8_WAIT_V(6); PG8_BAR;
    for (;;) {
        const bool has_next = S.next(ui + 1, nxt);
        const char* nA = has_next ? (const char*)g.A + (size_t)nxt.pn * pnA + (size_t)nxt.pm * tstepA : cA; const char* nB = has_next ? (const char*)g.Bt + (size_t)nxt.pn * tstepB : cB;
        for (int t = 0; t < nt; t += 2) {
            const bool last = (t == nt - 2);
            const char* a1 = cA + (size_t)(t + 1) * kstep;
            const char* a2 = last ? nA : cA + (size_t)(t + 2) * kstep; const char* b2 = last ? nB : cB + (size_t)(t + 2) * kstep;
            const char* a3 = a2 + kstep; const char* b3 = b2 + kstep;
            PG8_LDB(B0, 0, 0); PG8_LDB(B1, 0, 1); PG8_SCHED; PG8_LDA(At, 0, 0); PG8_STAGE(PG8_SA(1, 1), a1 + hstepA, voffA);
            PG8_WAIT_V(8); PG8_WAIT_L(0); PG8_BAR; PG8_MMA(0, 0, At, B0); PG8_MMA(0, 1, At, B1); PG8_BAR; PG8_SCHED;
            PG8_LDA(At, 0, 1); PG8_STAGE(PG8_SB(0, 0), b2, voffB); PG8_STAGE(PG8_SB(0, 1), b2 + hstepB, voffB); PG8_STAGE(PG8_SA(0, 0), a2, voffA);
            PG8_WAIT_V(8); PG8_WAIT_L(0); PG8_BAR; PG8_MMA(1, 0, At, B0); PG8_MMA(1, 1, At, B1); PG8_BAR; PG8_SCHED;
            PG8_LDB(B0, 1, 0); PG8_LDB(B1, 1, 1); PG8_SCHED; PG8_LDA(At, 1, 0); PG8_STAGE(PG8_SA(0, 1), a2 + hstepA, voffA);
            PG8_WAIT_V(8); PG8_WAIT_L(0); PG8_BAR; PG8_MMA(0, 0, At, B0); PG8_MMA(0, 1, At, B1); PG8_BAR; PG8_SCHED;
            PG8_LDA(At, 1, 1); PG8_STAGE(PG8_SB(1, 0), b3, voffB); PG8_STAGE(PG8_SB(1, 1), b3 + hstepB, voffB); PG8_STAGE(PG8_SA(1, 0), a3, voffA);
            PG8_WAIT_V(8); PG8_WAIT_L(0); PG8_BAR; PG8_MMA(1, 0, At, B0); PG8_MMA(1, 1, At, B1); PG8_BAR; PG8_SCHED;
        }
        if (wr == 0) PG8_BAR;
        E(acc, cur, wr, wc, fr, fq);
        if (!has_next) break;
#pragma unroll
        for (int a = 0; a < 2; ++a)
#pragma unroll
            for (int b = 0; b < 2; ++b)
#pragma unroll
                for (int m = 0; m < 4; ++m)
#pragma unroll
                    for (int n = 0; n < 2; ++n) acc[a][b][m][n] = (f32x4){0.f, 0.f, 0.f, 0.f};
        cur = nxt; cA = nA; cB = nB; ++ui;
        if (wr == 1) PG8_BAR;
    }
    PG8_WAIT_V(0);
    PG8_BAR;
#undef PG8_SA
#undef PG8_SB
#undef PG8_STAGE
#undef PG8_LDA
#undef PG8_LDB
#undef PG8_MMA
#undef PG8_WAIT_V
#undef PG8_WAIT_L
#undef PG8_BAR
#undef PG8_SCHED
}
}

template <class E>
__device__ __forceinline__ void run_gemm(LAS unsigned char* lds, const Gemm g, const E& e, int bid, int nb) {
#if FAST_GEMM
    pg8::StaticOrder S; S.init(g.M, g.N, nb, bid);
    pg8::PgEpi<E> pe{e};
    pg8::gemm_phase<pg8::PgEpi<E>>(lds, g, S, pe);
#else
    gemm_naive<E>(g, e, bid, nb);
#endif
}

constexpr int NWV = 8;

__device__ __forceinline__ void transpose_item(const float* W, int K, int N, bf16_t* WT, int row_off, const float* gk, LAS float* scr, int item, int lane) {
    const int nblk = N / 32, kb = item / nblk, nbk = item % nblk, k0 = 64 * kb, n0 = 32 * nbk;
#pragma unroll 8
    for (int i = 0; i < 32; ++i) { const int kk = 2 * i + (lane >> 5); float w = W[(size_t)(k0 + kk) * N + n0 + (lane & 31)]; if (gk) w *= gk[k0 + kk]; scr[kk * 33 + (lane & 31)] = w; }
    asm volatile("s_waitcnt lgkmcnt(0)" ::: "memory");
    const int cch = lane & 7;
#pragma unroll
    for (int j = 0; j < 4; ++j) { const int n = (lane >> 3) + 8 * j; const LAS float* s = scr + (8 * cch) * 33 + n;
        u32x4 o; o.x = pk2(s[0 * 33], s[1 * 33]); o.y = pk2(s[2 * 33], s[3 * 33]); o.z = pk2(s[4 * 33], s[5 * 33]); o.w = pk2(s[6 * 33], s[7 * 33]);
        *(u32x4*)(WT + (size_t)(row_off + n0 + n) * K + k0 + 8 * cch) = o; }
    asm volatile("s_waitcnt lgkmcnt(0)" ::: "memory");
}
struct MatDesc { const float* W; int K, N; bf16_t* WT; int row_off; const float* gk; };
constexpr int TR_COUNT[18] = {720, 8, 8, 8, 8, 8, 8, 8, 8, 96, 64, 512, 2048, 2048, 3072, 1024, 2048, 2048};
constexpr int tr_total() { int s = 0; for (int i = 0; i < 18; ++i) s += TR_COUNT[i]; return s; }
__device__ __forceinline__ MatDesc get_mat(const Ctx& c, int i) {
    MatDesc d; d.gk = nullptr; d.row_off = 0;
    if (i == 0) { d.W = c.in[2]; d.K = 1024; d.N = EVEN_IN; d.WT = c.b16(OFF_WIN0); }
    else if (i <= 4) { const int h = i - 1; d.W = c.in[5] + h * 16384; d.K = 128; d.N = 128; d.WT = c.b16(OFF_WGATE); d.row_off = h * 256; }
    else if (i <= 8) { const int h = i - 5; d.W = c.in[7] + h * 16384; d.K = 128; d.N = 128; d.WT = c.b16(OFF_WGATE); d.row_off = h * 256 + 128; }
    else if (i == 9) { d.W = c.in[11]; d.K = 256; d.N = 768; d.WT = c.b16(OFF_WUQ); d.gk = c.in[10]; }
    else if (i == 10) { d.W = c.in[13]; d.K = 128; d.N = 1024; d.WT = c.b16(OFF_WUKV); d.gk = c.in[12]; }
    else if (i == 11) { d.W = c.in[14]; d.K = 1024; d.N = 1024; d.WT = c.b16(OFF_WOUT0); }
    else if (i == 12) { d.W = c.in[19]; d.K = 1024; d.N = 4096; d.WT = c.b16(OFF_W1_0); d.gk = c.in[17]; }
    else if (i == 13) { d.W = c.in[20]; d.K = 4096; d.N = 1024; d.WT = c.b16(OFF_W2_0); }
    else if (i == 14) { d.W = c.in[15]; d.K = 1024; d.N = 6144; d.WT = c.b16(OFF_WIN1); d.gk = c.in[21]; }
    else if (i == 15) { d.W = c.in[16]; d.K = 2048; d.N = 1024; d.WT = c.b16(OFF_WOUT1); }
    else if (i == 16) { d.W = c.in[19] + (size_t)1024 * 4096; d.K = 1024; d.N = 4096; d.WT = c.b16(OFF_W1_1); d.gk = c.in[17] + 1024; }
    else { d.W = c.in[20] + (size_t)4096 * 1024; d.K = 4096; d.N = 1024; d.WT = c.b16(OFF_W2_1); }
    return d;
}
constexpr int C1_UP0 = 0, C2_UP0 = 4096, C1_IN1 = 8192, C2_IN1 = 14336, C1_UP1 = 20480, C2_UP1 = 24576;
__device__ __forceinline__ void sincos_d(double ang, float& cs, float& sn) {
    const double TWO_PI = 6.283185307179586476925, HALF_PI = 1.5707963267948966192;
    double r = ang - rint(ang / TWO_PI) * TWO_PI;
    const double q = rint(r / HALF_PI); const double y = r - q * HALF_PI; const double y2 = y * y;
    const double s = y * (1.0 + y2 * (-1.0 / 6 + y2 * (1.0 / 120 + y2 * (-1.0 / 5040 + y2 * (1.0 / 362880 + y2 * (-1.0 / 39916800 + y2 * (1.0 / 6227020800.0)))))));
    const double c = 1.0 + y2 * (-0.5 + y2 * (1.0 / 24 + y2 * (-1.0 / 720 + y2 * (1.0 / 40320 + y2 * (-1.0 / 3628800 + y2 * (1.0 / 479001600.0))))));
    const int qi = ((int)q) & 3;
    double cc, ss;
    if (qi == 0) { cc = c; ss = s; } else if (qi == 1) { cc = -s; ss = c; } else if (qi == 2) { cc = -c; ss = -s; } else { cc = s; ss = -c; }
    cs = (float)cc; sn = (float)ss;
}
__device__ __forceinline__ void phase_prologue(const Ctx& c, const Params& p, LAS unsigned char* lds, int bid, int nb) {
    const int tid = opaque_tid(), wid = tid >> 6, lane = tid & 63;
    LAS float* scr = (LAS float*)(lds + wid * 16384);
    const long gw = (long)bid * NWV + wid, NW = (long)nb * NWV;
    constexpr int T_C12 = 224 * 8, T_TR = tr_total(), T_ZP = 96, T_XB = MP, T_ROPE = (TT * 144 + 63) / 64, T_CCH = 8;
    constexpr int TOTAL = T_C12 + T_TR + T_ZP + T_XB + T_ROPE + T_CCH;
    for (long it = gw; it < TOTAL; it += NW) {
        int r = (int)it;
        if (r < T_C12) {
            const int part = r & 7, grp = r >> 3;
            const float* W; const float* gk; const float* bk; int N, ncol, c1o, c2o;
            if (grp < 64) { W = c.in[19]; gk = c.in[17]; bk = c.in[18]; N = 4096; ncol = grp * 64; c1o = C1_UP0; c2o = C2_UP0; }
            else if (grp < 160) { W = c.in[15]; gk = c.in[21]; bk = c.in[22]; N = 6144; ncol = (grp - 64) * 64; c1o = C1_IN1; c2o = C2_IN1; }
            else { W = c.in[19] + (size_t)1024 * 4096; gk = c.in[17] + 1024; bk = c.in[18] + 1024; N = 4096; ncol = (grp - 160) * 64; c1o = C1_UP1; c2o = C2_UP1; }
            float s1 = 0.f, s2 = 0.f;
#pragma unroll 8
            for (int k = part * 128; k < part * 128 + 128; ++k) { const float w = W[(size_t)k * N + ncol + lane]; s1 += bfround(gk[k] * w); s2 += bk[k] * w; }
            float* cv = c.f32(OFF_C12);
            atomicAdd(cv + c1o + ncol + lane, s1); atomicAdd(cv + c2o + ncol + lane, s2);
            continue;
        }
        r -= T_C12;
        if (r < T_TR) {
            int mi = 0;
#pragma unroll
            for (int i = 0; i < 18; ++i) { if (mi == i && r >= TR_COUNT[i]) { r -= TR_COUNT[i]; mi = i + 1; } }
            const MatDesc d = get_mat(c, mi);
            transpose_item(d.W, d.K, d.N, d.WT, d.row_off, d.gk, scr, r, lane);
            continue;
        }
        r -= T_TR;
        if (r < T_ZP) {
            u32x4* dst = (u32x4*)(c.b16(OFF_WIN0) + (size_t)(EVEN_IN + r) * 1024); dst[lane] = (u32x4){0, 0, 0, 0}; dst[64 + lane] = (u32x4){0, 0, 0, 0};
            continue;
        }
        r -= T_ZP;
        if (r < T_XB) {
            const int row = r; u32x2* dst = (u32x2*)(c.b16(OFF_XB) + (size_t)row * DM);
            const float* src = row < MR ? c.in[0] + (size_t)row * DM : (row < MR + NMETA ? c.in[1] + (size_t)(row - MR) * DM : nullptr);
#pragma unroll
            for (int j = 0; j < 4; ++j) { const f32x4 v = src ? *(const f32x4*)(src + 256 * j + 4 * lane) : (f32x4){0.f, 0.f, 0.f, 0.f}; dst[64 * j + lane] = pk4(v); }
            continue;
        }
        r -= T_XB;
        if (r < T_ROPE) {
            const int e = r * 64 + lane;
            if (e < TT * 144) {
                const int pos = e / 144, j = e % 144; float cs, sn;
                if (j < 16) { sincos_d((double)pos * p.inv0[j], cs, sn); c.f32(OFF_ROPE0C)[pos * 16 + j] = cs; c.f32(OFF_ROPE0S)[pos * 16 + j] = sn; }
                else { sincos_d((double)pos * p.inv1[j - 16], cs, sn); c.f32(OFF_ROPE1C)[pos * 128 + j - 16] = cs; c.f32(OFF_ROPE1S)[pos * 128 + j - 16] = sn; }
            }
            continue;
        }
        r -= T_ROPE;
        { const int ch = r * 64 + lane; const float lam = c.in[9][ch]; c.f32(OFF_CCH)[ch] = -8.f * log1pf(__expf(-lam)); }
    }
}

__device__ __forceinline__ void phase_conv(const Ctx& c, int bid, int nb) {
    const int tid = opaque_tid(), wid = tid >> 6, lane = tid & 63;
    const bf16_t* p0 = c.b16(OFF_P0); bf16_t* xc = c.b16(OFF_XC); bf16_t* Kb = c.b16(OFF_K);
    const float* cw = c.in[3]; const float* cb = c.in[4];
    const int ch0 = lane * 8;
    for (int row = bid * NWV + wid; row < MP; row += nb * NWV) {
        float acc[8];
#pragma unroll
        for (int e = 0; e < 8; ++e) acc[e] = cb[ch0 + e];
#pragma unroll
        for (int w = 0; w < 4; ++w) {
            const int d = 3 - w; int srow = -1;
            if (row < MR) { const int sp = (row & (SEQ - 1)) - d; srow = sp >= 0 ? row - d : MR + NMETA + sp; }
            else if (row < MR + NMETA) { srow = (row - MR - d) >= 0 ? row - d : -1; }
            if (srow >= 0) {
                const u32x4 x = *(const u32x4*)(p0 + (size_t)srow * N_IN0 + 512 + ch0);
                const f32x4 w0 = *(const f32x4*)(cw + w * 512 + ch0), w1 = *(const f32x4*)(cw + w * 512 + ch0 + 4);
                acc[0] += w0[0] * bf2f(x.x & 0xffffu); acc[1] += w0[1] * bf2f(x.x >> 16); acc[2] += w0[2] * bf2f(x.y & 0xffffu); acc[3] += w0[3] * bf2f(x.y >> 16);
                acc[4] += w1[0] * bf2f(x.z & 0xffffu); acc[5] += w1[1] * bf2f(x.z >> 16); acc[6] += w1[2] * bf2f(x.w & 0xffffu); acc[7] += w1[3] * bf2f(x.w >> 16);
            }
        }
        if (row >= MR + NMETA) {
#pragma unroll
            for (int e = 0; e < 8; ++e) acc[e] = 0.f;
        }
        u32x4 o; o.x = pk2(acc[0], acc[1]); o.y = pk2(acc[2], acc[3]); o.z = pk2(acc[4], acc[5]); o.w = pk2(acc[6], acc[7]);
        *(u32x4*)(xc + (size_t)row * LRUW + ch0) = o;
        const int h = lane >> 3, d0 = (lane & 7) * 4, jj = d0 & 15; u32x2 ko = (u32x2){0u, 0u};
        if (row < MR + NMETA) {
            const int pos = row_pos(row);
            const f32x4 x1 = unpk4(*(const u32x2*)(p0 + (size_t)row * N_IN0 + 1408 + jj)), x2 = unpk4(*(const u32x2*)(p0 + (size_t)row * N_IN0 + 1424 + jj));
            const f32x4 cs = *(const f32x4*)(c.f32(OFF_ROPE0C) + pos * 16 + jj), sn = *(const f32x4*)(c.f32(OFF_ROPE0S) + pos * 16 + jj);
            ko = pk4(d0 < 16 ? x1 * cs - x2 * sn : x1 * sn + x2 * cs);
        }
        *(u32x2*)(Kb + (size_t)row * NQ + h * QKD + 64 + d0) = ko;
    }
}

__device__ __forceinline__ float meta_state(const Ctx& c, int ch) {
    float h = 0.f; const float* a = c.f32(OFF_ABMETA) + ch; const float* b = a + 256 * LRUW;
#pragma unroll
    for (int i = 0; i < NMETA; ++i) h = a[i * LRUW] * h + b[i * LRUW];
    return h;
}
__device__ __forceinline__ void phase_scan1(const Ctx& c, int bid, int nb) {
    const int tid = opaque_tid(), wid = tid >> 6, lane = tid & 63;
    for (int it = bid * NWV + wid; it < 2048; it += nb * NWV) {
        const int chg = it & 7, ck = (it >> 3) & 15, b = it >> 7, ch = chg * 64 + lane, row0 = b * SEQ + ck * 128;
        const float* a = c.out + (size_t)row0 * LRUW + ch; const float* bb = a + (size_t)MR * LRUW;
        float P = 1.f, S = 0.f;
#pragma unroll 8
        for (int t = 0; t < 128; ++t) { const float av = a[(size_t)t * LRUW], bv = bb[(size_t)t * LRUW]; S = av * S + bv; P *= av; }
        *(f32x2*)(c.f32(OFF_CARRY) + ((size_t)(b * 16 + ck) * LRUW + ch) * 2) = (f32x2){P, S};
    }
}
__device__ __forceinline__ void phase_scan2(const Ctx& c, int bid, int nb) {
    const int tid = opaque_tid(), wid = tid >> 6, lane = tid & 63;
    const bf16_t* p0 = c.b16(OFF_P0); bf16_t* mix = c.b16(OFF_MIX);
    for (int it = bid * NWV + wid; it < 2048 + 8; it += nb * NWV) {
        if (it >= 2048) {
            const int ch = (it - 2048) * 64 + lane; float h = 0.f;
            const float* a = c.f32(OFF_ABMETA) + ch; const float* bb = a + 256 * LRUW;
            for (int i = 0; i < NMETA; ++i) { h = a[i * LRUW] * h + bb[i * LRUW]; const int row = MR + i;
                const float gt = bf2f(p0[(size_t)row * N_IN0 + ch]); mix[(size_t)row * DM + ch] = (bf16_t)(pk2(h * gelu_tanh(gt), 0.f) & 0xffffu); }
            continue;
        }
        const int chg = it & 7, ck = (it >> 3) & 15, b = it >> 7, ch = chg * 64 + lane, row0 = b * SEQ + ck * 128;
        float h = meta_state(c, ch);
        const float* cr = c.f32(OFF_CARRY) + ((size_t)(b * 16) * LRUW + ch) * 2;
        for (int k = 0; k < ck; ++k) { const f32x2 ps = *(const f32x2*)(cr + (size_t)k * LRUW * 2); h = ps.x * h + ps.y; }
        const float* a = c.out + (size_t)row0 * LRUW + ch; const float* bb = a + (size_t)MR * LRUW;
#pragma unroll 8
        for (int t = 0; t < 128; ++t) {
            h = a[(size_t)t * LRUW] * h + bb[(size_t)t * LRUW];
            const int row = row0 + t; const float gt = bf2f(p0[(size_t)row * N_IN0 + ch]);
            mix[(size_t)row * DM + ch] = (bf16_t)(pk2(h * gelu_tanh(gt), 0.f) & 0xffffu);
        }
    }
}

__device__ __forceinline__ void phase_attn_naive(const Ctx& c, int bid, int nb) {
    const int tid = opaque_tid(), wid = tid >> 6, lane = tid & 63;
    const bf16_t* Q = c.b16(OFF_Q); const bf16_t* K = c.b16(OFF_K); const bf16_t* V = c.b16(OFF_V); bf16_t* mix = c.b16(OFF_MIX);
    const long nitems = (long)NBATCH * MLA_H * SEQ + MLA_H * NMETA;
    for (long it = (long)bid * NWV + wid; it < nitems; it += (long)nb * NWV) {
        int b, h, s, qrow;
        if (it < (long)NBATCH * MLA_H * SEQ) { s = (int)(it & (SEQ - 1)); h = (int)((it >> 11) & 7); b = (int)(it >> 14); qrow = b * SEQ + s; }
        else { const int r = (int)(it - (long)NBATCH * MLA_H * SEQ); s = r & 15; h = r >> 4; b = -1; qrow = MR + s; }
        float q[QKD];
#pragma unroll
        for (int j = 0; j < QKD / 8; ++j) { const u32x4 w = *(const u32x4*)(Q + (size_t)qrow * NQ + h * QKD + 8 * j);
            q[8 * j] = bf2f(w.x & 0xffffu); q[8 * j + 1] = bf2f(w.x >> 16); q[8 * j + 2] = bf2f(w.y & 0xffffu); q[8 * j + 3] = bf2f(w.y >> 16);
            q[8 * j + 4] = bf2f(w.z & 0xffffu); q[8 * j + 5] = bf2f(w.z >> 16); q[8 * j + 6] = bf2f(w.w & 0xffffu); q[8 * j + 7] = bf2f(w.w >> 16); }
        float m = -1e30f, l = 0.f, o = 0.f;
        const int ntile = b < 0 ? 1 : 2 + (s >> 6);
        for (int t = 0; t < ntile; ++t) {
            int krow0, nvalid;
            if (t == 0) { krow0 = MR; nvalid = b < 0 ? s + 1 : NMETA; } else { krow0 = b * SEQ + 64 * (t - 1); nvalid = min(64, s + 1 - 64 * (t - 1)); }
            const bool valid = lane < nvalid;
            float sv = 0.f;
            { const bf16_t* kp = K + (size_t)(krow0 + lane) * NQ + h * QKD;
#pragma unroll
              for (int j = 0; j < QKD / 8; ++j) { const u32x4 w = *(const u32x4*)(kp + 8 * j);
                sv += q[8 * j] * bf2f(w.x & 0xffffu) + q[8 * j + 1] * bf2f(w.x >> 16) + q[8 * j + 2] * bf2f(w.y & 0xffffu) + q[8 * j + 3] * bf2f(w.y >> 16)
                    + q[8 * j + 4] * bf2f(w.z & 0xffffu) + q[8 * j + 5] * bf2f(w.z >> 16) + q[8 * j + 6] * bf2f(w.w & 0xffffu) + q[8 * j + 7] * bf2f(w.w >> 16); } }
            if (!valid) sv = -1e30f;
            const float mn = fmaxf(m, wave_max(sv)), f = exp2f(m - mn), pv = valid ? exp2f(sv - mn) : 0.f;
            l = l * f + wave_sum(pv); o *= f; m = mn;
            for (int k = 0; k < nvalid; ++k) { const float pk = __shfl(pv, k); o += pk * bf2f(V[(size_t)(krow0 + k) * NV + h * VD + lane]); }
        }
        mix[(size_t)qrow * DM + 512 + h * VD + lane] = (bf16_t)(pk2(o / l, 0.f) & 0xffffu);
    }
}

__device__ __forceinline__ void phase_ret_naive(const Ctx& c, LAS unsigned char* lds, int bid, int nb) {
    const int tid = opaque_tid(), wid = tid >> 6, lane = tid & 63;
    const bf16_t* Q1 = c.b16(OFF_Q1); const bf16_t* K1 = c.b16(OFF_K1); const bf16_t* V1 = c.b16(OFF_V1); bf16_t* G1 = c.b16(OFF_G1);
    LAS float* qs = (LAS float*)(lds + wid * 1024);
    const long nitems = (long)NBATCH * RET_H * SEQ;
    for (long it = (long)bid * NWV + wid; it < nitems; it += (long)nb * NWV) {
        const int s = (int)(it & (SEQ - 1)), h = (int)((it >> 11) & 3), b = (int)(it >> 13), qrow = b * SEQ + s;
        { const u32x2 w = *(const u32x2*)(Q1 + (size_t)qrow * 1024 + h * RDK + 4 * lane); const f32x4 f = unpk4(w); qs[4 * lane] = f[0]; qs[4 * lane + 1] = f[1]; qs[4 * lane + 2] = f[2]; qs[4 * lane + 3] = f[3]; }
        asm volatile("s_waitcnt lgkmcnt(0)" ::: "memory");
        const float lg2 = log2f(1.f - exp2f(-5.f - (float)h));
        float o[8];
#pragma unroll
        for (int e = 0; e < 8; ++e) o[e] = 0.f;
        const int ntile = 2 + (s >> 6), qpos = NMETA + s;
        for (int t = 0; t < ntile; ++t) {
            int krow0, nvalid, kpos0;
            if (t == 0) { krow0 = MR; nvalid = NMETA; kpos0 = 0; } else { krow0 = b * SEQ + 64 * (t - 1); nvalid = min(64, s + 1 - 64 * (t - 1)); kpos0 = NMETA + 64 * (t - 1); }
            float sv = 0.f;
            { const bf16_t* kp = K1 + (size_t)(krow0 + lane) * 1024 + h * RDK;
#pragma unroll 4
              for (int j = 0; j < RDK / 8; ++j) { const u32x4 w = *(const u32x4*)(kp + 8 * j); const LAS float* qq = qs + 8 * j;
                sv += qq[0] * bf2f(w.x & 0xffffu) + qq[1] * bf2f(w.x >> 16) + qq[2] * bf2f(w.y & 0xffffu) + qq[3] * bf2f(w.y >> 16)
                    + qq[4] * bf2f(w.z & 0xffffu) + qq[5] * bf2f(w.z >> 16) + qq[6] * bf2f(w.w & 0xffffu) + qq[7] * bf2f(w.w >> 16); } }
            const float wv = lane < nvalid ? sv * exp2f(lg2 * (float)(qpos - kpos0 - lane)) : 0.f;
            for (int k = 0; k < nvalid; ++k) { const float wk = __shfl(wv, k); const u32x4 w = *(const u32x4*)(V1 + (size_t)(krow0 + k) * RMIX + h * RDV + 8 * lane);
                o[0] += wk * bf2f(w.x & 0xffffu); o[1] += wk * bf2f(w.x >> 16); o[2] += wk * bf2f(w.y & 0xffffu); o[3] += wk * bf2f(w.y >> 16);
                o[4] += wk * bf2f(w.z & 0xffffu); o[5] += wk * bf2f(w.z >> 16); o[6] += wk * bf2f(w.w & 0xffffu); o[7] += wk * bf2f(w.w >> 16); }
        }
        float ss = 0.f;
#pragma unroll
        for (int e = 0; e < 8; ++e) ss += o[e] * o[e];
        const float rstd = rsqrtf(wave_sum(ss) * (1.f / RDV) + LN_EPS);
        bf16_t* gp = G1 + (size_t)qrow * RMIX + h * RDV + 8 * lane; const u32x4 gw = *(const u32x4*)gp;
        u32x4 r; r.x = pk2(bf2f(gw.x & 0xffffu) * o[0] * rstd, bf2f(gw.x >> 16) * o[1] * rstd); r.y = pk2(bf2f(gw.y & 0xffffu) * o[2] * rstd, bf2f(gw.y >> 16) * o[3] * rstd);
        r.z = pk2(bf2f(gw.z & 0xffffu) * o[4] * rstd, bf2f(gw.z >> 16) * o[5] * rstd); r.w = pk2(bf2f(gw.w & 0xffffu) * o[6] * rstd, bf2f(gw.w >> 16) * o[7] * rstd);
        *(u32x4*)gp = r;
    }
}

__device__ __forceinline__ void phase_final(const Ctx& c, int bid, int nb) {
    const int tid = opaque_tid(), wid = tid >> 6, lane = tid & 63;
    const float* g = c.in[21] + 1024; const float* bv = c.in[22] + 1024;
    for (int row = bid * NWV + wid; row < MR; row += nb * NWV) {
        f32x4* zr = (f32x4*)(c.out + (size_t)row * DM) + lane;
        f32x4 v[4]; float s = 0.f;
#pragma unroll
        for (int j = 0; j < 4; ++j) { v[j] = zr[64 * j]; s += (v[j][0] + v[j][1]) + (v[j][2] + v[j][3]); }
        const float mean = wave_sum(s) * (1.f / DM); float s2 = 0.f;
#pragma unroll
        for (int j = 0; j < 4; ++j) { v[j] = v[j] - mean; s2 += (v[j][0] * v[j][0] + v[j][1] * v[j][1]) + (v[j][2] * v[j][2] + v[j][3] * v[j][3]); }
        const float rstd = rsqrtf(wave_sum(s2) * (1.f / DM) + LN_EPS);
#pragma unroll
        for (int j = 0; j < 4; ++j) zr[64 * j] = v[j] * rstd * *(const f32x4*)(g + 256 * j + 4 * lane) + *(const f32x4*)(bv + 256 * j + 4 * lane);
    }
}

enum { PH_PRO = 0, PH_IN0, PH_PREP, PH_GATE, PH_ATTN, PH_SCAN2, PH_OUT0, PH_UP0, PH_DOWN0, PH_IN1, PH_RET, PH_OUT1, PH_UP1, PH_DOWN1, PH_FINAL, NPH };
constexpr int LDS_BYTES = 147456;

__device__ __forceinline__ void run_phase(int ph, const Ctx& c, const Params& p, LAS unsigned char* lds, int bid, int nb) {
    const float* stA = c.f32(OFF_STATA); const float* stB = c.f32(OFF_STATB); const float* cv = c.f32(OFF_C12);
    switch (ph) {
    case PH_PRO: phase_prologue(c, p, lds, bid, nb); break;
    case PH_IN0: {
        Gemm g{c.b16(OFF_XB), c.b16(OFF_WIN0), MP, N_IN0, 1024, 1024, 1024, 0};
        EpiIn0 e{c.b16(OFF_P0), c.f32(OFF_SSQQ), c.f32(OFF_SSQKV)};
        run_gemm(lds, g, e, bid, nb);
    } break;
    case PH_PREP: {
        phase_conv(c, bid, nb);
        { Gemm g{c.b16(OFF_P0) + 1024, c.b16(OFF_WUQ), MP, NQ, QRANK, N_IN0, QRANK, 0};
          EpiQup e{c.b16(OFF_Q), c.f32(OFF_SSQQ), c.f32(OFF_ROPE0C), c.f32(OFF_ROPE0S)}; run_gemm(lds, g, e, bid, nb); }
        { Gemm g{c.b16(OFF_P0) + 1280, c.b16(OFF_WUKV), MP, 1024, KVRANK, N_IN0, KVRANK, 0};
          EpiKVup e{c.b16(OFF_K), c.b16(OFF_V), c.f32(OFF_SSQKV)}; run_gemm(lds, g, e, bid, nb); }
    } break;
    case PH_GATE: {
        Gemm g{c.b16(OFF_XC), c.b16(OFF_WGATE), MP, 1024, 128, LRUW, 128, 128};
        EpiGate e{c, c.b16(OFF_XC), c.f32(OFF_CCH), c.in[6], c.in[8]};
        run_gemm(lds, g, e, bid, nb);
    } break;
    case PH_ATTN: phase_scan1(c, bid, nb); phase_attn_naive(c, bid, nb); break;
    case PH_SCAN2: phase_scan2(c, bid, nb); break;
    case PH_OUT0: {
        Gemm g{c.b16(OFF_MIX), c.b16(OFF_WOUT0), MP, 1024, 1024, 1024, 1024, 0};
        EpiRes<0, false> e{c, c.b16(OFF_ZB), nullptr, c.f32(OFF_STATA), nullptr, nullptr, c.in[0], c.in[1]};
        run_gemm(lds, g, e, bid, nb);
    } break;
    case PH_UP0: {
        Gemm g{c.b16(OFF_ZB), c.b16(OFF_W1_0), MP, FF, 1024, 1024, 1024, 0};
        EpiMlpUp e{c.b16(OFF_HID), stA, cv + C1_UP0, cv + C2_UP0};
        run_gemm(lds, g, e, bid, nb);
    } break;
    case PH_DOWN0: {
        Gemm g{c.b16(OFF_HID), c.b16(OFF_W2_0), MP, 1024, FF, FF, FF, 0};
        EpiRes<1, false> e{c, c.b16(OFF_ZB), stA, c.f32(OFF_STATB), c.in[17], c.in[18], nullptr, nullptr};
        run_gemm(lds, g, e, bid, nb);
    } break;
    case PH_IN1: {
        Gemm g{c.b16(OFF_ZB), c.b16(OFF_WIN1), MP, N_IN1, 1024, 1024, 1024, 0};
        EpiIn1 e{c.b16(OFF_Q1), c.b16(OFF_K1), c.b16(OFF_V1), c.b16(OFF_G1), stB, cv + C1_IN1, cv + C2_IN1, c.f32(OFF_ROPE1C), c.f32(OFF_ROPE1S)};
        run_gemm(lds, g, e, bid, nb);
    } break;
    case PH_RET: phase_ret_naive(c, lds, bid, nb); break;
    case PH_OUT1: {
        Gemm g{c.b16(OFF_G1), c.b16(OFF_WOUT1), MP, 1024, RMIX, RMIX, RMIX, 0};
        EpiRes<1, false> e{c, c.b16(OFF_ZB), stB, c.f32(OFF_STATA), c.in[21], c.in[22], nullptr, nullptr};
        run_gemm(lds, g, e, bid, nb);
    } break;
    case PH_UP1: {
        Gemm g{c.b16(OFF_ZB), c.b16(OFF_W1_1), MP, FF, 1024, 1024, 1024, 0};
        EpiMlpUp e{c.b16(OFF_HID), stA, cv + C1_UP1, cv + C2_UP1};
        run_gemm(lds, g, e, bid, nb);
    } break;
    case PH_DOWN1: {
        Gemm g{c.b16(OFF_HID), c.b16(OFF_W2_1), MP, 1024, FF, FF, FF, 0};
        EpiRes<1, true> e{c, c.b16(OFF_ZB), stA, nullptr, c.in[17] + 1024, c.in[18] + 1024, nullptr, nullptr};
        run_gemm(lds, g, e, bid, nb);
    } break;
    case PH_FINAL: phase_final(c, bid, nb); break;
    default: break;
    }
}

#if N_LAUNCH_MODE == 1
__global__ void __launch_bounds__(512, 2) k_fwd(Params p) {
    extern __shared__ __attribute__((aligned(16))) unsigned char lds_raw[];
    LAS unsigned char* lds = (LAS unsigned char*)lds_raw;
    Ctx c{p.in, p.out, p.ws};
    const int bid = blockIdx.x, nb = gridDim.x;
    const int lo = (int)p.ph_lo, hi = (int)p.ph_hi;
#define PHASE(k) if (lo <= (k) && (k) < hi) { run_phase((k), c, p, lds, bid, nb); if ((k) + 1 < hi) cg::this_grid().sync(); }
    PHASE(0) PHASE(1) PHASE(2) PHASE(3) PHASE(4) PHASE(5) PHASE(6) PHASE(7) PHASE(8) PHASE(9) PHASE(10) PHASE(11) PHASE(12) PHASE(13) PHASE(14)
#undef PHASE
}
#else
template <int PH> __global__ void __launch_bounds__(512, 2) k_one(Params p) {
    extern __shared__ __attribute__((aligned(16))) unsigned char lds_raw[];
    LAS unsigned char* lds = (LAS unsigned char*)lds_raw;
    Ctx c{p.in, p.out, p.ws};
    run_phase(PH, c, p, lds, blockIdx.x, gridDim.x);
}
template <int PH> static void launch_one(int grid, const Params& p, hipStream_t stream) {
    static bool attr = false;
    if (!attr) { (void)hipFuncSetAttribute((const void*)k_one<PH>, hipFuncAttributeMaxDynamicSharedMemorySize, LDS_BYTES); attr = true; }
    hipLaunchKernelGGL(k_one<PH>, dim3(grid), dim3(512), LDS_BYTES, stream, p);
}
#endif

extern "C" void kernel_launch(void* const* d_in, const int* in_sizes, int n_in, void* d_out, int out_size, void* d_ws, size_t ws_size, hipStream_t stream) {
    static int grid = 0;
    if (grid == 0) {
        int dev = 0, cus = 0;
        if (hipGetDevice(&dev) != hipSuccess || hipDeviceGetAttribute(&cus, hipDeviceAttributeMultiprocessorCount, dev) != hipSuccess) { grid = -1; return; }
#if N_LAUNCH_MODE == 1
        if (hipFuncSetAttribute((const void*)k_fwd, hipFuncAttributeMaxDynamicSharedMemorySize, LDS_BYTES) != hipSuccess) { grid = -1; return; }
        int per_cu = 0;
        if (hipOccupancyMaxActiveBlocksPerMultiprocessor(&per_cu, (const void*)k_fwd, 512, LDS_BYTES) != hipSuccess || per_cu < 1) { fprintf(stderr, "occupancy query: %d\n", per_cu); }
        (void)hipGetLastError();
#endif
        grid = cus;
        if (n_in != 23 || ws_size < WS_END) { fprintf(stderr, "kernel_launch: unexpected n_in %d / ws %zu\n", n_in, ws_size); grid = -1; return; }
    }
    if (grid < 0) return;
    (void)hipMemsetAsync((char*)d_ws + OFF_CTL, 0, SZ_CTL, stream);
    (void)hipMemsetAsync((char*)d_ws + OFF_C12, 0, 128 * KB, stream);
    Params p{};
    for (int i = 0; i < 23; ++i) p.in[i] = (const float*)d_in[i];
    p.out = (float*)d_out; p.ws = (unsigned char*)d_ws;
    for (int j = 0; j < 16; ++j) p.inv0[j] = pow(10000.0, -(double)j / 16.0);
    for (int j = 0; j < 128; ++j) p.inv1[j] = pow(10000.0, -(double)j / 128.0);
#if N_LAUNCH_MODE == 1
    p.ph_lo = 0; p.ph_hi = NPH;
    void* args[] = {&p};
    hipError_t e = hipLaunchCooperativeKernel((const void*)k_fwd, dim3(grid), dim3(512), args, LDS_BYTES, stream);
    if (e != hipSuccess) fprintf(stderr, "cooperative launch failed: %s (grid %d)\n", hipGetErrorString(e), grid);
#else
    launch_one<0>(grid, p, stream); launch_one<1>(grid, p, stream); launch_one<2>(grid, p, stream); launch_one<3>(grid, p, stream); launch_one<4>(grid, p, stream);
    launch_one<5>(grid, p, stream); launch_one<6>(grid, p, stream); launch_one<7>(grid, p, stream); launch_one<8>(grid, p, stream); launch_one<9>(grid, p, stream);
    launch_one<10>(grid, p, stream); launch_one<11>(grid, p, stream); launch_one<12>(grid, p, stream); launch_one<13>(grid, p, stream); launch_one<14>(grid, p, stream);
#endif
}
```

```cpp
#include <hip/hip_runtime.h>
#include <hip/hip_cooperative_groups.h>
#include <stdint.h>
#include <stdio.h>
namespace cg = cooperative_groups;

#ifndef FAST_GEMM
#define FAST_GEMM 1
#endif
#ifndef FAST_ATTN
#define FAST_ATTN 1
#endif
#ifndef FAST_RET
#define FAST_RET 1
#endif
#ifndef N_LAUNCH_MODE
#define N_LAUNCH_MODE 1
#endif

#define LAS __attribute__((address_space(3)))
typedef unsigned short bf16_t;
typedef short bf16x8 __attribute__((ext_vector_type(8)));
typedef float f32x4 __attribute__((ext_vector_type(4)));
typedef float f32x2 __attribute__((ext_vector_type(2)));
typedef unsigned u32x4 __attribute__((ext_vector_type(4)));
typedef unsigned u32x2 __attribute__((ext_vector_type(2)));
typedef __bf16 bf16x2_t __attribute__((ext_vector_type(2)));

constexpr int DM = 1024, NBATCH = 16, SEQ = 2048, NMETA = 16, TT = SEQ + NMETA;
constexpr int MR = NBATCH * SEQ;
constexpr int MP = MR + 256;
constexpr int LRUW = 512, EVEN_IN = 1440, N_IN0 = 1536, QRANK = 256, KVRANK = 128;
constexpr int MLA_H = 8, QKD = 96, VD = 64, NQ = MLA_H * QKD  , NV = MLA_H * VD  ;
constexpr int FF = 4096, N_IN1 = 6144, RET_H = 4, RDK = 256, RDV = 512, RMIX = 2048;
constexpr float LN_EPS = 1e-5f;
constexpr float DN_ALPHA = 1.41421356237309515f;
constexpr float QSCALE = 0.10206207261596575f * 1.4426950408889634f;

constexpr size_t KB = 1024, MB = 1024 * 1024;
constexpr size_t OFF_CTL = 0;
constexpr size_t SZ_CTL = 64 * KB;
constexpr size_t OFF_ROPE0C = OFF_CTL + SZ_CTL;
constexpr size_t OFF_ROPE0S = OFF_ROPE0C + 132 * KB;
constexpr size_t OFF_ROPE1C = OFF_ROPE0S + 132 * KB;
constexpr size_t OFF_ROPE1S = OFF_ROPE1C + 1056 * KB;
constexpr size_t OFF_CCH = OFF_ROPE1S + 1056 * KB;
constexpr size_t OFF_C12 = OFF_CCH + 4 * KB;
constexpr size_t OFF_SSQQ = OFF_C12 + 128 * KB;
constexpr size_t OFF_SSQKV = OFF_SSQQ + 528 * KB;
constexpr size_t OFF_STATA = OFF_SSQKV + 528 * KB;
constexpr size_t OFF_STATB = OFF_STATA + (size_t)MP * 128;
constexpr size_t OFF_ZMETA = OFF_STATB + (size_t)MP * 128;
constexpr size_t OFF_ABMETA = OFF_ZMETA + MB;
constexpr size_t OFF_CARRY = OFF_ABMETA + MB;
constexpr size_t OFF_W = 18 * MB;
static_assert(OFF_CARRY + MB <= OFF_W, "small buffers");
constexpr size_t OFF_WIN1 = OFF_W;
constexpr size_t OFF_WOUT1 = OFF_WIN1 + (size_t)6144 * 1024 * 2;
constexpr size_t OFF_W1_1 = OFF_WOUT1 + (size_t)2048 * 1024 * 2;
constexpr size_t OFF_W2_1 = OFF_W1_1 + (size_t)4096 * 1024 * 2;
constexpr size_t OFF_BIG = 50 * MB;
static_assert(OFF_W2_1 + (size_t)4096 * 1024 * 2 <= OFF_BIG, "weights");
constexpr size_t SZ_ROW1K = (size_t)MP * 1024 * 2;
constexpr size_t OFF_XB = OFF_BIG;
constexpr size_t OFF_MIX = OFF_XB;
constexpr size_t OFF_P0 = OFF_XB + SZ_ROW1K;
constexpr size_t OFF_XC = OFF_P0 + (size_t)MP * 1536 * 2;
constexpr size_t OFF_Q = OFF_XC + (size_t)MP * 512 * 2;
constexpr size_t OFF_K = OFF_Q + (size_t)MP * 768 * 2;
constexpr size_t OFF_V = OFF_K + (size_t)MP * 768 * 2;
constexpr size_t OFF_HID = OFF_BIG;
constexpr size_t OFF_Q1 = OFF_BIG;
constexpr size_t OFF_K1 = OFF_Q1 + SZ_ROW1K;
constexpr size_t OFF_V1 = OFF_K1 + SZ_ROW1K;
constexpr size_t OFF_G1 = OFF_V1 + 2 * SZ_ROW1K;
constexpr size_t OFF_W0 = 415 * MB;
constexpr size_t OFF_WIN0 = OFF_W0;
constexpr size_t OFF_WGATE = OFF_WIN0 + (size_t)N_IN0 * 1024 * 2;
constexpr size_t OFF_WUQ = OFF_WGATE + 1024 * 128 * 2;
constexpr size_t OFF_WUKV = OFF_WUQ + 768 * 256 * 2;
constexpr size_t OFF_WOUT0 = OFF_WUKV + 1024 * 128 * 2;
constexpr size_t OFF_W1_0 = OFF_WOUT0 + 1024 * 1024 * 2;
constexpr size_t OFF_W2_0 = OFF_W1_0 + (size_t)4096 * 1024 * 2;
constexpr size_t OFF_ZB = 438 * MB;
constexpr size_t OFF_OSQ = OFF_ZB;
constexpr size_t WS_END = 504 * MB;
static_assert(OFF_V + (size_t)MP * 512 * 2 <= OFF_W0 && OFF_HID + (size_t)MP * 4096 * 2 <= OFF_W0 && OFF_G1 + 2 * SZ_ROW1K <= OFF_ZB && OFF_W2_0 + (size_t)4096 * 1024 * 2 <= OFF_ZB && OFF_ZB + SZ_ROW1K <= WS_END, "ws map");

struct Params { const float* in[23]; float* out; unsigned char* ws; long long ph_lo, ph_hi; double inv0[16]; double inv1[128]; };

__device__ __forceinline__ int opaque_tid() { int t = threadIdx.x; asm volatile("" : "+v"(t)); return t; }
__device__ __forceinline__ float bf2f(unsigned v) { return __uint_as_float(v << 16); }
__device__ __forceinline__ unsigned pk2(float lo, float hi) { f32x2 v = {lo, hi}; bf16x2_t b = __builtin_convertvector(v, bf16x2_t); return __builtin_bit_cast(unsigned, b); }
__device__ __forceinline__ u32x2 pk4(f32x4 v) { u32x2 r; r.x = pk2(v[0], v[1]); r.y = pk2(v[2], v[3]); return r; }
__device__ __forceinline__ f32x4 unpk4(u32x2 w) { return (f32x4){bf2f(w.x & 0xffffu), bf2f(w.x >> 16), bf2f(w.y & 0xffffu), bf2f(w.y >> 16)}; }
__device__ __forceinline__ float bfround(float x) { return bf2f(pk2(x, 0.f) & 0xffffu); }
__device__ __forceinline__ float wave_sum(float v) {
#pragma unroll
    for (int o = 1; o < 64; o <<= 1) v += __shfl_xor(v, o);
    return v;
}
__device__ __forceinline__ float wave_max(float v) {
#pragma unroll
    for (int o = 1; o < 64; o <<= 1) v = fmaxf(v, __shfl_xor(v, o));
    return v;
}
__device__ __forceinline__ float sigmoidf_(float x) { return 1.f / (1.f + __expf(-x)); }
__device__ __forceinline__ float gelu_tanh(float x) { const float u = 0.7978845608028654f * (x + 0.044715f * x * x * x); const float t = 1.f - 2.f / (1.f + __expf(2.f * u)); return 0.5f * x * (1.f + t); }
__device__ __forceinline__ int row_pos(int row) { return row < MR ? NMETA + (row & (SEQ - 1)) : (row - MR); }

struct Ctx {
    const float* const* in; float* out; unsigned char* ws;
    __device__ __forceinline__ bf16_t* b16(size_t off) const { return (bf16_t*)(ws + off); }
    __device__ __forceinline__ float* f32(size_t off) const { return (float*)(ws + off); }
    __device__ __forceinline__ float* zrow(int row) const { return row < MR ? out + (size_t)row * DM : f32(OFF_ZMETA) + (size_t)(row - MR) * DM; }
    __device__ __forceinline__ float* arow(int row) const { return row < MR ? out + (size_t)row * LRUW : f32(OFF_ABMETA) + (size_t)(row - MR) * LRUW; }
    __device__ __forceinline__ float* brow(int row) const { return row < MR ? out + (size_t)MR * LRUW + (size_t)row * LRUW : f32(OFF_ABMETA) + 256 * LRUW + (size_t)(row - MR) * LRUW; }
};

struct Gemm { const bf16_t* A; const bf16_t* Bt; int M, N, K, lda, ldb, a_pn_off; };

__device__ __forceinline__ void row_stats(const float* st, int row, int fq, float& mean, float& rstd) {
    const f32x4* p = (const f32x4*)(st + (size_t)row * 32 + fq * 8);
    const f32x4 a = p[0], b = p[1];
    float s1 = a[0] + a[2] + b[0] + b[2], s2 = a[1] + a[3] + b[1] + b[3];
    s1 += __shfl_xor(s1, 16); s2 += __shfl_xor(s2, 16); s1 += __shfl_xor(s1, 32); s2 += __shfl_xor(s2, 32);
    mean = s1 * (1.f / DM); const float var = fmaxf(s2 * (1.f / DM) - mean * mean, 0.f); rstd = rsqrtf(var + LN_EPS);
}
__device__ __forceinline__ void put_stats(float* st, int row, int pn, int q0, const f32x4 (&v)[2][2]) {
    float s1 = 0.f, s2 = 0.f;
#pragma unroll
    for (int bj = 0; bj < 2; ++bj)
#pragma unroll
        for (int n = 0; n < 2; ++n)
#pragma unroll
            for (int e = 0; e < 4; ++e) { s1 += v[bj][n][e]; s2 += v[bj][n][e] * v[bj][n][e]; }
    s1 += __shfl_xor(s1, 16); s2 += __shfl_xor(s2, 16); s1 += __shfl_xor(s1, 32); s2 += __shfl_xor(s2, 32);
    if (((q0 >> 2) & 7) == 0) *(f32x2*)(st + (size_t)row * 32 + (pn * 4 + (q0 >> 5)) * 2) = (f32x2){s1, s2};
}

struct EpiIn0 {
    bf16_t* p0; float* ssq_q; float* ssq_kv;
    __device__ __forceinline__ void apply(int row, int pn, int q0, f32x4 (&v)[2][2]) const {
        bf16_t* base = p0 + (size_t)row * N_IN0 + 256 * pn + q0;
#pragma unroll
        for (int bj = 0; bj < 2; ++bj)
#pragma unroll
            for (int n = 0; n < 2; ++n) *(u32x2*)(base + 128 * bj + 16 * n) = pk4(v[bj][n]);
        if (pn == 4 || pn == 5) {
            float s = 0.f;
#pragma unroll
            for (int n = 0; n < 2; ++n)
#pragma unroll
                for (int e = 0; e < 4; ++e) { s += v[0][n][e] * v[0][n][e]; if (pn == 4) s += v[1][n][e] * v[1][n][e]; }
            s += __shfl_xor(s, 16); s += __shfl_xor(s, 32);
            if (((q0 >> 2) & 7) == 0) (pn == 4 ? ssq_q : ssq_kv)[(size_t)row * 4 + (q0 >> 5)] = s;
        }
    }
};
struct EpiQup {
    bf16_t* Q; const float* ssq_q; const float* rc; const float* rs;
    __device__ __forceinline__ void apply(int row, int pn, int q0, f32x4 (&v)[2][2]) const {
        const f32x4 sq = *(const f32x4*)(ssq_q + (size_t)row * 4);
        const float r = rsqrtf((sq[0] + sq[1] + sq[2] + sq[3]) * (1.f / QRANK) + LN_EPS) * QSCALE;
        const int fq = (q0 >> 2) & 7, wc = q0 >> 5, pos = row_pos(row);
#pragma unroll
        for (int bj = 0; bj < 2; ++bj) {
            f32x4 x1 = v[bj][0] * r, x2 = v[bj][1] * r;
            const int G = 8 * pn + 4 * bj + wc;
            if ((G % 3) == 2) {
                const f32x4 c = *(const f32x4*)(rc + pos * 16 + 4 * fq), s = *(const f32x4*)(rs + pos * 16 + 4 * fq);
                const f32x4 y1 = x1 * c - x2 * s, y2 = x1 * s + x2 * c; x1 = y1; x2 = y2;
            }
            bf16_t* base = Q + (size_t)row * NQ + 256 * pn + 128 * bj + q0;
            *(u32x2*)(base) = pk4(x1); *(u32x2*)(base + 16) = pk4(x2);
        }
    }
};
struct EpiKVup {
    bf16_t* K; bf16_t* V; const float* ssq_kv;
    __device__ __forceinline__ void apply(int row, int pn, int q0, f32x4 (&v)[2][2]) const {
        const f32x4 sq = *(const f32x4*)(ssq_kv + (size_t)row * 4);
        const float r = rsqrtf((sq[0] + sq[1] + sq[2] + sq[3]) * (1.f / KVRANK) + LN_EPS);
        const int wc = q0 >> 5;
#pragma unroll
        for (int bj = 0; bj < 2; ++bj) {
            const int head = 2 * pn + bj;
#pragma unroll
            for (int n = 0; n < 2; ++n) {
                const int within = q0 + 16 * n;
                bf16_t* dst = (wc < 2) ? K + (size_t)row * NQ + head * QKD + within : V + (size_t)row * NV + head * VD + (within - 64);
                *(u32x2*)dst = pk4(v[bj][n] * r);
            }
        }
    }
};
struct EpiGate {
    Ctx c; const bf16_t* xc; const float* cch; const float* ba; const float* bx;
    __device__ __forceinline__ void apply(int row, int pn, int q0, f32x4 (&v)[2][2]) const {
        float* ar = c.arow(row); float* br = c.brow(row);
#pragma unroll
        for (int n = 0; n < 2; ++n) {
            const int ch = 128 * pn + q0 + 16 * n;
            const f32x4 cc = *(const f32x4*)(cch + ch), va = *(const f32x4*)(ba + ch), vx = *(const f32x4*)(bx + ch);
            const f32x4 xv = unpk4(*(const u32x2*)(xc + (size_t)row * LRUW + ch));
            f32x4 oa, ob;
#pragma unroll
            for (int e = 0; e < 4; ++e) {
                const float r = sigmoidf_(v[0][n][e] + va[e]), ig = sigmoidf_(v[1][n][e] + vx[e]);
                const float la = cc[e] * r, x = 2.f * la;
                const float em = x * (1.f + x * (0.5f + x * (1.f / 6 + x * (1.f / 24 + x * (1.f / 120 + x * (1.f / 720 + x * (1.f / 5040)))))));
                oa[e] = __expf(la); ob[e] = sqrtf(fmaxf(-em, 0.f)) * (ig * xv[e]);
            }
            *(f32x4*)(ar + ch) = oa; *(f32x4*)(br + ch) = ob;
        }
    }
};
template <int MODE, bool LAST> struct EpiRes {
    Ctx c; bf16_t* zb; const float* st_in; float* st_out; const float* g; const float* b; const float* x; const float* meta;
    __device__ __forceinline__ void apply(int row, int pn, int q0, f32x4 (&v)[2][2]) const {
        float* zr = c.zrow(row);
        float mean = 0.f, rstd = 0.f;
        if (MODE == 1) row_stats(st_in, row, (q0 >> 2) & 7, mean, rstd);
#pragma unroll
        for (int bj = 0; bj < 2; ++bj)
#pragma unroll
            for (int n = 0; n < 2; ++n) {
                const int col = 256 * pn + 128 * bj + q0 + 16 * n;
                f32x4 h;
                if (MODE == 1) { const f32x4 z = *(const f32x4*)(zr + col); h = (z - mean) * rstd * *(const f32x4*)(g + col) + *(const f32x4*)(b + col); }
                else { h = row < MR ? *(const f32x4*)(x + (size_t)row * DM + col) : (row < MR + NMETA ? *(const f32x4*)(meta + (size_t)(row - MR) * DM + col) : (f32x4){0.f, 0.f, 0.f, 0.f}); }
                v[bj][n] = h * DN_ALPHA + v[bj][n];
                *(f32x4*)(zr + col) = v[bj][n];
                if (!LAST) *(u32x2*)(zb + (size_t)row * DM + col) = pk4(v[bj][n]);
            }
        if (!LAST) put_stats(st_out, row, pn, q0, v);
    }
};
struct EpiMlpUp {
    bf16_t* hid; const float* st_in; const float* c1; const float* c2;
    __device__ __forceinline__ void apply(int row, int pn, int q0, f32x4 (&v)[2][2]) const {
        float mean, rstd; row_stats(st_in, row, (q0 >> 2) & 7, mean, rstd);
#pragma unroll
        for (int bj = 0; bj < 2; ++bj)
#pragma unroll
            for (int n = 0; n < 2; ++n) {
                const int col = 256 * pn + 128 * bj + q0 + 16 * n;
                f32x4 u = (v[bj][n] - *(const f32x4*)(c1 + col) * mean) * rstd + *(const f32x4*)(c2 + col);
#pragma unroll
                for (int e = 0; e < 4; ++e) { const float r = fmaxf(u[e], 0.f); u[e] = r * r; }
                *(u32x2*)(hid + (size_t)row * FF + col) = pk4(u);
            }
    }
};
struct EpiIn1 {
    bf16_t* q1; bf16_t* k1; bf16_t* v1; bf16_t* g1; const float* st_in; const float* c1; const float* c2; const float* rc; const float* rs;
    __device__ __forceinline__ void apply(int row, int pn, int q0, f32x4 (&v)[2][2]) const {
        float mean, rstd; row_stats(st_in, row, (q0 >> 2) & 7, mean, rstd);
#pragma unroll
        for (int bj = 0; bj < 2; ++bj)
#pragma unroll
            for (int n = 0; n < 2; ++n) { const int col = 256 * pn + 128 * bj + q0 + 16 * n; v[bj][n] = (v[bj][n] - *(const f32x4*)(c1 + col) * mean) * rstd + *(const f32x4*)(c2 + col); }
        if (pn < 8) {
            const int pos = row_pos(row); const float sc = pn < 4 ? 1.f : 0.0625f;
            bf16_t* dst = (pn < 4 ? q1 : k1) + (size_t)row * 1024 + 256 * (pn & 3) + q0;
#pragma unroll
            for (int n = 0; n < 2; ++n) {
                const int j = q0 + 16 * n;
                const f32x4 cs = *(const f32x4*)(rc + pos * 128 + j) * sc, sn = *(const f32x4*)(rs + pos * 128 + j) * sc;
                const f32x4 y1 = v[0][n] * cs - v[1][n] * sn, y2 = v[0][n] * sn + v[1][n] * cs;
                *(u32x2*)(dst + 16 * n) = pk4(y1); *(u32x2*)(dst + 128 + 16 * n) = pk4(y2);
            }
        } else {
            const bool isg = pn >= 16;
            bf16_t* dst = (isg ? g1 : v1) + (size_t)row * RMIX + 256 * (isg ? pn - 16 : pn - 8) + q0;
#pragma unroll
            for (int bj = 0; bj < 2; ++bj)
#pragma unroll
                for (int n = 0; n < 2; ++n) {
                    f32x4 u = v[bj][n];
                    if (isg) {
#pragma unroll
                        for (int e = 0; e < 4; ++e) u[e] = u[e] * sigmoidf_(u[e]);
                    }
                    *(u32x2*)(dst + 128 * bj + 16 * n) = pk4(u);
                }
        }
    }
};

template <class Epi>
__device__ __forceinline__ void gemm_naive(const Gemm g, const Epi& E, int bid, int nb) {
    const int tid = opaque_tid(), wid = tid >> 6, lane = tid & 63, fr = lane & 15, fq = lane >> 4;
    const int nN = g.N / 256, units = (g.M / 256) * nN;
    for (long item = (long)bid * 8 + wid; item < (long)units * 64; item += (long)nb * 8) {
        const int unit = (int)(item >> 6), sub = (int)(item & 63), pm = unit / nN, pn = unit % nN, mg = sub >> 2, wc = sub & 3;
        const int row0 = 256 * pm + 16 * mg;
        const bf16_t* ap = g.A + (size_t)pn * g.a_pn_off + (size_t)(row0 + fr) * g.lda + 8 * fq;
        const bf16_t* bp = g.Bt + (size_t)(256 * pn + 32 * wc + fr) * g.ldb + 8 * fq;
        f32x4 acc[2][2];
#pragma unroll
        for (int bj = 0; bj < 2; ++bj)
#pragma unroll
            for (int n = 0; n < 2; ++n) acc[bj][n] = (f32x4){0.f, 0.f, 0.f, 0.f};
        for (int k0 = 0; k0 < g.K; k0 += 32) {
            const bf16x8 a = *(const bf16x8*)(ap + k0);
#pragma unroll
            for (int bj = 0; bj < 2; ++bj)
#pragma unroll
                for (int n = 0; n < 2; ++n) {
                    const bf16x8 b = *(const bf16x8*)(bp + (size_t)(128 * bj + 16 * n) * g.ldb + k0);
                    acc[bj][n] = __builtin_amdgcn_mfma_f32_16x16x32_bf16(b, a, acc[bj][n], 0, 0, 0);
                }
        }
        E.apply(row0 + fr, pn, 32 * wc + 4 * fq, acc);
    }
}

namespace pg8 {
constexpr int BM = 256, BK = 64, HALF = 128, HTB = HALF * BK * 2  , STAGE_BYTES = 8 * HTB, NXCD = 8, WGM = 8;
__host__ __device__ __forceinline__ int lds_byte(int r, int c) { const int st = (r >> 4) * 2 + (c >> 5), rr = r & 15, cc = c & 31, ob = rr * 64 + cc * 2; return st * 1024 + (ob ^ (((ob >> 9) & 1) << 5)); }
__host__ __device__ __forceinline__ void stage_rc(int b, int& R, int& C) { const int st = b / 1024, sb = b % 1024, swz = sb ^ (((sb >> 9) & 1) << 5); R = (st >> 1) * 16 + swz / 64; C = (st & 1) * 32 + (swz % 64) / 2; }
struct Unit { int pm, pn; };
struct StaticOrder {
    int nM, nN, nwg, G, c;
    __host__ __device__ void init(int M, int N, int G_, int c_) { nM = M / BM; nN = N / BM; nwg = nM * nN; G = G_; c = c_; }
    __host__ __device__ bool next(int i, Unit& u) const {
        const long L = (long)i * G + c; if (L >= nwg) return false;
        int wgid = (int)L; { const int q = nwg / NXCD, r = nwg % NXCD, xcd = wgid % NXCD, off = wgid / NXCD; wgid = (xcd < r ? xcd * (q + 1) : r * (q + 1) + (xcd - r) * q) + off; }
        const int nig = WGM * nN, gid = wgid / nig, fm = gid * WGM, gsz = (nM - fm) < WGM ? (nM - fm) : WGM;
        u.pm = fm + ((wgid % nig) % gsz); u.pn = (wgid % nig) / gsz; return true;
    }
};
template <class E> struct PgEpi {
    E e;
    __device__ __forceinline__ void operator()(const f32x4 (&acc)[2][2][4][2], const Unit& u, int wr, int wc, int fr, int fq) const {
#pragma unroll
        for (int ai = 0; ai < 2; ++ai)
#pragma unroll
            for (int m = 0; m < 4; ++m) {
                f32x4 v[2][2] = {{acc[ai][0][m][0], acc[ai][0][m][1]}, {acc[ai][1][m][0], acc[ai][1][m][1]}};
                e.apply(u.pm * BM + ai * HALF + wr * 64 + m * 16 + fr, u.pn, wc * 32 + 4 * fq, v);
                asm volatile("" ::: "memory");
            }
    }
};
template <class Epi>
__device__ __forceinline__ void gemm_phase(LAS unsigned char* lds, const Gemm g, const StaticOrder& S, const Epi& E) {
    const int tid = opaque_tid(), wid = __builtin_amdgcn_readfirstlane(tid >> 6), lane = tid & 63, wr = wid >> 2, wc = wid & 3, fr = lane & 15, fq = lane >> 4;
    int Ko = g.K; asm volatile("" : "+s"(Ko));
    const int K = Ko, nt = K / BK;
    unsigned voffA[2], voffB[2];
#pragma unroll
    for (int i = 0; i < 2; ++i) { int R, C; stage_rc(tid * 16 + i * 8192, R, C); voffA[i] = (unsigned)(R * g.lda + C) * 2u; voffB[i] = (unsigned)(R * g.ldb + C) * 2u; }
    const size_t kstep = (size_t)(BK * 2);
    const size_t hstepA = (size_t)HALF * g.lda * 2, hstepB = (size_t)HALF * g.ldb * 2;
    const size_t tstepA = 2 * hstepA, tstepB = 2 * hstepB;
    const size_t pnA = (size_t)g.a_pn_off * 2;
    const unsigned ldsw = (unsigned)wid * 1024u;
    const int aoff = lds_byte(wr * 64 + fr, fq * 8), boff = lds_byte(wc * 32 + fr, fq * 8);
#define PG8_SA(b, h) (((b) * 2 + (h)) * HTB)
#define PG8_SB(b, h) ((4 + (b) * 2 + (h)) * HTB)
#define PG8_STAGE(bufoff, gbase, voff) do { _Pragma("unroll") for (int _i = 0; _i < 2; ++_i) \
        __builtin_amdgcn_global_load_lds((const unsigned*)((const char*)(gbase) + (voff)[_i]), (LAS unsigned*)(lds + (bufoff) + ldsw + _i * 8192), 16, 0, 0); } while (0)
#define PG8_LDA(dst, b, h) do { _Pragma("unroll") for (int m = 0; m < 4; ++m) _Pragma("unroll") for (int k = 0; k < 2; ++k) dst[m][k] = *(const LAS bf16x8*)(lds + PG8_SA(b, h) + aoff + m * 2048 + k * 1024); } while (0)
#define PG8_LDB(dst, b, h) do { _Pragma("unroll") for (int n = 0; n < 2; ++n) _Pragma("unroll") for (int k = 0; k < 2; ++k) dst[n][k] = *(const LAS bf16x8*)(lds + PG8_SB(b, h) + boff + n * 2048 + k * 1024); } while (0)
#define PG8_MMA(ai, bj, At, Bt) do { __builtin_amdgcn_s_setprio(1); _Pragma("unroll") for (int m = 0; m < 4; ++m) _Pragma("unroll") for (int n = 0; n < 2; ++n) _Pragma("unroll") for (int k = 0; k < 2; ++k) \
        acc[ai][bj][m][n] = __builtin_amdgcn_mfma_f32_16x16x32_bf16(Bt[n][k], At[m][k], acc[ai][bj][m][n], 0, 0, 0); __builtin_amdgcn_s_setprio(0); } while (0)
#define PG8_WAIT_V(n) asm volatile("s_waitcnt vmcnt(" #n ")" ::: "memory")
#define PG8_WAIT_L(n) asm volatile("s_waitcnt lgkmcnt(" #n ")" ::: "memory")
#define PG8_BAR __builtin_amdgcn_s_barrier()
#define PG8_SCHED __builtin_amdgcn_sched_barrier(0)
    Unit cur, nxt; int ui = 0;
    if (!S.next(0, cur)) return;
    f32x4 acc[2][2][4][2];
#pragma unroll
    for (int a = 0; a < 2; ++a)
#pragma unroll
        for (int b = 0; b < 2; ++b)
#pragma unroll
            for (int m = 0; m < 4; ++m)
#pragma unroll
                for (int n = 0; n < 2; ++n) acc[a][b][m][n] = (f32x4){0.f, 0.f, 0.f, 0.f};
    bf16x8 At[4][2], B0[2][2], B1[2][2];
    const char* cA = (const char*)g.A + (size_t)cur.pn * pnA + (size_t)cur.pm * tstepA; const char* cB = (const char*)g.Bt + (size_t)cur.pn * tstepB;
    PG8_STAGE(PG8_SB(0, 0), cB, voffB); PG8_STAGE(PG8_SB(0, 1), cB + hstepB, voffB); PG8_STAGE(PG8_SA(0, 0), cA, voffA); PG8_STAGE(PG8_SA(0, 1), cA + hstepA, voffA);
    if (wr == 1) PG8_BAR;
    PG8_WAIT_V(2); PG8_BAR;
    PG8_STAGE(PG8_SB(1, 0), cB + kstep, voffB); PG8_STAGE(PG8_SA(1, 0), cA + kstep, voffA); PG8_STAGE(PG8_SB(1, 1), cB + hstepB + kstep, voffB);
    PG8_WAIT_V(6); PG8_BAR;
    for (;;) {
        const bool has_next = S.next(ui + 1, nxt);
        const char* nA = has_next ? (const char*)g.A + (size_t)nxt.pn * pnA + (size_t)nxt.pm * tstepA : cA; const char* nB = has_next ? (const char*)g.Bt + (size_t)nxt.pn * tstepB : cB;
        for (int t = 0; t < nt; t += 2) {
            const bool last = (t == nt - 2);
            const char* a1 = cA + (size_t)(t + 1) * kstep;
            const char* a2 = last ? nA : cA + (size_t)(t + 2) * kstep; const char* b2 = last ? nB : cB + (size_t)(t + 2) * kstep;
            const char* a3 = a2 + kstep; const char* b3 = b2 + kstep;
            PG8_LDB(B0, 0, 0); PG8_LDB(B1, 0, 1); PG8_SCHED; PG8_LDA(At, 0, 0); PG8_STAGE(PG8_SA(1, 1), a1 + hstepA, voffA);
            PG8_WAIT_V(8); PG8_WAIT_L(0); PG8_BAR; PG8_MMA(0, 0, At, B0); PG8_MMA(0, 1, At, B1); PG8_BAR; PG8_SCHED;
            PG8_LDA(At, 0, 1); PG8_STAGE(PG8_SB(0, 0), b2, voffB); PG8_STAGE(PG8_SB(0, 1), b2 + hstepB, voffB); PG8_STAGE(PG8_SA(0, 0), a2, voffA);
            PG8_WAIT_V(8); PG8_WAIT_L(0); PG8_BAR; PG8_MMA(1, 0, At, B0); PG8_MMA(1, 1, At, B1); PG8_BAR; PG8_SCHED;
            PG8_LDB(B0, 1, 0); PG8_LDB(B1, 1, 1); PG8_SCHED; PG8_LDA(At, 1, 0); PG8_STAGE(PG8_SA(0, 1), a2 + hstepA, voffA);
            PG8_WAIT_V(8); PG8_WAIT_L(0); PG8_BAR; PG8_MMA(0, 0, At, B0); PG8_MMA(0, 1, At, B1); PG8_BAR; PG8_SCHED;
            PG8_LDA(At, 1, 1); PG8_STAGE(PG8_SB(1, 0), b3, voffB); PG8_STAGE(PG8_SB(1, 1), b3 + hstepB, voffB); PG8_STAGE(PG8_SA(1, 0), a3, voffA);
            PG8_WAIT_V(8); PG8_WAIT_L(0); PG8_BAR; PG8_MMA(1, 0, At, B0); PG8_MMA(1, 1, At, B1); PG8_BAR; PG8_SCHED;
        }
        if (wr == 0) PG8_BAR;
        E(acc, cur, wr, wc, fr, fq);
        if (!has_next) break;
#pragma unroll
        for (int a = 0; a < 2; ++a)
#pragma unroll
            for (int b = 0; b < 2; ++b)
#pragma unroll
                for (int m = 0; m < 4; ++m)
#pragma unroll
                    for (int n = 0; n < 2; ++n) acc[a][b][m][n] = (f32x4){0.f, 0.f, 0.f, 0.f};
        cur = nxt; cA = nA; cB = nB; ++ui;
        if (wr == 1) PG8_BAR;
    }
    PG8_WAIT_V(0);
    PG8_BAR;
#undef PG8_SA
#undef PG8_SB
#undef PG8_STAGE
#undef PG8_LDA
#undef PG8_LDB
#undef PG8_MMA
#undef PG8_WAIT_V
#undef PG8_WAIT_L
#undef PG8_BAR
#undef PG8_SCHED
}
}

template <class E>
__device__ __forceinline__ void run_gemm(LAS unsigned char* lds, const Gemm g, const E& e, int bid, int nb) {
#if FAST_GEMM
    pg8::StaticOrder S; S.init(g.M, g.N, nb, bid);
    pg8::PgEpi<E> pe{e};
    pg8::gemm_phase<pg8::PgEpi<E>>(lds, g, S, pe);
#else
    gemm_naive<E>(g, e, bid, nb);
#endif
}

constexpr int NWV = 8;

__device__ __forceinline__ void transpose_item(const float* W, int K, int N, bf16_t* WT, int row_off, const float* gk, LAS float* scr, int item, int lane) {
    const int nblk = N / 32, kb = item / nblk, nbk = item % nblk, k0 = 64 * kb, n0 = 32 * nbk;
#pragma unroll 8
    for (int i = 0; i < 32; ++i) { const int kk = 2 * i + (lane >> 5); float w = W[(size_t)(k0 + kk) * N + n0 + (lane & 31)]; if (gk) w *= gk[k0 + kk]; scr[kk * 33 + (lane & 31)] = w; }
    asm volatile("s_waitcnt lgkmcnt(0)" ::: "memory");
    const int cch = lane & 7;
#pragma unroll
    for (int j = 0; j < 4; ++j) { const int n = (lane >> 3) + 8 * j; const LAS float* s = scr + (8 * cch) * 33 + n;
        u32x4 o; o.x = pk2(s[0 * 33], s[1 * 33]); o.y = pk2(s[2 * 33], s[3 * 33]); o.z = pk2(s[4 * 33], s[5 * 33]); o.w = pk2(s[6 * 33], s[7 * 33]);
        *(u32x4*)(WT + (size_t)(row_off + n0 + n) * K + k0 + 8 * cch) = o; }
    asm volatile("s_waitcnt lgkmcnt(0)" ::: "memory");
}
struct MatDesc { const float* W; int K, N; bf16_t* WT; int row_off; const float* gk; };
constexpr int TR_COUNT[18] = {720, 8, 8, 8, 8, 8, 8, 8, 8, 96, 64, 512, 2048, 2048, 3072, 1024, 2048, 2048};
constexpr int tr_total() { int s = 0; for (int i = 0; i < 18; ++i) s += TR_COUNT[i]; return s; }
__device__ __forceinline__ MatDesc get_mat(const Ctx& c, int i) {
    MatDesc d; d.gk = nullptr; d.row_off = 0;
    if (i == 0) { d.W = c.in[2]; d.K = 1024; d.N = EVEN_IN; d.WT = c.b16(OFF_WIN0); }
    else if (i <= 4) { const int h = i - 1; d.W = c.in[5] + h * 16384; d.K = 128; d.N = 128; d.WT = c.b16(OFF_WGATE); d.row_off = h * 256; }
    else if (i <= 8) { const int h = i - 5; d.W = c.in[7] + h * 16384; d.K = 128; d.N = 128; d.WT = c.b16(OFF_WGATE); d.row_off = h * 256 + 128; }
    else if (i == 9) { d.W = c.in[11]; d.K = 256; d.N = 768; d.WT = c.b16(OFF_WUQ); d.gk = c.in[10]; }
    else if (i == 10) { d.W = c.in[13]; d.K = 128; d.N = 1024; d.WT = c.b16(OFF_WUKV); d.gk = c.in[12]; }
    else if (i == 11) { d.W = c.in[14]; d.K = 1024; d.N = 1024; d.WT = c.b16(OFF_WOUT0); }
    else if (i == 12) { d.W = c.in[19]; d.K = 1024; d.N = 4096; d.WT = c.b16(OFF_W1_0); d.gk = c.in[17]; }
    else if (i == 13) { d.W = c.in[20]; d.K = 4096; d.N = 1024; d.WT = c.b16(OFF_W2_0); }
    else if (i == 14) { d.W = c.in[15]; d.K = 1024; d.N = 6144; d.WT = c.b16(OFF_WIN1); d.gk = c.in[21]; }
    else if (i == 15) { d.W = c.in[16]; d.K = 2048; d.N = 1024; d.WT = c.b16(OFF_WOUT1); }
    else if (i == 16) { d.W = c.in[19] + (size_t)1024 * 4096; d.K = 1024; d.N = 4096; d.WT = c.b16(OFF_W1_1); d.gk = c.in[17] + 1024; }
    else { d.W = c.in[20] + (size_t)4096 * 1024; d.K = 4096; d.N = 1024; d.WT = c.b16(OFF_W2_1); }
    return d;
}
constexpr int C1_UP0 = 0, C2_UP0 = 4096, C1_IN1 = 8192, C2_IN1 = 14336, C1_UP1 = 20480, C2_UP1 = 24576;
__device__ __forceinline__ void sincos_d(double ang, float& cs, float& sn) {
    const double TWO_PI = 6.283185307179586476925, HALF_PI = 1.5707963267948966192;
    double r = ang - rint(ang / TWO_PI) * TWO_PI;
    const double q = rint(r / HALF_PI); const double y = r - q * HALF_PI; const double y2 = y * y;
    const double s = y * (1.0 + y2 * (-1.0 / 6 + y2 * (1.0 / 120 + y2 * (-1.0 / 5040 + y2 * (1.0 / 362880 + y2 * (-1.0 / 39916800 + y2 * (1.0 / 6227020800.0)))))));
    const double c = 1.0 + y2 * (-0.5 + y2 * (1.0 / 24 + y2 * (-1.0 / 720 + y2 * (1.0 / 40320 + y2 * (-1.0 / 3628800 + y2 * (1.0 / 479001600.0))))));
    const int qi = ((int)q) & 3;
    double cc, ss;
    if (qi == 0) { cc = c; ss = s; } else if (qi == 1) { cc = -s; ss = c; } else if (qi == 2) { cc = -c; ss = -s; } else { cc = s; ss = -c; }
    cs = (float)cc; sn = (float)ss;
}
__device__ __forceinline__ void phase_prologue(const Ctx& c, const Params& p, LAS unsigned char* lds, int bid, int nb) {
    const int tid = opaque_tid(), wid = tid >> 6, lane = tid & 63;
    LAS float* scr = (LAS float*)(lds + wid * 16384);
    const long gw = (long)bid * NWV + wid, NW = (long)nb * NWV;
    constexpr int T_C12 = 224 * 8, T_TR = tr_total(), T_ZP = 96, T_XB = MP, T_ROPE = (TT * 144 + 63) / 64, T_CCH = 8;
    constexpr int TOTAL = T_C12 + T_TR + T_ZP + T_XB + T_ROPE + T_CCH;
    for (long it = gw; it < TOTAL; it += NW) {
        int r = (int)it;
        if (r < T_C12) {
            const int part = r & 7, grp = r >> 3;
            const float* W; const float* gk; const float* bk; int N, ncol, c1o, c2o;
            if (grp < 64) { W = c.in[19]; gk = c.in[17]; bk = c.in[18]; N = 4096; ncol = grp * 64; c1o = C1_UP0; c2o = C2_UP0; }
            else if (grp < 160) { W = c.in[15]; gk = c.in[21]; bk = c.in[22]; N = 6144; ncol = (grp - 64) * 64; c1o = C1_IN1; c2o = C2_IN1; }
            else { W = c.in[19] + (size_t)1024 * 4096; gk = c.in[17] + 1024; bk = c.in[18] + 1024; N = 4096; ncol = (grp - 160) * 64; c1o = C1_UP1; c2o = C2_UP1; }
            float s1 = 0.f, s2 = 0.f;
#pragma unroll 8
            for (int k = part * 128; k < part * 128 + 128; ++k) { const float w = W[(size_t)k * N + ncol + lane]; s1 += bfround(gk[k] * w); s2 += bk[k] * w; }
            float* cv = c.f32(OFF_C12);
            atomicAdd(cv + c1o + ncol + lane, s1); atomicAdd(cv + c2o + ncol + lane, s2);
            continue;
        }
        r -= T_C12;
        if (r < T_TR) {
            int mi = 0;
#pragma unroll
            for (int i = 0; i < 18; ++i) { if (mi == i && r >= TR_COUNT[i]) { r -= TR_COUNT[i]; mi = i + 1; } }
            const MatDesc d = get_mat(c, mi);
            transpose_item(d.W, d.K, d.N, d.WT, d.row_off, d.gk, scr, r, lane);
            continue;
        }
        r -= T_TR;
        if (r < T_ZP) {
            u32x4* dst = (u32x4*)(c.b16(OFF_WIN0) + (size_t)(EVEN_IN + r) * 1024); dst[lane] = (u32x4){0, 0, 0, 0}; dst[64 + lane] = (u32x4){0, 0, 0, 0};
            continue;
        }
        r -= T_ZP;
        if (r < T_XB) {
            const int row = r; u32x2* dst = (u32x2*)(c.b16(OFF_XB) + (size_t)row * DM);
            const float* src = row < MR ? c.in[0] + (size_t)row * DM : (row < MR + NMETA ? c.in[1] + (size_t)(row - MR) * DM : nullptr);
#pragma unroll
            for (int j = 0; j < 4; ++j) { const f32x4 v = src ? *(const f32x4*)(src + 256 * j + 4 * lane) : (f32x4){0.f, 0.f, 0.f, 0.f}; dst[64 * j + lane] = pk4(v); }
            continue;
        }
        r -= T_XB;
        if (r < T_ROPE) {
            const int e = r * 64 + lane;
            if (e < TT * 144) {
                const int pos = e / 144, j = e % 144; float cs, sn;
                if (j < 16) { sincos_d((double)pos * p.inv0[j], cs, sn); c.f32(OFF_ROPE0C)[pos * 16 + j] = cs; c.f32(OFF_ROPE0S)[pos * 16 + j] = sn; }
                else { sincos_d((double)pos * p.inv1[j - 16], cs, sn); c.f32(OFF_ROPE1C)[pos * 128 + j - 16] = cs; c.f32(OFF_ROPE1S)[pos * 128 + j - 16] = sn; }
            }
            continue;
        }
        r -= T_ROPE;
        { const int ch = r * 64 + lane; const float lam = c.in[9][ch]; c.f32(OFF_CCH)[ch] = -8.f * log1pf(__expf(-lam)); }
    }
}

__device__ __forceinline__ void phase_conv(const Ctx& c, int bid, int nb) {
    const int tid = opaque_tid(), wid = tid >> 6, lane = tid & 63;
    const bf16_t* p0 = c.b16(OFF_P0); bf16_t* xc = c.b16(OFF_XC); bf16_t* Kb = c.b16(OFF_K);
    const float* cw = c.in[3]; const float* cb = c.in[4];
    const int ch0 = lane * 8;
    for (int row = bid * NWV + wid; row < MP; row += nb * NWV) {
        float acc[8];
#pragma unroll
        for (int e = 0; e < 8; ++e) acc[e] = cb[ch0 + e];
#pragma unroll
        for (int w = 0; w < 4; ++w) {
            const int d = 3 - w; int srow = -1;
            if (row < MR) { const int sp = (row & (SEQ - 1)) - d; srow = sp >= 0 ? row - d : MR + NMETA + sp; }
            else if (row < MR + NMETA) { srow = (row - MR - d) >= 0 ? row - d : -1; }
            if (srow >= 0) {
                const u32x4 x = *(const u32x4*)(p0 + (size_t)srow * N_IN0 + 512 + ch0);
                const f32x4 w0 = *(const f32x4*)(cw + w * 512 + ch0), w1 = *(const f32x4*)(cw + w * 512 + ch0 + 4);
                acc[0] += w0[0] * bf2f(x.x & 0xffffu); acc[1] += w0[1] * bf2f(x.x >> 16); acc[2] += w0[2] * bf2f(x.y & 0xffffu); acc[3] += w0[3] * bf2f(x.y >> 16);
                acc[4] += w1[0] * bf2f(x.z & 0xffffu); acc[5] += w1[1] * bf2f(x.z >> 16); acc[6] += w1[2] * bf2f(x.w & 0xffffu); acc[7] += w1[3] * bf2f(x.w >> 16);
            }
        }
        if (row >= MR + NMETA) {
#pragma unroll
            for (int e = 0; e < 8; ++e) acc[e] = 0.f;
        }
        u32x4 o; o.x = pk2(acc[0], acc[1]); o.y = pk2(acc[2], acc[3]); o.z = pk2(acc[4], acc[5]); o.w = pk2(acc[6], acc[7]);
        *(u32x4*)(xc + (size_t)row * LRUW + ch0) = o;
        const int h = lane >> 3, d0 = (lane & 7) * 4, jj = d0 & 15; u32x2 ko = (u32x2){0u, 0u};
        if (row < MR + NMETA) {
            const int pos = row_pos(row);
            const f32x4 x1 = unpk4(*(const u32x2*)(p0 + (size_t)row * N_IN0 + 1408 + jj)), x2 = unpk4(*(const u32x2*)(p0 + (size_t)row * N_IN0 + 1424 + jj));
            const f32x4 cs = *(const f32x4*)(c.f32(OFF_ROPE0C) + pos * 16 + jj), sn = *(const f32x4*)(c.f32(OFF_ROPE0S) + pos * 16 + jj);
            ko = pk4(d0 < 16 ? x1 * cs - x2 * sn : x1 * sn + x2 * cs);
        }
        *(u32x2*)(Kb + (size_t)row * NQ + h * QKD + 64 + d0) = ko;
    }
}

__device__ __forceinline__ float meta_state(const Ctx& c, int ch) {
    float h = 0.f; const float* a = c.f32(OFF_ABMETA) + ch; const float* b = a + 256 * LRUW;
#pragma unroll
    for (int i = 0; i < NMETA; ++i) h = a[i * LRUW] * h + b[i * LRUW];
    return h;
}
__device__ __forceinline__ void phase_scan1(const Ctx& c, int bid, int nb) {
    const int tid = opaque_tid(), wid = tid >> 6, lane = tid & 63;
    for (int it = bid * NWV + wid; it < 2048; it += nb * NWV) {
        const int chg = it & 7, ck = (it >> 3) & 15, b = it >> 7, ch = chg * 64 + lane, row0 = b * SEQ + ck * 128;
        const float* a = c.out + (size_t)row0 * LRUW + ch; const float* bb = a + (size_t)MR * LRUW;
        float P = 1.f, S = 0.f;
#pragma unroll 8
        for (int t = 0; t < 128; ++t) { const float av = a[(size_t)t * LRUW], bv = bb[(size_t)t * LRUW]; S = av * S + bv; P *= av; }
        *(f32x2*)(c.f32(OFF_CARRY) + ((size_t)(b * 16 + ck) * LRUW + ch) * 2) = (f32x2){P, S};
    }
}
__device__ __forceinline__ void phase_scan2(const Ctx& c, int bid, int nb) {
    const int tid = opaque_tid(), wid = tid >> 6, lane = tid & 63;
    const bf16_t* p0 = c.b16(OFF_P0); bf16_t* mix = c.b16(OFF_MIX);
    for (int it = bid * NWV + wid; it < 2048 + 8; it += nb * NWV) {
        if (it >= 2048) {
            const int ch = (it - 2048) * 64 + lane; float h = 0.f;
            const float* a = c.f32(OFF_ABMETA) + ch; const float* bb = a + 256 * LRUW;
            for (int i = 0; i < NMETA; ++i) { h = a[i * LRUW] * h + bb[i * LRUW]; const int row = MR + i;
                const float gt = bf2f(p0[(size_t)row * N_IN0 + ch]); mix[(size_t)row * DM + ch] = (bf16_t)(pk2(h * gelu_tanh(gt), 0.f) & 0xffffu); }
            continue;
        }
        const int chg = it & 7, ck = (it >> 3) & 15, b = it >> 7, ch = chg * 64 + lane, row0 = b * SEQ + ck * 128;
        float h = meta_state(c, ch);
        const float* cr = c.f32(OFF_CARRY) + ((size_t)(b * 16) * LRUW + ch) * 2;
        for (int k = 0; k < ck; ++k) { const f32x2 ps = *(const f32x2*)(cr + (size_t)k * LRUW * 2); h = ps.x * h + ps.y; }
        const float* a = c.out + (size_t)row0 * LRUW + ch; const float* bb = a + (size_t)MR * LRUW;
#pragma unroll 8
        for (int t = 0; t < 128; ++t) {
            h = a[(size_t)t * LRUW] * h + bb[(size_t)t * LRUW];
            const int row = row0 + t; const float gt = bf2f(p0[(size_t)row * N_IN0 + ch]);
            mix[(size_t)row * DM + ch] = (bf16_t)(pk2(h * gelu_tanh(gt), 0.f) & 0xffffu);
        }
    }
}

__device__ __forceinline__ void phase_attn_naive(const Ctx& c, int bid, int nb, bool meta_only) {
    const int tid = opaque_tid(), wid = tid >> 6, lane = tid & 63;
    const bf16_t* Q = c.b16(OFF_Q); const bf16_t* K = c.b16(OFF_K); const bf16_t* V = c.b16(OFF_V); bf16_t* mix = c.b16(OFF_MIX);
    const long nitems = (long)NBATCH * MLA_H * SEQ + MLA_H * NMETA;
    for (long it = (meta_only ? (long)NBATCH * MLA_H * SEQ : 0) + (long)bid * NWV + wid; it < nitems; it += (long)nb * NWV) {
        int b, h, s, qrow;
        if (it < (long)NBATCH * MLA_H * SEQ) { s = (int)(it & (SEQ - 1)); h = (int)((it >> 11) & 7); b = (int)(it >> 14); qrow = b * SEQ + s; }
        else { const int r = (int)(it - (long)NBATCH * MLA_H * SEQ); s = r & 15; h = r >> 4; b = -1; qrow = MR + s; }
        float q[QKD];
#pragma unroll
        for (int j = 0; j < QKD / 8; ++j) { const u32x4 w = *(const u32x4*)(Q + (size_t)qrow * NQ + h * QKD + 8 * j);
            q[8 * j] = bf2f(w.x & 0xffffu); q[8 * j + 1] = bf2f(w.x >> 16); q[8 * j + 2] = bf2f(w.y & 0xffffu); q[8 * j + 3] = bf2f(w.y >> 16);
            q[8 * j + 4] = bf2f(w.z & 0xffffu); q[8 * j + 5] = bf2f(w.z >> 16); q[8 * j + 6] = bf2f(w.w & 0xffffu); q[8 * j + 7] = bf2f(w.w >> 16); }
        float m = -1e30f, l = 0.f, o = 0.f;
        const int ntile = b < 0 ? 1 : 2 + (s >> 6);
        for (int t = 0; t < ntile; ++t) {
            int krow0, nvalid;
            if (t == 0) { krow0 = MR; nvalid = b < 0 ? s + 1 : NMETA; } else { krow0 = b * SEQ + 64 * (t - 1); nvalid = min(64, s + 1 - 64 * (t - 1)); }
            const bool valid = lane < nvalid;
            float sv = 0.f;
            { const bf16_t* kp = K + (size_t)(krow0 + lane) * NQ + h * QKD;
#pragma unroll
              for (int j = 0; j < QKD / 8; ++j) { const u32x4 w = *(const u32x4*)(kp + 8 * j);
                sv += q[8 * j] * bf2f(w.x & 0xffffu) + q[8 * j + 1] * bf2f(w.x >> 16) + q[8 * j + 2] * bf2f(w.y & 0xffffu) + q[8 * j + 3] * bf2f(w.y >> 16)
                    + q[8 * j + 4] * bf2f(w.z & 0xffffu) + q[8 * j + 5] * bf2f(w.z >> 16) + q[8 * j + 6] * bf2f(w.w & 0xffffu) + q[8 * j + 7] * bf2f(w.w >> 16); } }
            if (!valid) sv = -1e30f;
            const float mn = fmaxf(m, wave_max(sv)), f = exp2f(m - mn), pv = valid ? exp2f(sv - mn) : 0.f;
            l = l * f + wave_sum(pv); o *= f; m = mn;
            for (int k = 0; k < nvalid; ++k) { const float pk = __shfl(pv, k); o += pk * bf2f(V[(size_t)(krow0 + k) * NV + h * VD + lane]); }
        }
        mix[(size_t)qrow * DM + 512 + h * VD + lane] = (bf16_t)(pk2(o / l, 0.f) & 0xffffu);
    }
}

typedef float f32x16 __attribute__((ext_vector_type(16)));
typedef short v4i16_t __attribute__((ext_vector_type(4)));
__device__ __forceinline__ int crow(int r, int hi) { return (r & 3) + 8 * (r >> 2) + 4 * hi; }
__device__ __forceinline__ bf16x8 tr_pair(const LAS unsigned char* p0, const LAS unsigned char* p1) {
    const v4i16_t a = __builtin_amdgcn_ds_read_tr16_b64_v4i16((LAS v4i16_t*)p0), b = __builtin_amdgcn_ds_read_tr16_b64_v4i16((LAS v4i16_t*)p1);
    return (bf16x8){a[0], a[1], a[2], a[3], b[0], b[1], b[2], b[3]};
}
constexpr int AT_KPITCH = 208, AT_KBYTES = 64 * AT_KPITCH  , AT_VBYTES = 8192, AT_BUF = AT_KBYTES + AT_VBYTES;
__device__ __forceinline__ void attn_unit(const Ctx& c, LAS unsigned char* lds, int b, int h, int qb) {
    const int tid = opaque_tid(), lane = tid & 63, wid = __builtin_amdgcn_readfirstlane(tid >> 6), r32 = lane & 31, hi = lane >> 5;
    const bf16_t* Q = c.b16(OFF_Q); const bf16_t* K = c.b16(OFF_K) + h * QKD; const bf16_t* V = c.b16(OFF_V) + h * VD; bf16_t* mix = c.b16(OFF_MIX);
    const int qrel = 32 * wid + r32;
    const size_t qrow = (size_t)b * SEQ + 256 * qb + qrel;
    bf16x8 qr[6];
#pragma unroll
    for (int d0 = 0; d0 < 6; ++d0) qr[d0] = *(const bf16x8*)(Q + qrow * NQ + h * QKD + 16 * d0 + 8 * hi);
    const int kp0 = tid, kp1 = tid + 512; const bool k1ok = tid < 256;
    const int kr0 = kp0 / 12, kc0 = kp0 % 12, kr1 = k1ok ? kp1 / 12 : 0, kc1 = k1ok ? kp1 % 12 : 0;
    const int vr = tid >> 3, vc = tid & 7;
    const unsigned kdst0 = kr0 * AT_KPITCH + kc0 * 16, kdst1 = kr1 * AT_KPITCH + kc1 * 16, vdst = AT_KBYTES + (vc >> 2) * 4096 + vr * 64 + (vc & 3) * 16;
    u32x4 kg0, kg1, vg;
    const int NT = 4 * qb + 5;
#define AT_GLOAD(t) do { const size_t base_ = (t) == 0 ? (size_t)MR : (size_t)b * SEQ + 64 * ((t) - 1); \
        kg0 = *(const u32x4*)(K + (base_ + kr0) * NQ + 8 * kc0); if (k1ok) kg1 = *(const u32x4*)(K + (base_ + kr1) * NQ + 8 * kc1); \
        vg = *(const u32x4*)(V + (base_ + vr) * NV + 8 * vc); } while (0)
#define AT_LWRITE(buf) do { LAS unsigned char* d_ = lds + (buf) * AT_BUF; *(LAS u32x4*)(d_ + kdst0) = kg0; if (k1ok) *(LAS u32x4*)(d_ + kdst1) = kg1; *(LAS u32x4*)(d_ + vdst) = vg; } while (0)
    f32x16 o0, o1;
#pragma unroll
    for (int r = 0; r < 16; ++r) { o0[r] = 0.f; o1[r] = 0.f; }
    float m = -1e30f, l = 0.f;
    AT_GLOAD(0); AT_LWRITE(0);
    __syncthreads();
    const unsigned kfo = r32 * AT_KPITCH + hi * 16;
    const unsigned vfo = AT_KBYTES + ((lane >> 4) & 1) * 32 + (lane & 3) * 8 + (4 * hi + ((lane & 15) >> 2)) * 64;
    for (int t = 0; t < NT; ++t) {
        const bool more = t + 1 < NT;
        if (more) AT_GLOAD(t + 1);
        const int jb = t - 1 - 4 * qb;
        if (jb < 0 || 64 * jb <= 32 * wid + 31) {
            const LAS unsigned char* bufp = lds + (t & 1) * AT_BUF;
            f32x16 p0, p1;
#pragma unroll
            for (int r = 0; r < 16; ++r) { p0[r] = 0.f; p1[r] = 0.f; }
#pragma unroll
            for (int d0 = 0; d0 < 6; ++d0) {
                const bf16x8 k0 = *(const LAS bf16x8*)(bufp + kfo + d0 * 32), k1 = *(const LAS bf16x8*)(bufp + kfo + 32 * AT_KPITCH + d0 * 32);
                p0 = __builtin_amdgcn_mfma_f32_32x32x16_bf16(k0, qr[d0], p0, 0, 0, 0);
                p1 = __builtin_amdgcn_mfma_f32_32x32x16_bf16(k1, qr[d0], p1, 0, 0, 0);
            }
            if (t == 0) {
#pragma unroll
                for (int r = 0; r < 16; ++r) { if (crow(r, hi) >= NMETA) p0[r] = -1e30f; p1[r] = -1e30f; }
            } else if (jb >= 0) {
#pragma unroll
                for (int r = 0; r < 16; ++r) { const int kv = 64 * jb + crow(r, hi); if (kv > qrel) p0[r] = -1e30f; if (kv + 32 > qrel) p1[r] = -1e30f; }
            }
            float rm = fmaxf(p0[0], p1[0]);
#pragma unroll
            for (int r = 1; r < 16; ++r) rm = fmaxf(rm, fmaxf(p0[r], p1[r]));
            rm = fmaxf(rm, __shfl_xor(rm, 32));
            const float mn = fmaxf(m, rm), f = __builtin_amdgcn_exp2f(m - mn); m = mn;
            float ls = 0.f;
#pragma unroll
            for (int r = 0; r < 16; ++r) { p0[r] = __builtin_amdgcn_exp2f(p0[r] - mn); p1[r] = __builtin_amdgcn_exp2f(p1[r] - mn); ls += p0[r] + p1[r]; }
            l = l * f + ls;
#pragma unroll
            for (int r = 0; r < 16; ++r) { o0[r] *= f; o1[r] *= f; }
            u32x4 pw[4];
#pragma unroll
            for (int q4 = 0; q4 < 4; ++q4) { pw[0][q4] = pk2(p0[2 * q4], p0[2 * q4 + 1]); pw[1][q4] = pk2(p0[8 + 2 * q4], p0[9 + 2 * q4]); pw[2][q4] = pk2(p1[2 * q4], p1[2 * q4 + 1]); pw[3][q4] = pk2(p1[8 + 2 * q4], p1[9 + 2 * q4]); }
#pragma unroll
            for (int s4 = 0; s4 < 4; ++s4) {
                const bf16x8 pf = __builtin_bit_cast(bf16x8, pw[s4]);
                const bf16x8 v0 = tr_pair(bufp + vfo + s4 * 1024, bufp + vfo + s4 * 1024 + 512);
                const bf16x8 v1 = tr_pair(bufp + vfo + 4096 + s4 * 1024, bufp + vfo + 4096 + s4 * 1024 + 512);
                o0 = __builtin_amdgcn_mfma_f32_32x32x16_bf16(v0, pf, o0, 0, 0, 0);
                o1 = __builtin_amdgcn_mfma_f32_32x32x16_bf16(v1, pf, o1, 0, 0, 0);
            }
        }
        if (more) AT_LWRITE((t + 1) & 1);
        __syncthreads();
    }
#undef AT_GLOAD
#undef AT_LWRITE
    l += __shfl_xor(l, 32);
    const float inv = 1.f / l;
    bf16_t* orow = mix + qrow * DM + 512 + h * VD + 4 * hi;
#pragma unroll
    for (int g = 0; g < 4; ++g) {
        *(u32x2*)(orow + 8 * g) = pk4((f32x4){o0[4 * g] * inv, o0[4 * g + 1] * inv, o0[4 * g + 2] * inv, o0[4 * g + 3] * inv});
        *(u32x2*)(orow + 32 + 8 * g) = pk4((f32x4){o1[4 * g] * inv, o1[4 * g + 1] * inv, o1[4 * g + 2] * inv, o1[4 * g + 3] * inv});
    }
}
__device__ __forceinline__ void phase_attn_fast(const Ctx& c, LAS unsigned char* lds, int bid, int nb) {
    const int vcu = (nb % 8 == 0) ? (bid % 8) * (nb / 8) + bid / 8 : bid;
    for (int slot = vcu; slot < 256; slot += nb) {
        const int bh = slot >> 1;
        for (int i = 0; i < 4; ++i) { const int s_ = 2 * (slot & 1) + (i >> 1), qb = (i & 1) ? s_ : 7 - s_; attn_unit(c, lds, bh >> 3, bh & 7, qb); }
    }
}

__device__ __forceinline__ void phase_ret_naive(const Ctx& c, LAS unsigned char* lds, int bid, int nb) {
    const int tid = opaque_tid(), wid = tid >> 6, lane = tid & 63;
    const bf16_t* Q1 = c.b16(OFF_Q1); const bf16_t* K1 = c.b16(OFF_K1); const bf16_t* V1 = c.b16(OFF_V1); bf16_t* G1 = c.b16(OFF_G1);
    LAS float* qs = (LAS float*)(lds + wid * 1024);
    const long nitems = (long)NBATCH * RET_H * SEQ;
    for (long it = (long)bid * NWV + wid; it < nitems; it += (long)nb * NWV) {
        const int s = (int)(it & (SEQ - 1)), h = (int)((it >> 11) & 3), b = (int)(it >> 13), qrow = b * SEQ + s;
        { const u32x2 w = *(const u32x2*)(Q1 + (size_t)qrow * 1024 + h * RDK + 4 * lane); const f32x4 f = unpk4(w); qs[4 * lane] = f[0]; qs[4 * lane + 1] = f[1]; qs[4 * lane + 2] = f[2]; qs[4 * lane + 3] = f[3]; }
        asm volatile("s_waitcnt lgkmcnt(0)" ::: "memory");
        const float lg2 = log2f(1.f - exp2f(-5.f - (float)h));
        float o[8];
#pragma unroll
        for (int e = 0; e < 8; ++e) o[e] = 0.f;
        const int ntile = 2 + (s >> 6), qpos = NMETA + s;
        for (int t = 0; t < ntile; ++t) {
            int krow0, nvalid, kpos0;
            if (t == 0) { krow0 = MR; nvalid = NMETA; kpos0 = 0; } else { krow0 = b * SEQ + 64 * (t - 1); nvalid = min(64, s + 1 - 64 * (t - 1)); kpos0 = NMETA + 64 * (t - 1); }
            float sv = 0.f;
            { const bf16_t* kp = K1 + (size_t)(krow0 + lane) * 1024 + h * RDK;
#pragma unroll 4
              for (int j = 0; j < RDK / 8; ++j) { const u32x4 w = *(const u32x4*)(kp + 8 * j); const LAS float* qq = qs + 8 * j;
                sv += qq[0] * bf2f(w.x & 0xffffu) + qq[1] * bf2f(w.x >> 16) + qq[2] * bf2f(w.y & 0xffffu) + qq[3] * bf2f(w.y >> 16)
                    + qq[4] * bf2f(w.z & 0xffffu) + qq[5] * bf2f(w.z >> 16) + qq[6] * bf2f(w.w & 0xffffu) + qq[7] * bf2f(w.w >> 16); } }
            const float wv = lane < nvalid ? sv * exp2f(lg2 * (float)(qpos - kpos0 - lane)) : 0.f;
            for (int k = 0; k < nvalid; ++k) { const float wk = __shfl(wv, k); const u32x4 w = *(const u32x4*)(V1 + (size_t)(krow0 + k) * RMIX + h * RDV + 8 * lane);
                o[0] += wk * bf2f(w.x & 0xffffu); o[1] += wk * bf2f(w.x >> 16); o[2] += wk * bf2f(w.y & 0xffffu); o[3] += wk * bf2f(w.y >> 16);
                o[4] += wk * bf2f(w.z & 0xffffu); o[5] += wk * bf2f(w.z >> 16); o[6] += wk * bf2f(w.w & 0xffffu); o[7] += wk * bf2f(w.w >> 16); }
        }
        float ss = 0.f;
#pragma unroll
        for (int e = 0; e < 8; ++e) ss += o[e] * o[e];
        const float rstd = rsqrtf(wave_sum(ss) * (1.f / RDV) + LN_EPS);
        bf16_t* gp = G1 + (size_t)qrow * RMIX + h * RDV + 8 * lane; const u32x4 gw = *(const u32x4*)gp;
        u32x4 r; r.x = pk2(bf2f(gw.x & 0xffffu) * o[0] * rstd, bf2f(gw.x >> 16) * o[1] * rstd); r.y = pk2(bf2f(gw.y & 0xffffu) * o[2] * rstd, bf2f(gw.y >> 16) * o[3] * rstd);
        r.z = pk2(bf2f(gw.z & 0xffffu) * o[4] * rstd, bf2f(gw.z >> 16) * o[5] * rstd); r.w = pk2(bf2f(gw.w & 0xffffu) * o[6] * rstd, bf2f(gw.w >> 16) * o[7] * rstd);
        *(u32x4*)gp = r;
    }
}

__device__ __forceinline__ unsigned off_b(unsigned row, unsigned ch) { return 256u * row + 16u * (ch ^ (((row & 3) << 2) | ((row >> 2) & 3))); }
constexpr int RT_Q = 0, RT_K = 32768, RT_V = 65536, RT_ST = 81920, RT_END = 147456;
__device__ __forceinline__ void ret_unit(const Ctx& c, LAS unsigned char* lds, int b, int h, int sl) {
    const int tid0 = opaque_tid(), wid = __builtin_amdgcn_readfirstlane(tid0 >> 6); int tid = tid0, lane = tid & 63, r32 = lane & 31, hi = lane >> 5;
    const int wi = wid & 1, wdv = wid >> 1;
    const int wk = wid & 3, wd = wid >> 2;
    const bf16_t* Q1 = c.b16(OFF_Q1) + h * RDK; const bf16_t* K1 = c.b16(OFF_K1) + h * RDK; bf16_t* V1 = c.b16(OFF_V1) + h * RDV + sl * 128;
    float* osq = c.f32(OFF_OSQ);
    const float lg2 = log2f(1.f - exp2f(-5.f - (float)h));
    const float g64 = exp2f(lg2 * 64.f);
    const int il = 32 * wi + r32;
    const float rowscale = exp2f(lg2 * (float)(il - 63));
    u32x4 gq[4], gk[4], gv[2];
    f32x16 S[2][2];
#pragma unroll
    for (int a = 0; a < 2; ++a)
#pragma unroll
        for (int bb = 0; bb < 2; ++bb)
#pragma unroll
            for (int r = 0; r < 16; ++r) S[a][bb][r] = 0.f;
#define RT_GLOAD(cc) do { const size_t base_ = (cc) == 0 ? (size_t)MR : (size_t)b * SEQ + 64 * ((cc) - 1); \
        _Pragma("unroll") for (int k_ = 0; k_ < 4; ++k_) { const int p_ = tid + 512 * k_; gq[k_] = *(const u32x4*)(Q1 + (base_ + (p_ >> 5)) * 1024 + 8 * (p_ & 31)); gk[k_] = *(const u32x4*)(K1 + (base_ + (p_ >> 5)) * 1024 + 8 * (p_ & 31)); } \
        _Pragma("unroll") for (int k_ = 0; k_ < 2; ++k_) { const int p_ = tid + 512 * k_; gv[k_] = *(const u32x4*)(V1 + (base_ + (p_ >> 4)) * RMIX + 8 * (p_ & 15)); } } while (0)
#define RT_LWRITE(cc) do { const int L_ = (cc) == 0 ? NMETA : 64; \
        _Pragma("unroll") for (int k_ = 0; k_ < 4; ++k_) { const int p_ = tid + 512 * k_, row_ = p_ >> 5, ch_ = p_ & 31; const unsigned o_ = (ch_ >> 4) * 16384 + off_b(row_, ch_ & 15); \
            *(LAS u32x4*)(lds + RT_Q + o_) = gq[k_]; *(LAS u32x4*)(lds + RT_K + o_) = gk[k_]; } \
        _Pragma("unroll") for (int k_ = 0; k_ < 2; ++k_) { const int p_ = tid + 512 * k_, row_ = p_ >> 4, ch_ = p_ & 15; \
            const float fc_ = row_ < L_ ? exp2f(lg2 * (float)(L_ - 1 - row_)) : 0.f; const u32x4 w_ = gv[k_]; u32x4 r_; \
            r_.x = pk2(bf2f(w_.x & 0xffffu) * fc_, bf2f(w_.x >> 16) * fc_); r_.y = pk2(bf2f(w_.y & 0xffffu) * fc_, bf2f(w_.y >> 16) * fc_); \
            r_.z = pk2(bf2f(w_.z & 0xffffu) * fc_, bf2f(w_.z >> 16) * fc_); r_.w = pk2(bf2f(w_.w & 0xffffu) * fc_, bf2f(w_.w >> 16) * fc_); \
            *(LAS u32x4*)(lds + RT_V + off_b(row_, ch_)) = r_; } } while (0)
    for (int i = tid; i < 65536 / 16; i += 512) *(LAS u32x4*)(lds + RT_ST + i * 16) = (u32x4){0u, 0u, 0u, 0u};
    RT_GLOAD(0); RT_LWRITE(0);
    __syncthreads();
    for (int cc = 0; cc <= 32; ++cc) {
        const bool more = cc < 32;
        tid = tid0; asm volatile("" : "+v"(tid)); lane = tid & 63; r32 = lane & 31; hi = lane >> 5;
        const unsigned h5 = lane >> 5, blk = (lane >> 4) & 1, q4 = (lane & 15) >> 2, p3 = lane & 3;
        if (more) RT_GLOAD(cc + 1);
        f32x16 P0, P1, acc;
#pragma unroll
        for (int r = 0; r < 16; ++r) { P0[r] = 0.f; P1[r] = 0.f; acc[r] = 0.f; }
#pragma unroll
        for (int s = 0; s < 16; ++s) {
            const unsigned hf = (s >> 3) * 16384, ch = 2 * (s & 7) + h5;
            const bf16x8 qf = *(const LAS bf16x8*)(lds + RT_Q + hf + off_b(32 * wi + r32, ch));
            const bf16x8 k0 = *(const LAS bf16x8*)(lds + RT_K + hf + off_b(r32, ch)), k1 = *(const LAS bf16x8*)(lds + RT_K + hf + off_b(32 + r32, ch));
            const bf16x8 sf = *(const LAS bf16x8*)(lds + RT_ST + (s >> 3) * 32768 + off_b(32 * wdv + r32, ch));
            P0 = __builtin_amdgcn_mfma_f32_32x32x16_bf16(k0, qf, P0, 0, 0, 0);
            P1 = __builtin_amdgcn_mfma_f32_32x32x16_bf16(k1, qf, P1, 0, 0, 0);
            acc = __builtin_amdgcn_mfma_f32_32x32x16_bf16(sf, qf, acc, 0, 0, 0);
        }
#pragma unroll
        for (int r = 0; r < 16; ++r) { const int j = crow(r, hi); if (j > il) P0[r] = 0.f; if (j + 32 > il) P1[r] = 0.f; acc[r] *= g64; }
        u32x4 pw[4];
#pragma unroll
        for (int e = 0; e < 4; ++e) { pw[0][e] = pk2(P0[2 * e], P0[2 * e + 1]); pw[1][e] = pk2(P0[8 + 2 * e], P0[9 + 2 * e]); pw[2][e] = pk2(P1[2 * e], P1[2 * e + 1]); pw[3][e] = pk2(P1[8 + 2 * e], P1[9 + 2 * e]); }
#pragma unroll
        for (int ks = 0; ks < 4; ++ks) {
            const unsigned chv = 4 * wdv + 2 * blk + (p3 >> 1);
            const bf16x8 vf = tr_pair(lds + RT_V + off_b(16 * ks + 4 * h5 + q4, chv) + 8 * (p3 & 1), lds + RT_V + off_b(16 * ks + 4 * h5 + 8 + q4, chv) + 8 * (p3 & 1));
            acc = __builtin_amdgcn_mfma_f32_32x32x16_bf16(vf, __builtin_bit_cast(bf16x8, pw[ks]), acc, 0, 0, 0);
        }
        if (cc > 0) {
            const size_t row = (size_t)b * SEQ + 64 * (cc - 1) + il;
            float ss = 0.f;
            bf16_t* orow = V1 + row * RMIX + 32 * wdv + 4 * hi;
#pragma unroll
            for (int g = 0; g < 4; ++g) {
                const f32x4 ov = (f32x4){acc[4 * g] * rowscale, acc[4 * g + 1] * rowscale, acc[4 * g + 2] * rowscale, acc[4 * g + 3] * rowscale};
                ss += ov[0] * ov[0] + ov[1] * ov[1] + ov[2] * ov[2] + ov[3] * ov[3];
                *(u32x2*)(orow + 8 * g) = pk4(ov);
            }
            ss += __shfl_xor(ss, 32);
            if (hi == 0) osq[(row * 4 + h) * 16 + sl * 4 + wdv] = ss;
        }
        {
            const float gl = cc == 0 ? 1.f : g64;
#pragma unroll
            for (int a = 0; a < 2; ++a)
#pragma unroll
                for (int bb = 0; bb < 2; ++bb)
#pragma unroll
                    for (int r = 0; r < 16; ++r) S[a][bb][r] *= gl;
#pragma unroll
            for (int ks = 0; ks < 4; ++ks) {
                bf16x8 kf[2], vf[2];
#pragma unroll
                for (int a = 0; a < 2; ++a) {
                    const unsigned chk = 4 * (2 * (wk & 1) + a) + 2 * blk + (p3 >> 1), hfk = (wk >> 1) * 16384;
                    kf[a] = tr_pair(lds + RT_K + hfk + off_b(16 * ks + 8 * h5 + q4, chk) + 8 * (p3 & 1), lds + RT_K + hfk + off_b(16 * ks + 8 * h5 + 4 + q4, chk) + 8 * (p3 & 1));
                    const unsigned chv = 4 * (2 * wd + a) + 2 * blk + (p3 >> 1);
                    vf[a] = tr_pair(lds + RT_V + off_b(16 * ks + 8 * h5 + q4, chv) + 8 * (p3 & 1), lds + RT_V + off_b(16 * ks + 8 * h5 + 4 + q4, chv) + 8 * (p3 & 1));
                }
#pragma unroll
                for (int a = 0; a < 2; ++a)
#pragma unroll
                    for (int bb = 0; bb < 2; ++bb) S[a][bb] = __builtin_amdgcn_mfma_f32_32x32x16_bf16(kf[a], vf[bb], S[a][bb], 0, 0, 0);
            }
        }
        __syncthreads();
        if (more) {
#pragma unroll
            for (int a = 0; a < 2; ++a)
#pragma unroll
                for (int bb = 0; bb < 2; ++bb)
#pragma unroll
                    for (int g = 0; g < 4; ++g) {
                        const unsigned dvr = 64 * wd + 32 * bb + r32, chunk = 8 * (wk & 1) + 4 * a + g;
                        *(LAS u32x2*)(lds + RT_ST + (wk >> 1) * 32768 + off_b(dvr, chunk) + 8 * hi) = pk4((f32x4){S[a][bb][4 * g], S[a][bb][4 * g + 1], S[a][bb][4 * g + 2], S[a][bb][4 * g + 3]});
                    }
            RT_LWRITE(cc + 1);
        }
        __syncthreads();
    }
#undef RT_GLOAD
#undef RT_LWRITE
}
__device__ __forceinline__ void phase_ret_fast(const Ctx& c, LAS unsigned char* lds, int bid, int nb) {
    const int vcu = (nb % 8 == 0) ? (bid % 8) * (nb / 8) + bid / 8 : bid;
    for (int u = vcu; u < 256; u += nb) ret_unit(c, lds, u >> 4, (u >> 2) & 3, u & 3);
}
__device__ __forceinline__ void phase_gatepass(const Ctx& c, int bid, int nb) {
    const int tid = opaque_tid(), wid = tid >> 6, lane = tid & 63;
    const bf16_t* O = c.b16(OFF_V1); bf16_t* G1 = c.b16(OFF_G1); const float* osq = c.f32(OFF_OSQ);
    for (int row = bid * NWV + wid; row < MR; row += nb * NWV) {
        float sq = osq[(size_t)row * 64 + lane];
        sq += __shfl_xor(sq, 1); sq += __shfl_xor(sq, 2); sq += __shfl_xor(sq, 4); sq += __shfl_xor(sq, 8);
        const float rs = rsqrtf(sq * (1.f / RDV) + LN_EPS);
#pragma unroll
        for (int k = 0; k < 4; ++k) {
            const float r = __shfl(rs, 16 * k);
            const size_t off = (size_t)row * RMIX + 512 * k + 8 * lane;
            const u32x4 ow = *(const u32x4*)(O + off), gw = *(const u32x4*)(G1 + off);
            u32x4 o;
            o.x = pk2(bf2f(gw.x & 0xffffu) * bf2f(ow.x & 0xffffu) * r, bf2f(gw.x >> 16) * bf2f(ow.x >> 16) * r);
            o.y = pk2(bf2f(gw.y & 0xffffu) * bf2f(ow.y & 0xffffu) * r, bf2f(gw.y >> 16) * bf2f(ow.y >> 16) * r);
            o.z = pk2(bf2f(gw.z & 0xffffu) * bf2f(ow.z & 0xffffu) * r, bf2f(gw.z >> 16) * bf2f(ow.z >> 16) * r);
            o.w = pk2(bf2f(gw.w & 0xffffu) * bf2f(ow.w & 0xffffu) * r, bf2f(gw.w >> 16) * bf2f(ow.w >> 16) * r);
            *(u32x4*)(G1 + off) = o;
        }
    }
}

__device__ __forceinline__ void phase_final(const Ctx& c, int bid, int nb) {
    const int tid = opaque_tid(), wid = tid >> 6, lane = tid & 63;
    const float* g = c.in[21] + 1024; const float* bv = c.in[22] + 1024;
    for (int row = bid * NWV + wid; row < MR; row += nb * NWV) {
        f32x4* zr = (f32x4*)(c.out + (size_t)row * DM) + lane;
        f32x4 v[4]; float s = 0.f;
#pragma unroll
        for (int j = 0; j < 4; ++j) { v[j] = zr[64 * j]; s += (v[j][0] + v[j][1]) + (v[j][2] + v[j][3]); }
        const float mean = wave_sum(s) * (1.f / DM); float s2 = 0.f;
#pragma unroll
        for (int j = 0; j < 4; ++j) { v[j] = v[j] - mean; s2 += (v[j][0] * v[j][0] + v[j][1] * v[j][1]) + (v[j][2] * v[j][2] + v[j][3] * v[j][3]); }
        const float rstd = rsqrtf(wave_sum(s2) * (1.f / DM) + LN_EPS);
#pragma unroll
        for (int j = 0; j < 4; ++j) zr[64 * j] = v[j] * rstd * *(const f32x4*)(g + 256 * j + 4 * lane) + *(const f32x4*)(bv + 256 * j + 4 * lane);
    }
}

enum { PH_PRO = 0, PH_IN0, PH_PREP, PH_GATE, PH_ATTN, PH_SCAN2, PH_OUT0, PH_UP0, PH_DOWN0, PH_IN1, PH_RET, PH_GPASS, PH_OUT1, PH_UP1, PH_DOWN1, PH_FINAL, NPH };
constexpr int LDS_BYTES = 147456;
static_assert(NPH == 16, "phase list");

__device__ __forceinline__ void run_phase(int ph, const Ctx& c, const Params& p, LAS unsigned char* lds, int bid, int nb) {
    const float* stA = c.f32(OFF_STATA); const float* stB = c.f32(OFF_STATB); const float* cv = c.f32(OFF_C12);
    switch (ph) {
    case PH_PRO: phase_prologue(c, p, lds, bid, nb); break;
    case PH_IN0: {
        Gemm g{c.b16(OFF_XB), c.b16(OFF_WIN0), MP, N_IN0, 1024, 1024, 1024, 0};
        EpiIn0 e{c.b16(OFF_P0), c.f32(OFF_SSQQ), c.f32(OFF_SSQKV)};
        run_gemm(lds, g, e, bid, nb);
    } break;
    case PH_PREP: {
        phase_conv(c, bid, nb);
        { Gemm g{c.b16(OFF_P0) + 1024, c.b16(OFF_WUQ), MP, NQ, QRANK, N_IN0, QRANK, 0};
          EpiQup e{c.b16(OFF_Q), c.f32(OFF_SSQQ), c.f32(OFF_ROPE0C), c.f32(OFF_ROPE0S)}; run_gemm(lds, g, e, bid, nb); }
        { Gemm g{c.b16(OFF_P0) + 1280, c.b16(OFF_WUKV), MP, 1024, KVRANK, N_IN0, KVRANK, 0};
          EpiKVup e{c.b16(OFF_K), c.b16(OFF_V), c.f32(OFF_SSQKV)}; run_gemm(lds, g, e, bid, nb); }
    } break;
    case PH_GATE: {
        Gemm g{c.b16(OFF_XC), c.b16(OFF_WGATE), MP, 1024, 128, LRUW, 128, 128};
        EpiGate e{c, c.b16(OFF_XC), c.f32(OFF_CCH), c.in[6], c.in[8]};
        run_gemm(lds, g, e, bid, nb);
    } break;
#if FAST_ATTN
    case PH_ATTN: phase_scan1(c, bid, nb); phase_attn_naive(c, bid, nb, true); phase_attn_fast(c, lds, bid, nb); break;
#else
    case PH_ATTN: phase_scan1(c, bid, nb); phase_attn_naive(c, bid, nb, false); break;
#endif
    case PH_SCAN2: phase_scan2(c, bid, nb); break;
    case PH_OUT0: {
        Gemm g{c.b16(OFF_MIX), c.b16(OFF_WOUT0), MP, 1024, 1024, 1024, 1024, 0};
        EpiRes<0, false> e{c, c.b16(OFF_ZB), nullptr, c.f32(OFF_STATA), nullptr, nullptr, c.in[0], c.in[1]};
        run_gemm(lds, g, e, bid, nb);
    } break;
    case PH_UP0: {
        Gemm g{c.b16(OFF_ZB), c.b16(OFF_W1_0), MP, FF, 1024, 1024, 1024, 0};
        EpiMlpUp e{c.b16(OFF_HID), stA, cv + C1_UP0, cv + C2_UP0};
        run_gemm(lds, g, e, bid, nb);
    } break;
    case PH_DOWN0: {
        Gemm g{c.b16(OFF_HID), c.b16(OFF_W2_0), MP, 1024, FF, FF, FF, 0};
        EpiRes<1, false> e{c, c.b16(OFF_ZB), stA, c.f32(OFF_STATB), c.in[17], c.in[18], nullptr, nullptr};
        run_gemm(lds, g, e, bid, nb);
    } break;
    case PH_IN1: {
        Gemm g{c.b16(OFF_ZB), c.b16(OFF_WIN1), MP, N_IN1, 1024, 1024, 1024, 0};
        EpiIn1 e{c.b16(OFF_Q1), c.b16(OFF_K1), c.b16(OFF_V1), c.b16(OFF_G1), stB, cv + C1_IN1, cv + C2_IN1, c.f32(OFF_ROPE1C), c.f32(OFF_ROPE1S)};
        run_gemm(lds, g, e, bid, nb);
    } break;
#if FAST_RET
    case PH_RET: phase_ret_fast(c, lds, bid, nb); break;
    case PH_GPASS: phase_gatepass(c, bid, nb); break;
#else
    case PH_RET: phase_ret_naive(c, lds, bid, nb); break;
#endif
    case PH_OUT1: {
        Gemm g{c.b16(OFF_G1), c.b16(OFF_WOUT1), MR, 1024, RMIX, RMIX, RMIX, 0};
        EpiRes<1, false> e{c, c.b16(OFF_ZB), stB, c.f32(OFF_STATA), c.in[21], c.in[22], nullptr, nullptr};
        run_gemm(lds, g, e, bid, nb);
    } break;
    case PH_UP1: {
        Gemm g{c.b16(OFF_ZB), c.b16(OFF_W1_1), MR, FF, 1024, 1024, 1024, 0};
        EpiMlpUp e{c.b16(OFF_HID), stA, cv + C1_UP1, cv + C2_UP1};
        run_gemm(lds, g, e, bid, nb);
    } break;
    case PH_DOWN1: {
        Gemm g{c.b16(OFF_HID), c.b16(OFF_W2_1), MR, 1024, FF, FF, FF, 0};
        EpiRes<1, true> e{c, c.b16(OFF_ZB), stA, nullptr, c.in[17] + 1024, c.in[18] + 1024, nullptr, nullptr};
        run_gemm(lds, g, e, bid, nb);
    } break;
    case PH_FINAL: phase_final(c, bid, nb); break;
    default: break;
    }
}

#if N_LAUNCH_MODE == 1
__global__ void __launch_bounds__(512, 2) k_fwd(Params p) {
    extern __shared__ __attribute__((aligned(16))) unsigned char lds_raw[];
    LAS unsigned char* lds = (LAS unsigned char*)lds_raw;
    Ctx c{p.in, p.out, p.ws};
    const int bid = blockIdx.x, nb = gridDim.x;
    const int lo = (int)p.ph_lo, hi = (int)p.ph_hi;
#define PHASE(k) if (lo <= (k) && (k) < hi) { run_phase((k), c, p, lds, bid, nb); if ((k) + 1 < hi) cg::this_grid().sync(); }
    PHASE(0) PHASE(1) PHASE(2) PHASE(3) PHASE(4) PHASE(5) PHASE(6) PHASE(7) PHASE(8) PHASE(9) PHASE(10) PHASE(11) PHASE(12) PHASE(13) PHASE(14) PHASE(15)
#undef PHASE
}
#else
template <int PH> __global__ void __launch_bounds__(512, 2) k_one(Params p) {
    extern __shared__ __attribute__((aligned(16))) unsigned char lds_raw[];
    LAS unsigned char* lds = (LAS unsigned char*)lds_raw;
    Ctx c{p.in, p.out, p.ws};
    run_phase(PH, c, p, lds, blockIdx.x, gridDim.x);
}
template <int PH> static void launch_one(int grid, const Params& p, hipStream_t stream) {
    static bool attr = false;
    if (!attr) { (void)hipFuncSetAttribute((const void*)k_one<PH>, hipFuncAttributeMaxDynamicSharedMemorySize, LDS_BYTES); attr = true; }
    hipLaunchKernelGGL(k_one<PH>, dim3(grid), dim3(512), LDS_BYTES, stream, p);
}
#endif

extern "C" void kernel_launch(void* const* d_in, const int* in_sizes, int n_in, void* d_out, int out_size, void* d_ws, size_t ws_size, hipStream_t stream) {
    static int grid = 0;
    if (grid == 0) {
        int dev = 0, cus = 0;
        if (hipGetDevice(&dev) != hipSuccess || hipDeviceGetAttribute(&cus, hipDeviceAttributeMultiprocessorCount, dev) != hipSuccess) { grid = -1; return; }
#if N_LAUNCH_MODE == 1
        if (hipFuncSetAttribute((const void*)k_fwd, hipFuncAttributeMaxDynamicSharedMemorySize, LDS_BYTES) != hipSuccess) { grid = -1; return; }
        int per_cu = 0;
        if (hipOccupancyMaxActiveBlocksPerMultiprocessor(&per_cu, (const void*)k_fwd, 512, LDS_BYTES) != hipSuccess || per_cu < 1) { fprintf(stderr, "occupancy query: %d\n", per_cu); }
        (void)hipGetLastError();
#endif
        grid = cus;
        if (n_in != 23 || ws_size < WS_END) { fprintf(stderr, "kernel_launch: unexpected n_in %d / ws %zu\n", n_in, ws_size); grid = -1; return; }
    }
    if (grid < 0) return;
    (void)hipMemsetAsync((char*)d_ws + OFF_CTL, 0, SZ_CTL, stream);
    (void)hipMemsetAsync((char*)d_ws + OFF_C12, 0, 128 * KB, stream);
    Params p{};
    for (int i = 0; i < 23; ++i) p.in[i] = (const float*)d_in[i];
    p.out = (float*)d_out; p.ws = (unsigned char*)d_ws;
    for (int j = 0; j < 16; ++j) p.inv0[j] = pow(10000.0, -(double)j / 16.0);
    for (int j = 0; j < 128; ++j) p.inv1[j] = pow(10000.0, -(double)j / 128.0);
#if N_LAUNCH_MODE == 1
    p.ph_lo = 0; p.ph_hi = NPH;
    void* args[] = {&p};
    hipError_t e = hipLaunchCooperativeKernel((const void*)k_fwd, dim3(grid), dim3(512), args, LDS_BYTES, stream);
    if (e != hipSuccess) fprintf(stderr, "cooperative launch failed: %s (grid %d)\n", hipGetErrorString(e), grid);
#else
    launch_one<0>(grid, p, stream); launch_one<1>(grid, p, stream); launch_one<2>(grid, p, stream); launch_one<3>(grid, p, stream); launch_one<4>(grid, p, stream);
    launch_one<5>(grid, p, stream); launch_one<6>(grid, p, stream); launch_one<7>(grid, p, stream); launch_one<8>(grid, p, stream); launch_one<9>(grid, p, stream);
    launch_one<10>(grid, p, stream); launch_one<11>(grid, p, stream); launch_one<12>(grid, p, stream); launch_one<13>(grid, p, stream); launch_one<14>(grid, p, stream); launch_one<15>(grid, p, stream);
#endif
}
```

```cpp
#include <hip/hip_runtime.h>
#include <hip/hip_cooperative_groups.h>
#include <stdint.h>
#include <stdio.h>
namespace cg = cooperative_groups;

#ifndef FAST_GEMM
#define FAST_GEMM 1
#endif
#ifndef FAST_ATTN
#define FAST_ATTN 1
#endif
#ifndef FAST_RET
#define FAST_RET 1
#endif
#ifndef N_LAUNCH_MODE
#define N_LAUNCH_MODE 1
#endif

#define LAS __attribute__((address_space(3)))
typedef unsigned short bf16_t;
typedef short bf16x8 __attribute__((ext_vector_type(8)));
typedef float f32x4 __attribute__((ext_vector_type(4)));
typedef float f32x2 __attribute__((ext_vector_type(2)));
typedef unsigned u32x4 __attribute__((ext_vector_type(4)));
typedef unsigned u32x2 __attribute__((ext_vector_type(2)));
typedef __bf16 bf16x2_t __attribute__((ext_vector_type(2)));

constexpr int DM = 1024, NBATCH = 16, SEQ = 2048, NMETA = 16, TT = SEQ + NMETA;
constexpr int MR = NBATCH * SEQ;
constexpr int MP = MR + 256;
constexpr int LRUW = 512, EVEN_IN = 1440, N_IN0 = 1536, QRANK = 256, KVRANK = 128;
constexpr int MLA_H = 8, QKD = 96, VD = 64, NQ = MLA_H * QKD  , NV = MLA_H * VD  ;
constexpr int FF = 4096, N_IN1 = 6144, RET_H = 4, RDK = 256, RDV = 512, RMIX = 2048;
constexpr float LN_EPS = 1e-5f;
constexpr float DN_ALPHA = 1.41421356237309515f;
constexpr float QSCALE = 0.10206207261596575f * 1.4426950408889634f;

constexpr size_t KB = 1024, MB = 1024 * 1024;
constexpr size_t OFF_CTL = 0;
constexpr size_t SZ_CTL = 64 * KB;
constexpr size_t OFF_ROPE0C = OFF_CTL + SZ_CTL;
constexpr size_t OFF_ROPE0S = OFF_ROPE0C + 132 * KB;
constexpr size_t OFF_ROPE1C = OFF_ROPE0S + 132 * KB;
constexpr size_t OFF_ROPE1S = OFF_ROPE1C + 1056 * KB;
constexpr size_t OFF_CCH = OFF_ROPE1S + 1056 * KB;
constexpr size_t OFF_C12 = OFF_CCH + 4 * KB;
constexpr size_t OFF_SSQQ = OFF_C12 + 128 * KB;
constexpr size_t OFF_SSQKV = OFF_SSQQ + 528 * KB;
constexpr size_t OFF_STATA = OFF_SSQKV + 528 * KB;
constexpr size_t OFF_STATB = OFF_STATA + (size_t)MP * 128;
constexpr size_t OFF_ZMETA = OFF_STATB + (size_t)MP * 128;
constexpr size_t OFF_ABMETA = OFF_ZMETA + MB;
constexpr size_t OFF_CARRY = OFF_ABMETA + MB;
constexpr size_t OFF_W = 18 * MB;
static_assert(OFF_CARRY + 2 * MB <= OFF_W, "small buffers");
constexpr size_t OFF_WIN1 = OFF_W;
constexpr size_t OFF_WOUT1 = OFF_WIN1 + (size_t)6144 * 1024 * 2;
constexpr size_t OFF_W1_1 = OFF_WOUT1 + (size_t)2048 * 1024 * 2;
constexpr size_t OFF_W2_1 = OFF_W1_1 + (size_t)4096 * 1024 * 2;
constexpr size_t OFF_BIG = 50 * MB;
static_assert(OFF_W2_1 + (size_t)4096 * 1024 * 2 <= OFF_BIG, "weights");
constexpr size_t SZ_ROW1K = (size_t)MP * 1024 * 2;
constexpr size_t OFF_XB = OFF_BIG;
constexpr size_t OFF_P0 = OFF_XB + SZ_ROW1K;
constexpr size_t OFF_Q = OFF_P0 + (size_t)MP * 1536 * 2;
constexpr size_t OFF_K = OFF_Q + (size_t)MP * 768 * 2;
constexpr size_t OFF_V = OFF_K + (size_t)MP * 768 * 2;
constexpr size_t OFF_XC = OFF_V + (size_t)MP * 512 * 2;
constexpr size_t OFF_MIX = OFF_XC;
constexpr size_t OFF_HID = OFF_BIG;
constexpr size_t OFF_Q1 = OFF_BIG;
constexpr size_t OFF_K1 = OFF_Q1 + SZ_ROW1K;
constexpr size_t OFF_V1 = OFF_K1 + SZ_ROW1K;
constexpr size_t OFF_G1 = OFF_V1 + 2 * SZ_ROW1K;
constexpr size_t OFF_W0 = 415 * MB;
constexpr size_t OFF_WIN0 = OFF_W0;
constexpr size_t OFF_WGATE = OFF_WIN0 + (size_t)N_IN0 * 1024 * 2;
constexpr size_t OFF_WUQ = OFF_WGATE + 1024 * 128 * 2;
constexpr size_t OFF_WUKV = OFF_WUQ + 768 * 256 * 2;
constexpr size_t OFF_WOUT0 = OFF_WUKV + 1024 * 128 * 2;
constexpr size_t OFF_W1_0 = OFF_WOUT0 + 1024 * 1024 * 2;
constexpr size_t OFF_W2_0 = OFF_W1_0 + (size_t)4096 * 1024 * 2;
constexpr size_t OFF_ZB = 438 * MB;
constexpr size_t WS_END = 504 * MB;
static_assert(OFF_MIX + SZ_ROW1K <= OFF_W0 && OFF_HID + (size_t)MP * 4096 * 2 <= OFF_W0 && OFF_G1 + 2 * SZ_ROW1K <= OFF_ZB && OFF_W2_0 + (size_t)4096 * 1024 * 2 <= OFF_ZB && OFF_ZB + SZ_ROW1K <= WS_END, "ws map");

struct Params { const float* in[23]; float* out; unsigned char* ws; long long ph_lo, ph_hi; double inv0[16]; double inv1[128]; };

__device__ __forceinline__ int opaque_tid() { int t = threadIdx.x; asm volatile("" : "+v"(t)); return t; }
__device__ __forceinline__ float bf2f(unsigned v) { return __uint_as_float(v << 16); }
__device__ __forceinline__ unsigned pk2(float lo, float hi) { f32x2 v = {lo, hi}; bf16x2_t b = __builtin_convertvector(v, bf16x2_t); return __builtin_bit_cast(unsigned, b); }
__device__ __forceinline__ u32x2 pk4(f32x4 v) { u32x2 r; r.x = pk2(v[0], v[1]); r.y = pk2(v[2], v[3]); return r; }
__device__ __forceinline__ f32x4 unpk4(u32x2 w) { return (f32x4){bf2f(w.x & 0xffffu), bf2f(w.x >> 16), bf2f(w.y & 0xffffu), bf2f(w.y >> 16)}; }
__device__ __forceinline__ float bfround(float x) { return bf2f(pk2(x, 0.f) & 0xffffu); }
__device__ __forceinline__ float wave_sum(float v) {
#pragma unroll
    for (int o = 1; o < 64; o <<= 1) v += __shfl_xor(v, o);
    return v;
}
__device__ __forceinline__ float wave_max(float v) {
#pragma unroll
    for (int o = 1; o < 64; o <<= 1) v = fmaxf(v, __shfl_xor(v, o));
    return v;
}
__device__ __forceinline__ float frcp(float x) { return __builtin_amdgcn_rcpf(x); }
__device__ __forceinline__ float frsq(float x) { return __builtin_amdgcn_rsqf(x); }
__device__ __forceinline__ float fsqrt(float x) { return __builtin_amdgcn_sqrtf(x); }
__device__ __forceinline__ float sigmoidf_(float x) { return frcp(1.f + __expf(-x)); }
__device__ __forceinline__ float gelu_tanh(float x) { const float u = 0.7978845608028654f * (x + 0.044715f * x * x * x); const float t = 1.f - 2.f * frcp(1.f + __expf(2.f * u)); return 0.5f * x * (1.f + t); }
__device__ __forceinline__ int row_pos(int row) { return row < MR ? NMETA + (row & (SEQ - 1)) : (row - MR); }

struct Ctx {
    const float* const* in; float* out; unsigned char* ws;
    __device__ __forceinline__ bf16_t* b16(size_t off) const { return (bf16_t*)(ws + off); }
    __device__ __forceinline__ float* f32(size_t off) const { return (float*)(ws + off); }
    __device__ __forceinline__ unsigned* abrow(int row) const { return row < MR ? (unsigned*)out + (size_t)row * LRUW : (unsigned*)f32(OFF_ABMETA) + (size_t)(row - MR) * LRUW; }
};

struct Gemm { const bf16_t* A; const bf16_t* Bt; int M, N, K, lda, ldb, a_pn_off; };

__device__ __forceinline__ void row_stats(const float* st, int row, int fq, float& mean, float& rstd) {
    const f32x4* p = (const f32x4*)(st + (size_t)row * 32 + fq * 8);
    const f32x4 a = p[0], b = p[1];
    float s1 = a[0] + a[2] + b[0] + b[2], s2 = a[1] + a[3] + b[1] + b[3];
    s1 += __shfl_xor(s1, 16); s2 += __shfl_xor(s2, 16); s1 += __shfl_xor(s1, 32); s2 += __shfl_xor(s2, 32);
    mean = s1 * (1.f / DM); const float var = fmaxf(s2 * (1.f / DM) - mean * mean, 0.f); rstd = frsq(var + LN_EPS);
}
__device__ __forceinline__ void put_stats(float* st, int row, int pn, int q0, const f32x4 (&v)[2][2]) {
    float s1 = 0.f, s2 = 0.f;
#pragma unroll
    for (int bj = 0; bj < 2; ++bj)
#pragma unroll
        for (int n = 0; n < 2; ++n)
#pragma unroll
            for (int e = 0; e < 4; ++e) { s1 += v[bj][n][e]; s2 += v[bj][n][e] * v[bj][n][e]; }
    s1 += __shfl_xor(s1, 16); s2 += __shfl_xor(s2, 16); s1 += __shfl_xor(s1, 32); s2 += __shfl_xor(s2, 32);
    if (((q0 >> 2) & 7) == 0) *(f32x2*)(st + (size_t)row * 32 + (pn * 4 + (q0 >> 5)) * 2) = (f32x2){s1, s2};
}

constexpr int ROT_OFF = 131072 + 12 * 2048;
struct RowS { float a, b; };
struct NoCol {}; struct NoRow {};
__device__ __forceinline__ u32x4 pk8(f32x4 a, f32x4 b) { u32x4 r; r.x = pk2(a[0], a[1]); r.y = pk2(a[2], a[3]); r.z = pk2(b[0], b[1]); r.w = pk2(b[2], b[3]); return r; }
__device__ __forceinline__ void unpk8(u32x4 w, f32x4& a, f32x4& b) { a = (f32x4){bf2f(w.x & 0xffffu), bf2f(w.x >> 16), bf2f(w.y & 0xffffu), bf2f(w.y >> 16)}; b = (f32x4){bf2f(w.z & 0xffffu), bf2f(w.z >> 16), bf2f(w.w & 0xffffu), bf2f(w.w >> 16)}; }
__device__ __forceinline__ void put_stats8(float* st, int row, int pn, int wc, int fq, const f32x4 (&v)[2][2]) {
    float s1 = 0.f, s2 = 0.f;
#pragma unroll
    for (int bj = 0; bj < 2; ++bj)
#pragma unroll
        for (int n = 0; n < 2; ++n)
#pragma unroll
            for (int e = 0; e < 4; ++e) { s1 += v[bj][n][e]; s2 += v[bj][n][e] * v[bj][n][e]; }
    s1 += __shfl_xor(s1, 16); s2 += __shfl_xor(s2, 16); s1 += __shfl_xor(s1, 32); s2 += __shfl_xor(s2, 32);
    if (fq == 0) *(f32x2*)(st + (size_t)row * 32 + (pn * 4 + wc) * 2) = (f32x2){s1, s2};
}

struct EpiIn0 {
    static constexpr bool HAS_INIT = false, PERM = true, ROW_AHEAD = true, USE_TAB = false;
    typedef NoCol ColS; typedef NoRow RowL;
    bf16_t* p0; float* ssq_q; float* ssq_kv;
    __device__ __forceinline__ ColS cols(int, int, int) const { return ColS{}; }
    __device__ __forceinline__ RowS pre(int, int) const { return RowS{0.f, 0.f}; }
    __device__ __forceinline__ RowL rload(int, int, int, int) const { return RowL{}; }
    __device__ __forceinline__ void apply(int row, int pn, int wc, int fq, f32x4 (&v)[2][2], RowS, const ColS&, const RowL&) const {
        bf16_t* base = p0 + (size_t)row * N_IN0 + 256 * pn + 32 * wc + 8 * fq;
#pragma unroll
        for (int bj = 0; bj < 2; ++bj) *(u32x4*)(base + 128 * bj) = pk8(v[bj][0], v[bj][1]);
        if (pn == 4 || pn == 5) {
            float s = 0.f;
#pragma unroll
            for (int n = 0; n < 2; ++n)
#pragma unroll
                for (int e = 0; e < 4; ++e) { s += v[0][n][e] * v[0][n][e]; if (pn == 4) s += v[1][n][e] * v[1][n][e]; }
            s += __shfl_xor(s, 16); s += __shfl_xor(s, 32);
            if (fq == 0) (pn == 4 ? ssq_q : ssq_kv)[(size_t)row * 4 + wc] = s;
        }
    }
};
struct EpiQup {
    static constexpr bool HAS_INIT = false, PERM = false, ROW_AHEAD = true, USE_TAB = false;
    typedef NoCol ColS; struct RowL { f32x4 c, s; };
    bf16_t* Q; const float* ssq_q; const float* rc; const float* rs;
    __device__ __forceinline__ ColS cols(int, int, int) const { return ColS{}; }
    __device__ __forceinline__ RowS pre(int row, int) const { const f32x4 sq = *(const f32x4*)(ssq_q + (size_t)row * 4); return RowS{frsq((sq[0] + sq[1] + sq[2] + sq[3]) * (1.f / QRANK) + LN_EPS) * QSCALE, 0.f}; }
    __device__ __forceinline__ RowL rload(int row, int, int, int fq) const { const int pos = row_pos(row); return RowL{*(const f32x4*)(rc + pos * 16 + 4 * fq), *(const f32x4*)(rs + pos * 16 + 4 * fq)}; }
    __device__ __forceinline__ void apply(int row, int pn, int wc, int fq, f32x4 (&v)[2][2], RowS rsv, const ColS&, const RowL& rl) const {
        const float r = rsv.a;
#pragma unroll
        for (int bj = 0; bj < 2; ++bj) {
            f32x4 x1 = v[bj][0] * r, x2 = v[bj][1] * r;
            const int G = 8 * pn + 4 * bj + wc;
            if ((G % 3) == 2) { const f32x4 y1 = x1 * rl.c - x2 * rl.s, y2 = x1 * rl.s + x2 * rl.c; x1 = y1; x2 = y2; }
            bf16_t* base = Q + (size_t)row * NQ + 256 * pn + 128 * bj + 32 * wc + 4 * fq;
            *(u32x2*)(base) = pk4(x1); *(u32x2*)(base + 16) = pk4(x2);
        }
    }
};
struct EpiKVup {
    static constexpr bool HAS_INIT = false, PERM = true, ROW_AHEAD = true, USE_TAB = false;
    typedef NoCol ColS; typedef NoRow RowL;
    bf16_t* K; bf16_t* V; const float* ssq_kv;
    __device__ __forceinline__ ColS cols(int, int, int) const { return ColS{}; }
    __device__ __forceinline__ RowS pre(int row, int) const { const f32x4 sq = *(const f32x4*)(ssq_kv + (size_t)row * 4); return RowS{frsq((sq[0] + sq[1] + sq[2] + sq[3]) * (1.f / KVRANK) + LN_EPS), 0.f}; }
    __device__ __forceinline__ RowL rload(int, int, int, int) const { return RowL{}; }
    __device__ __forceinline__ void apply(int row, int pn, int wc, int fq, f32x4 (&v)[2][2], RowS rsv, const ColS&, const RowL&) const {
        const float r = rsv.a; const int within = 32 * wc + 8 * fq;
#pragma unroll
        for (int bj = 0; bj < 2; ++bj) {
            const int head = 2 * pn + bj;
            bf16_t* dst = (wc < 2) ? K + (size_t)row * NQ + head * QKD + within : V + (size_t)row * NV + head * VD + (within - 64);
            *(u32x4*)dst = pk8(v[bj][0] * r, v[bj][1] * r);
        }
    }
};
struct EpiGate {
    static constexpr bool HAS_INIT = false, PERM = true, ROW_AHEAD = true, USE_TAB = false;
    struct ColS { f32x4 cc[2], va[2], vx[2]; }; struct RowL { u32x4 x; };
    Ctx c; const bf16_t* xc; const float* cch; const float* ba; const float* bx;
    __device__ __forceinline__ ColS cols(int pn, int wc, int fq) const { ColS k;
#pragma unroll
        for (int n = 0; n < 2; ++n) { const int ch = 128 * pn + 32 * wc + 8 * fq + 4 * n; k.cc[n] = *(const f32x4*)(cch + ch); k.va[n] = *(const f32x4*)(ba + ch); k.vx[n] = *(const f32x4*)(bx + ch); }
        return k; }
    __device__ __forceinline__ RowS pre(int, int) const { return RowS{0.f, 0.f}; }
    __device__ __forceinline__ RowL rload(int row, int pn, int wc, int fq) const { return RowL{*(const u32x4*)(xc + (size_t)row * LRUW + 128 * pn + 32 * wc + 8 * fq)}; }
    __device__ __forceinline__ void apply(int row, int pn, int wc, int fq, f32x4 (&v)[2][2], RowS, const ColS& k, const RowL& l) const {
        unsigned* abr = c.abrow(row);
        f32x4 xv[2]; unpk8(l.x, xv[0], xv[1]);
#pragma unroll
        for (int n = 0; n < 2; ++n) {
            const int ch = 128 * pn + 32 * wc + 8 * fq + 4 * n;
            u32x4 o;
#pragma unroll
            for (int e = 0; e < 4; ++e) {
                const float r = sigmoidf_(v[0][n][e] + k.va[n][e]), ig = sigmoidf_(v[1][n][e] + k.vx[n][e]);
                const float la = k.cc[n][e] * r;
                const float ds = -la * (1.f + la * (0.5f + la * (1.f / 6 + la * (1.f / 24 + la * (1.f / 120)))));
                const float d = la > -0.25f ? ds : 1.f - __expf(la);
                o[e] = pk2(d, fsqrt(fmaxf(d * (2.f - d), 0.f)) * (ig * xv[n][e]));
            }
            *(u32x4*)(abr + ch) = o;
        }
    }
};
template <int MODE, bool LAST> struct EpiRes {
    static constexpr bool HAS_INIT = true, PERM = true, ROW_AHEAD = true, USE_TAB = (MODE == 1);
    typedef NoCol ColS; typedef NoRow RowL; struct ColI { f32x4 g[2][2], b[2][2]; };
    Ctx c; bf16_t* zb; const float* st_in; float* st_out; const float* g; const float* b; const float* x; const float* meta;
    __device__ __forceinline__ ColI colsi(int pn, int wc, int fq) const { ColI k;
#pragma unroll
        for (int bj = 0; bj < 2; ++bj)
#pragma unroll
            for (int n = 0; n < 2; ++n) { const int col = 256 * pn + 128 * bj + 32 * wc + 8 * fq + 4 * n;
                if (MODE == 1) { k.g[bj][n] = *(const f32x4*)(g + col); k.b[bj][n] = *(const f32x4*)(b + col); } else { k.g[bj][n] = (f32x4){0.f, 0.f, 0.f, 0.f}; k.b[bj][n] = k.g[bj][n]; } }
        return k; }
    __device__ __forceinline__ RowS prei(int row, int fq) const { RowS r{0.f, 0.f}; if (MODE == 1) row_stats(st_in, row, fq, r.a, r.b); return r; }
    __device__ __forceinline__ void init_row(int row, int pn, int wc, int fq, f32x4 (&v)[2][2], RowS rsv, const ColI& k) const {
        const int cb = 256 * pn + 32 * wc + 8 * fq;
        if (MODE == 1) {
#pragma unroll
            for (int bj = 0; bj < 2; ++bj) { f32x4 z0, z1; unpk8(*(const u32x4*)(zb + (size_t)row * DM + cb + 128 * bj), z0, z1);
                v[bj][0] = ((z0 - rsv.a) * rsv.b * k.g[bj][0] + k.b[bj][0]) * DN_ALPHA; v[bj][1] = ((z1 - rsv.a) * rsv.b * k.g[bj][1] + k.b[bj][1]) * DN_ALPHA; }
        } else {
            const bf16_t* src = (const bf16_t*)x + (size_t)row * DM + cb;
#pragma unroll
            for (int bj = 0; bj < 2; ++bj) { f32x4 z0, z1; unpk8(*(const u32x4*)(src + 128 * bj), z0, z1); v[bj][0] = z0 * DN_ALPHA; v[bj][1] = z1 * DN_ALPHA; }
        }
    }
    __device__ __forceinline__ ColS cols(int, int, int) const { return ColS{}; }
    __device__ __forceinline__ RowS pre(int, int) const { return RowS{0.f, 0.f}; }
    __device__ __forceinline__ RowL rload(int, int, int, int) const { return RowL{}; }
    __device__ __forceinline__ void apply(int row, int pn, int wc, int fq, f32x4 (&v)[2][2], RowS, const ColS&, const RowL&) const {
        const int cb = 256 * pn + 32 * wc + 8 * fq;
#pragma unroll
        for (int bj = 0; bj < 2; ++bj) {
            if (LAST) { float* zr = c.out + (size_t)row * DM + cb + 128 * bj; *(f32x4*)zr = v[bj][0]; *(f32x4*)(zr + 4) = v[bj][1]; }
            else *(u32x4*)(zb + (size_t)row * DM + cb + 128 * bj) = pk8(v[bj][0], v[bj][1]);
        }
        if (!LAST) put_stats8(st_out, row, pn, wc, fq, v);
    }
};
struct EpiResRho : EpiRes<1, false> { static constexpr bool KHOOK = true; const float* osq; };
struct EpiFinal : EpiRes<1, true> { static constexpr bool FUSED_LN = true; unsigned long long* xbuf; unsigned* cnt; const float* gF; const float* bF; };
struct EpiNull {
    static constexpr bool HAS_INIT = false, PERM = true, ROW_AHEAD = true, USE_TAB = false;
    typedef NoCol ColS; typedef NoRow RowL;
    __device__ __forceinline__ ColS cols(int, int, int) const { return ColS{}; }
    __device__ __forceinline__ RowS pre(int, int) const { return RowS{0.f, 0.f}; }
    __device__ __forceinline__ RowL rload(int, int, int, int) const { return RowL{}; }
    __device__ __forceinline__ void apply(int, int, int, int, f32x4 (&v)[2][2], RowS, const ColS&, const RowL&) const { asm volatile("" :: "v"(v[0][0]), "v"(v[0][1]), "v"(v[1][0]), "v"(v[1][1])); }
};
struct LnFoldInit {
    struct ColI { f32x4 c1[2][2], c2[2][2]; };
    const float* st_in; const float* c1; const float* c2;
    __device__ __forceinline__ ColI colsi(int pn, int wc, int fq) const { ColI k;
#pragma unroll
        for (int bj = 0; bj < 2; ++bj)
#pragma unroll
            for (int n = 0; n < 2; ++n) { const int col = 256 * pn + 128 * bj + 32 * wc + 8 * fq + 4 * n; k.c1[bj][n] = *(const f32x4*)(c1 + col); k.c2[bj][n] = *(const f32x4*)(c2 + col); }
        return k; }
    __device__ __forceinline__ RowS prei(int row, int fq) const { RowS r; row_stats(st_in, row, fq, r.a, r.b); return r; }
    __device__ __forceinline__ void init_row(int, int, int, int, f32x4 (&v)[2][2], RowS rs0, const ColI& k) const {
        const RowS rsv{rs0.a, frcp(rs0.b)};
#pragma unroll
        for (int bj = 0; bj < 2; ++bj)
#pragma unroll
            for (int n = 0; n < 2; ++n) v[bj][n] = k.c2[bj][n] * rsv.b - k.c1[bj][n] * rsv.a;
    }
    __device__ __forceinline__ RowS pre(int row, int fq) const { RowS r; row_stats(st_in, row, fq, r.a, r.b); return r; }
};
struct EpiMlpUp : LnFoldInit {
    static constexpr bool HAS_INIT = true, PERM = true, ROW_AHEAD = true, USE_TAB = true;
    typedef NoCol ColS; typedef NoRow RowL;
    bf16_t* hid;
    __device__ __forceinline__ ColS cols(int, int, int) const { return ColS{}; }
    __device__ __forceinline__ RowL rload(int, int, int, int) const { return RowL{}; }
    __device__ __forceinline__ void apply(int row, int pn, int wc, int fq, f32x4 (&v)[2][2], RowS rsv, const ColS&, const RowL&) const {
#pragma unroll
        for (int bj = 0; bj < 2; ++bj) {
            f32x4 u[2];
#pragma unroll
            for (int n = 0; n < 2; ++n) { u[n] = v[bj][n] * rsv.b;
#pragma unroll
                for (int e = 0; e < 4; ++e) { const float r = fmaxf(u[n][e], 0.f); u[n][e] = r * r; } }
            *(u32x4*)(hid + (size_t)row * FF + 256 * pn + 128 * bj + 32 * wc + 8 * fq) = pk8(u[0], u[1]);
        }
    }
};
struct EpiIn1 : LnFoldInit {
    static constexpr bool HAS_INIT = true, PERM = true, ROW_AHEAD = false, USE_TAB = true;
    typedef NoCol ColS; struct RowL { f32x4 cs[2], sn[2]; };
    bf16_t* q1; bf16_t* k1; bf16_t* v1; bf16_t* g1; const float* rc; const float* rs;
    __device__ __forceinline__ ColS cols(int, int, int) const { return ColS{}; }
    static constexpr bool ROT = true;
    __device__ __forceinline__ RowL rload(int row, int pn, int wc, int fq) const { RowL l;
        if (pn < 8) { const int pos = row_pos(row);
#pragma unroll
            for (int n = 0; n < 2; ++n) { l.cs[n] = *(const f32x4*)(rc + pos * 128 + 32 * wc + 8 * fq + 4 * n); l.sn[n] = *(const f32x4*)(rs + pos * 128 + 32 * wc + 8 * fq + 4 * n); } }
        else { l.cs[0] = l.cs[1] = l.sn[0] = l.sn[1] = (f32x4){0.f, 0.f, 0.f, 0.f}; }
        return l; }
    __device__ __forceinline__ void rot_build(LAS unsigned char* lds, int tid) const {
        if (tid < 128) { LAS float* t = (LAS float*)(lds + ROT_OFF); t[tid] = rc[16 * 128 + tid]; t[128 + tid] = rs[16 * 128 + tid]; t[256 + tid] = rc[80 * 128 + tid]; t[384 + tid] = rs[80 * 128 + tid]; }
    }
    __device__ __forceinline__ void rot_step(RowL& l, int which, LAS unsigned char* lds, int wc, int fq) const {
        const LAS float* t = (const LAS float*)(lds + ROT_OFF) + which * 256 + 32 * wc + 8 * fq;
#pragma unroll
        for (int n = 0; n < 2; ++n) { const f32x4 c = *(const LAS f32x4*)(t + 4 * n), sn_ = *(const LAS f32x4*)(t + 128 + 4 * n);
            const f32x4 nc = l.cs[n] * c - l.sn[n] * sn_, ns = l.sn[n] * c + l.cs[n] * sn_; l.cs[n] = nc; l.sn[n] = ns; }
    }
    __device__ __forceinline__ void apply(int row, int pn, int wc, int fq, f32x4 (&v)[2][2], RowS rsv, const ColS&, const RowL& l) const {
        const int q0 = 32 * wc + 8 * fq;
        if (pn < 8) {
            const float sc = rsv.b * (pn < 4 ? 1.f : 0.0625f);
            bf16_t* dst = (pn < 4 ? q1 : k1) + (size_t)row * 1024 + 256 * (pn & 3) + q0;
            f32x4 y1[2], y2[2];
#pragma unroll
            for (int n = 0; n < 2; ++n) { const f32x4 cs = l.cs[n] * sc, sn = l.sn[n] * sc; y1[n] = v[0][n] * cs - v[1][n] * sn; y2[n] = v[0][n] * sn + v[1][n] * cs; }
            *(u32x4*)dst = pk8(y1[0], y1[1]); *(u32x4*)(dst + 128) = pk8(y2[0], y2[1]);
        } else {
            const bool isg = pn >= 16;
            bf16_t* dst = (isg ? g1 : v1) + (size_t)row * RMIX + 256 * (isg ? pn - 16 : pn - 8) + q0;
#pragma unroll
            for (int bj = 0; bj < 2; ++bj) {
                f32x4 u[2];
#pragma unroll
                for (int n = 0; n < 2; ++n) { u[n] = v[bj][n] * rsv.b;
                    if (isg) {
#pragma unroll
                        for (int e = 0; e < 4; ++e) u[n][e] = u[n][e] * sigmoidf_(u[n][e]);
                    } }
                *(u32x4*)(dst + 128 * bj) = pk8(u[0], u[1]);
            }
        }
    }
};

__host__ __device__ __forceinline__ int perm32(int rho) { const int n = rho >> 4, i = rho & 15; return 8 * (i >> 2) + 4 * n + (i & 3); }
template <class Epi>
__device__ __forceinline__ void gemm_naive(const Gemm g, const Epi& E, int bid, int nb) {
    const int tid = opaque_tid(), wid = tid >> 6, lane = tid & 63, fr = lane & 15, fq = lane >> 4;
    const int nN = g.N / 256, units = (g.M / 256) * nN;
    for (long item = (long)bid * 8 + wid; item < (long)units * 64; item += (long)nb * 8) {
        const int unit = (int)(item >> 6), sub = (int)(item & 63), pm = unit / nN, pn = unit % nN, mg = sub >> 2, wc = sub & 3;
        const int row0 = 256 * pm + 16 * mg;
        const bf16_t* ap = g.A + (size_t)pn * g.a_pn_off + (size_t)(row0 + fr) * g.lda + 8 * fq;
        const bf16_t* bp = g.Bt + (size_t)(256 * pn + 32 * wc) * g.ldb + 8 * fq;
        f32x4 acc[2][2];
#pragma unroll
        for (int bj = 0; bj < 2; ++bj)
#pragma unroll
            for (int n = 0; n < 2; ++n) acc[bj][n] = (f32x4){0.f, 0.f, 0.f, 0.f};
        if constexpr (Epi::HAS_INIT) E.init_row(row0 + fr, pn, wc, fq, acc, E.prei(row0 + fr, fq), E.colsi(pn, wc, fq));
        for (int k0 = 0; k0 < g.K; k0 += 32) {
            const bf16x8 a = *(const bf16x8*)(ap + k0);
#pragma unroll
            for (int bj = 0; bj < 2; ++bj)
#pragma unroll
                for (int n = 0; n < 2; ++n) {
                    const int brow = Epi::PERM ? perm32(16 * n + fr) : 16 * n + fr;
                    const bf16x8 b = *(const bf16x8*)(bp + (size_t)(128 * bj + brow) * g.ldb + k0);
                    acc[bj][n] = __builtin_amdgcn_mfma_f32_16x16x32_bf16(b, a, acc[bj][n], 0, 0, 0);
                }
        }
        E.apply(row0 + fr, pn, wc, fq, acc, E.pre(row0 + fr, fq), E.cols(pn, wc, fq), E.rload(row0 + fr, pn, wc, fq));
    }
}

namespace pg8 {
constexpr int BM = 256, BK = 64, HALF = 128, HTB = HALF * BK * 2  , STAGE_BYTES = 8 * HTB, NXCD = 8, WGM = 8;
__host__ __device__ __forceinline__ int lds_byte(int r, int c) { const int st = (r >> 4) * 2 + (c >> 5), rr = r & 15, cc = c & 31, ob = rr * 64 + cc * 2; return st * 1024 + (ob ^ (((ob >> 9) & 1) << 5)); }
__host__ __device__ __forceinline__ void stage_rc(int b, int& R, int& C) { const int st = b / 1024, sb = b % 1024, swz = sb ^ (((sb >> 9) & 1) << 5); R = (st >> 1) * 16 + swz / 64; C = (st & 1) * 32 + (swz % 64) / 2; }
struct Unit { int pm, pn; };
struct StaticOrder {
    int nM, nN, nwg, G, c;
    __host__ __device__ void init(int M, int N, int G_, int c_) { nM = M / BM; nN = N / BM; nwg = nM * nN; G = G_; c = c_; }
    __host__ __device__ bool next(int i, Unit& u) const {
        const long L = (long)i * G + c; if (L >= nwg) return false;
        int wgid = (int)L; { const int q = nwg / NXCD, r = nwg % NXCD, xcd = wgid % NXCD, off = wgid / NXCD; wgid = (xcd < r ? xcd * (q + 1) : r * (q + 1) + (xcd - r) * q) + off; }
        const int nig = WGM * nN, gid = wgid / nig, fm = gid * WGM, gsz = (nM - fm) < WGM ? (nM - fm) : WGM;
        u.pm = fm + ((wgid % nig) % gsz); u.pn = (wgid % nig) / gsz; return true;
    }
};
constexpr int TAB_OFF = 131072, TAB_UNITS = 15;
template <class T, class = void> struct HasFused { static constexpr bool value = false; };
template <class T> struct HasFused<T, decltype((void)T::FUSED_LN)> { static constexpr bool value = T::FUSED_LN; };
constexpr int FIN_OFF = 131072 + 2 * 2048;
template <class T, class = void> struct HasRot { static constexpr bool value = false; };
template <class T> struct HasRot<T, decltype((void)T::ROT)> { static constexpr bool value = T::ROT; };
template <class T, class = void> struct HasKhook { static constexpr bool value = false; };
template <class T> struct HasKhook<T, decltype((void)T::KHOOK)> { static constexpr bool value = T::KHOOK; };
constexpr int RHO_OFF = TAB_OFF + 2 * 2048;
template <class E> struct PgEpi {
    static constexpr bool PERM = E::PERM, KHOOK = HasKhook<E>::value;
    E e;
#define PG_ROW(i) (rbase + ((i) >> 2) * HALF + ((i) & 3) * 16)
#define PG_TROW(i) (wr * 64 + fr + ((i) >> 2) * HALF + ((i) & 3) * 16)
    template <class Sched> __device__ __forceinline__ void build_tab(LAS unsigned char* lds, const Sched& S, int tid) const {
        if constexpr (E::USE_TAB) {
            LAS f32x2* tab = (LAS f32x2*)(lds + TAB_OFF);
            const int r = tid >> 1, hf = tid & 1; Unit u;
            for (int i = 0; i < TAB_UNITS && S.next(i, u); ++i) {
                const f32x4* p = (const f32x4*)(e.st_in + (size_t)(u.pm * BM + r) * 32 + hf * 16);
                const f32x4 a0 = p[0], a1 = p[1], a2 = p[2], a3 = p[3];
                float s1 = (a0[0] + a0[2]) + (a1[0] + a1[2]) + (a2[0] + a2[2]) + (a3[0] + a3[2]), s2 = (a0[1] + a0[3]) + (a1[1] + a1[3]) + (a2[1] + a2[3]) + (a3[1] + a3[3]);
                s1 += __shfl_xor(s1, 1); s2 += __shfl_xor(s2, 1);
                const float mean = s1 * (1.f / DM), var = fmaxf(s2 * (1.f / DM) - mean * mean, 0.f);
                if (hf == 0) tab[i * 256 + r] = (f32x2){mean, frsq(var + LN_EPS)};
            }
            if constexpr (HasRot<E>::value) e.rot_build(lds, tid);
            if constexpr (KHOOK) {
                LAS f32x4* rho = (LAS f32x4*)(lds + RHO_OFF);
                for (int i = 0; i < 2 && S.next(i, u); ++i) {
                    const f32x4* p = (const f32x4*)(e.osq + (size_t)(u.pm * BM + r) * 64 + hf * 32);
                    float sa = 0.f, sb = 0.f;
#pragma unroll
                    for (int k = 0; k < 4; ++k) { const f32x4 a = p[k], b = p[4 + k]; sa += (a[0] + a[1]) + (a[2] + a[3]); sb += (b[0] + b[1]) + (b[2] + b[3]); }
                    const float ra = frsq(sa * (1.f / RDV) + LN_EPS), rb = frsq(sb * (1.f / RDV) + LN_EPS);
                    const float oa = __shfl_xor(ra, 1), ob = __shfl_xor(rb, 1);
                    if (hf == 0) rho[i * 256 + r] = (f32x4){frcp(ra), ra * frcp(rb), rb * frcp(oa), oa * frcp(ob)};
                }
            }
            asm volatile("s_waitcnt lgkmcnt(0)" ::: "memory"); __syncthreads();
        }
    }
    __device__ __forceinline__ void khook(f32x4 (&acc)[2][2][4][2], int ui, int col, LAS unsigned char* lds, int wr, int fr) const {
        if constexpr (KHOOK) {
#pragma unroll
            for (int i = 0; i < 8; ++i) {
                const float sc = ((const LAS float*)(lds + RHO_OFF))[(ui * 256 + PG_TROW(i)) * 4 + col];
                const int ai = i >> 2, m = i & 3;
                acc[ai][0][m][0] *= sc; acc[ai][0][m][1] *= sc; acc[ai][1][m][0] *= sc; acc[ai][1][m][1] *= sc;
            }
        }
    }
    __device__ __forceinline__ void fused_ln(const f32x4 (&acc)[2][2][4][2], const Unit& u, LAS unsigned char* lds, int wr, int wc, int fr, int fq) const {
        if constexpr (HasFused<E>::value) {
            typedef float f2 __attribute__((ext_vector_type(2)));
            LAS f2* P = (LAS f2*)(lds + FIN_OFF); LAS f2* Sx = (LAS f2*)(lds + FIN_OFF + 8192); volatile LAS unsigned* flag = (volatile LAS unsigned*)(lds + FIN_OFF + 10240);
            const int tid = threadIdx.x, lane = tid & 63, wid = tid >> 6;
#pragma unroll
            for (int i = 0; i < 8; ++i) {
                const int ai = i >> 2, m = i & 3; float s1 = 0.f, s2 = 0.f;
#pragma unroll
                for (int bj = 0; bj < 2; ++bj)
#pragma unroll
                    for (int n = 0; n < 2; ++n)
#pragma unroll
                        for (int q = 0; q < 4; ++q) { const float x = acc[ai][bj][m][n][q]; s1 += x; s2 += x * x; }
                s1 += __shfl_xor(s1, 16); s2 += __shfl_xor(s2, 16); s1 += __shfl_xor(s1, 32); s2 += __shfl_xor(s2, 32);
                if (fq == 0) P[(wr * 64 + fr + ai * HALF + m * 16) * 4 + wc] = (f2){s1, s2};
            }
            asm volatile("s_waitcnt lgkmcnt(0)" ::: "memory"); __builtin_amdgcn_s_barrier(); asm volatile("" ::: "memory");
            if (tid < 256) {
                const f2 a = P[tid * 4], b = P[tid * 4 + 1], c2 = P[tid * 4 + 2], d = P[tid * 4 + 3];
                const float s1 = (a.x + b.x) + (c2.x + d.x), s2 = (a.y + b.y) + (c2.y + d.y);
                __hip_atomic_store(e.xbuf + ((size_t)(u.pm * BM + tid) * 4 + u.pn), ((unsigned long long)__float_as_uint(s2) << 32) | __float_as_uint(s1), __ATOMIC_RELAXED, __HIP_MEMORY_SCOPE_AGENT);
                asm volatile("s_waitcnt vmcnt(0)" ::: "memory");
                if (lane == 0) __hip_atomic_fetch_add(e.cnt + 64 * u.pm, 1u, __ATOMIC_RELAXED, __HIP_MEMORY_SCOPE_AGENT);
            }
            if (wid == 0) {
                unsigned sp = 0;
                while ((unsigned)__builtin_amdgcn_readfirstlane(__hip_atomic_load(e.cnt + 64 * u.pm, __ATOMIC_RELAXED, __HIP_MEMORY_SCOPE_AGENT)) < 16u) { __builtin_amdgcn_s_sleep(2); if (++sp > (1u << 22)) break; }
                __builtin_amdgcn_fence(__ATOMIC_ACQUIRE, "agent");
                if (lane == 0) flag[0] = 1u;
            }
            asm volatile("s_waitcnt vmcnt(0) lgkmcnt(0)" ::: "memory"); __builtin_amdgcn_s_barrier(); asm volatile("" ::: "memory");
            if (tid < 256) {
                float s1 = 0.f, s2 = 0.f;
#pragma unroll
                for (int t = 0; t < 4; ++t) { const unsigned long long w = __hip_atomic_load(e.xbuf + ((size_t)(u.pm * BM + tid) * 4 + t), __ATOMIC_RELAXED, __HIP_MEMORY_SCOPE_AGENT); s1 += __uint_as_float((unsigned)w); s2 += __uint_as_float((unsigned)(w >> 32)); }
                const float mean = s1 * (1.f / DM), var = fmaxf(s2 * (1.f / DM) - mean * mean, 0.f);
                Sx[tid] = (f2){mean, frsq(var + LN_EPS)};
            }
            asm volatile("s_waitcnt vmcnt(0) lgkmcnt(0)" ::: "memory"); __builtin_amdgcn_s_barrier(); asm volatile("" ::: "memory");
            f32x4 gv[2][2], bv[2][2];
#pragma unroll
            for (int bj = 0; bj < 2; ++bj)
#pragma unroll
                for (int n = 0; n < 2; ++n) { const int col = 256 * u.pn + 128 * bj + 32 * wc + 8 * fq + 4 * n; gv[bj][n] = *(const f32x4*)(e.gF + col); bv[bj][n] = *(const f32x4*)(e.bF + col); }
#pragma unroll
            for (int i = 0; i < 8; ++i) {
                const int ai = i >> 2, m = i & 3, rt = wr * 64 + fr + ai * HALF + m * 16; const f2 ms = Sx[rt];
                float* orow = e.c.out + (size_t)(u.pm * BM + rt) * DM + 256 * u.pn + 32 * wc + 8 * fq;
#pragma unroll
                for (int bj = 0; bj < 2; ++bj)
#pragma unroll
                    for (int n = 0; n < 2; ++n) *(f32x4*)(orow + 128 * bj + 4 * n) = (acc[ai][bj][m][n] - ms.x) * ms.y * gv[bj][n] + bv[bj][n];
            }
            asm volatile("s_waitcnt lgkmcnt(0)" ::: "memory"); __builtin_amdgcn_s_barrier(); asm volatile("" ::: "memory");
        }
    }
    __device__ __forceinline__ void operator()(const f32x4 (&acc)[2][2][4][2], const Unit& u, int ui, LAS unsigned char* lds, int wr, int wc, int fr, int fq) const {
        if constexpr (HasFused<E>::value) { fused_ln(acc, u, lds, wr, wc, fr, fq); return; }
        const int rbase = u.pm * BM + wr * 64 + fr;
        const typename E::ColS cs = e.cols(u.pn, wc, fq);
        RowS rs[8];
#pragma unroll
        for (int i = 0; i < 8; ++i) {
            if constexpr (E::USE_TAB) { const f32x2 t = ((const LAS f32x2*)(lds + TAB_OFF))[ui * 256 + PG_TROW(i)]; rs[i] = RowS{t.x, t.y}; }
            else rs[i] = e.pre(PG_ROW(i), fq);
        }
        typename E::RowL nxt = e.rload(PG_ROW(0), u.pn, wc, fq);
#pragma unroll
        for (int i = 0; i < 8; ++i) {
            const int ai = i >> 2, m = i & 3;
            typename E::RowL cur;
            if constexpr (HasRot<E>::value) { cur = nxt; if (i + 1 < 8 && u.pn < 8) e.rot_step(nxt, i == 3 ? 1 : 0, lds, wc, fq); }
            else if (E::ROW_AHEAD || i == 0) { cur = nxt; if (E::ROW_AHEAD && i + 1 < 8) nxt = e.rload(PG_ROW(i + 1), u.pn, wc, fq); }
            else cur = e.rload(PG_ROW(i), u.pn, wc, fq);
            f32x4 v[2][2] = {{acc[ai][0][m][0], acc[ai][0][m][1]}, {acc[ai][1][m][0], acc[ai][1][m][1]}};
            if constexpr (KHOOK) { const f32x4 rh = ((const LAS f32x4*)(lds + RHO_OFF))[ui * 256 + PG_TROW(i)]; const float r3 = frcp(rh[0] * rh[1] * rh[2] * rh[3]);
                v[0][0] *= r3; v[0][1] *= r3; v[1][0] *= r3; v[1][1] *= r3; }
            e.apply(PG_ROW(i), u.pn, wc, fq, v, rs[i], cs, cur);
        }
    }
    struct NoCi {};
    template <class T, bool H> struct CiSel { typedef NoCi type; };
    template <class T> struct CiSel<T, true> { typedef typename T::ColI type; };
    typedef typename CiSel<E, E::HAS_INIT>::type Ci;
    __device__ __forceinline__ Ci init_cols(const Unit& u, int wc, int fq) const { if constexpr (E::HAS_INIT) return e.colsi(u.pn, wc, fq); else return Ci{}; }
    __device__ __forceinline__ void init(f32x4 (&acc)[2][2][4][2], const Unit& u, int ui, LAS unsigned char* lds, int wr, int wc, int fr, int fq, const Ci& ci) const {
        if constexpr (E::HAS_INIT) {
            const int rbase = u.pm * BM + wr * 64 + fr;
            RowS rs[8];
#pragma unroll
            for (int i = 0; i < 8; ++i) {
                if constexpr (E::USE_TAB) { const f32x2 t = ((const LAS f32x2*)(lds + TAB_OFF))[ui * 256 + PG_TROW(i)]; rs[i] = RowS{t.x, t.y}; }
                else rs[i] = e.prei(PG_ROW(i), fq);
            }
#pragma unroll
            for (int i = 0; i < 8; ++i) {
                const int ai = i >> 2, m = i & 3; f32x4 v[2][2];
                e.init_row(PG_ROW(i), u.pn, wc, fq, v, rs[i], ci);
                if constexpr (KHOOK) { const float i0 = ((const LAS float*)(lds + RHO_OFF))[(ui * 256 + PG_TROW(i)) * 4]; v[0][0] *= i0; v[0][1] *= i0; v[1][0] *= i0; v[1][1] *= i0; }
                acc[ai][0][m][0] = v[0][0]; acc[ai][0][m][1] = v[0][1]; acc[ai][1][m][0] = v[1][0]; acc[ai][1][m][1] = v[1][1];
            }
        } else {
#pragma unroll
            for (int a = 0; a < 2; ++a)
#pragma unroll
                for (int b = 0; b < 2; ++b)
#pragma unroll
                    for (int m = 0; m < 4; ++m)
#pragma unroll
                        for (int n = 0; n < 2; ++n) acc[a][b][m][n] = (f32x4){0.f, 0.f, 0.f, 0.f};
        }
    }
#undef PG_ROW
#undef PG_TROW
};
template <class Epi>
__device__ __forceinline__ void gemm_phase(LAS unsigned char* lds, const Gemm g, const StaticOrder& S, const Epi& E) {
    const int tid = opaque_tid(), wid = __builtin_amdgcn_readfirstlane(tid >> 6), lane = tid & 63, wr = wid >> 2, wc = wid & 3, fr = lane & 15, fq = lane >> 4;
    int Ko = g.K; asm volatile("" : "+s"(Ko));
    const int K = Ko, nt = K / BK;
    unsigned voffA[2], voffB[2];
#pragma unroll
    for (int i = 0; i < 2; ++i) { int R, C; stage_rc(tid * 16 + i * 8192, R, C); const int Rb = Epi::PERM ? ((R & ~31) + perm32(R & 31)) : R; voffA[i] = (unsigned)(R * g.lda + C) * 2u; voffB[i] = (unsigned)(Rb * g.ldb + C) * 2u; }
    const size_t kstep = (size_t)(BK * 2);
    const size_t hstepA = (size_t)HALF * g.lda * 2, hstepB = (size_t)HALF * g.ldb * 2;
    const size_t tstepA = 2 * hstepA, tstepB = 2 * hstepB;
    const size_t pnA = (size_t)g.a_pn_off * 2;
    const unsigned ldsw = (unsigned)wid * 1024u;
    const int aoff = lds_byte(wr * 64 + fr, fq * 8), boff = lds_byte(wc * 32 + fr, fq * 8);
#define PG8_SA(b, h) (((b) * 2 + (h)) * HTB)
#define PG8_SB(b, h) ((4 + (b) * 2 + (h)) * HTB)
#define PG8_STAGE(bufoff, gbase, voff) do { _Pragma("unroll") for (int _i = 0; _i < 2; ++_i) \
        __builtin_amdgcn_global_load_lds((const unsigned*)((const char*)(gbase) + (voff)[_i]), (LAS unsigned*)(lds + (bufoff) + ldsw + _i * 8192), 16, 0, 0); } while (0)
#define PG8_LDA(dst, b, h) do { _Pragma("unroll") for (int m = 0; m < 4; ++m) _Pragma("unroll") for (int k = 0; k < 2; ++k) dst[m][k] = *(const LAS bf16x8*)(lds + PG8_SA(b, h) + aoff + m * 2048 + k * 1024); } while (0)
#define PG8_LDB(dst, b, h) do { _Pragma("unroll") for (int n = 0; n < 2; ++n) _Pragma("unroll") for (int k = 0; k < 2; ++k) dst[n][k] = *(const LAS bf16x8*)(lds + PG8_SB(b, h) + boff + n * 2048 + k * 1024); } while (0)
#define PG8_MMA(ai, bj, At, Bt) do { __builtin_amdgcn_s_setprio(1); _Pragma("unroll") for (int m = 0; m < 4; ++m) _Pragma("unroll") for (int n = 0; n < 2; ++n) _Pragma("unroll") for (int k = 0; k < 2; ++k) \
        acc[ai][bj][m][n] = __builtin_amdgcn_mfma_f32_16x16x32_bf16(Bt[n][k], At[m][k], acc[ai][bj][m][n], 0, 0, 0); __builtin_amdgcn_s_setprio(0); } while (0)
#define PG8_WAIT_V(n) asm volatile("s_waitcnt vmcnt(" #n ")" ::: "memory")
#define PG8_WAIT_L(n) asm volatile("s_waitcnt lgkmcnt(" #n ")" ::: "memory")
#define PG8_BAR __builtin_amdgcn_s_barrier()
#define PG8_SCHED __builtin_amdgcn_sched_barrier(0)
    Unit cur, nxt; int ui = 0;
    if (!S.next(0, cur)) return;
    E.build_tab(lds, S, tid);
    f32x4 acc[2][2][4][2];
    E.init(acc, cur, 0, lds, wr, wc, fr, fq, E.init_cols(cur, wc, fq));
    bf16x8 At[4][2], B0[2][2], B1[2][2];
    const char* cA = (const char*)g.A + (size_t)cur.pn * pnA + (size_t)cur.pm * tstepA; const char* cB = (const char*)g.Bt + (size_t)cur.pn * tstepB;
    PG8_STAGE(PG8_SB(0, 0), cB, voffB); PG8_STAGE(PG8_SB(0, 1), cB + hstepB, voffB); PG8_STAGE(PG8_SA(0, 0), cA, voffA); PG8_STAGE(PG8_SA(0, 1), cA + hstepA, voffA);
    if (wr == 1) PG8_BAR;
    PG8_WAIT_V(2); PG8_BAR;
    PG8_STAGE(PG8_SB(1, 0), cB + kstep, voffB); PG8_STAGE(PG8_SA(1, 0), cA + kstep, voffA); PG8_STAGE(PG8_SB(1, 1), cB + hstepB + kstep, voffB);
    PG8_WAIT_V(6); PG8_BAR;
    for (;;) {
        const bool has_next = S.next(ui + 1, nxt);
        const char* nA = has_next ? (const char*)g.A + (size_t)nxt.pn * pnA + (size_t)nxt.pm * tstepA : cA; const char* nB = has_next ? (const char*)g.Bt + (size_t)nxt.pn * tstepB : cB;
        for (int t = 0; t < nt; t += 2) {
            if constexpr (Epi::KHOOK) { if (t != 0 && (t & 7) == 0) E.khook(acc, ui, t >> 3, lds, wr, fr); }
            const bool last = (t == nt - 2);
            const char* a1 = cA + (size_t)(t + 1) * kstep;
            const char* a2 = last ? nA : cA + (size_t)(t + 2) * kstep; const char* b2 = last ? nB : cB + (size_t)(t + 2) * kstep;
            const char* a3 = a2 + kstep; const char* b3 = b2 + kstep;
            PG8_LDB(B0, 0, 0); PG8_LDB(B1, 0, 1); PG8_SCHED; PG8_LDA(At, 0, 0); PG8_STAGE(PG8_SA(1, 1), a1 + hstepA, voffA);
            PG8_WAIT_V(8); PG8_WAIT_L(0); PG8_BAR; PG8_MMA(0, 0, At, B0); PG8_MMA(0, 1, At, B1); PG8_BAR; PG8_SCHED;
            PG8_LDA(At, 0, 1); PG8_STAGE(PG8_SB(0, 0), b2, voffB); PG8_STAGE(PG8_SB(0, 1), b2 + hstepB, voffB); PG8_STAGE(PG8_SA(0, 0), a2, voffA);
            PG8_WAIT_V(8); PG8_WAIT_L(0); PG8_BAR; PG8_MMA(1, 0, At, B0); PG8_MMA(1, 1, At, B1); PG8_BAR; PG8_SCHED;
            PG8_LDB(B0, 1, 0); PG8_LDB(B1, 1, 1); PG8_SCHED; PG8_LDA(At, 1, 0); PG8_STAGE(PG8_SA(0, 1), a2 + hstepA, voffA);
            PG8_WAIT_V(8); PG8_WAIT_L(0); PG8_BAR; PG8_MMA(0, 0, At, B0); PG8_MMA(0, 1, At, B1); PG8_BAR; PG8_SCHED;
            PG8_LDA(At, 1, 1); PG8_STAGE(PG8_SB(1, 0), b3, voffB); PG8_STAGE(PG8_SB(1, 1), b3 + hstepB, voffB); PG8_STAGE(PG8_SA(1, 0), a3, voffA);
            PG8_WAIT_V(8); PG8_WAIT_L(0); PG8_BAR; PG8_MMA(1, 0, At, B0); PG8_MMA(1, 1, At, B1); PG8_BAR; PG8_SCHED;
        }
        if (wr == 0) PG8_BAR;
        E(acc, cur, ui, lds, wr, wc, fr, fq);
        if (!has_next) break;
        E.init(acc, nxt, ui + 1, lds, wr, wc, fr, fq, E.init_cols(nxt, wc, fq));
        cur = nxt; cA = nA; cB = nB; ++ui;
        if (wr == 1) PG8_BAR;
    }
    PG8_WAIT_V(0);
    PG8_BAR;
#undef PG8_SA
#undef PG8_SB
#undef PG8_STAGE
#undef PG8_LDA
#undef PG8_LDB
#undef PG8_MMA
#undef PG8_WAIT_V
#undef PG8_WAIT_L
#undef PG8_BAR
#undef PG8_SCHED
}
}

template <class Epi>
__device__ __forceinline__ void gemm_meta(LAS unsigned char* lds, const Gemm g, const Epi& E, int bid, int nb, int pn_lo, int pn_hi) {
    const int tid = opaque_tid(), wid = __builtin_amdgcn_readfirstlane(tid >> 6), lane = tid & 63, fr = lane & 15, fq = lane >> 4;
    const int ntask = (pn_hi - pn_lo) * 4, ksteps = g.K / 32;
    LAS f32x4* part = (LAS f32x4*)lds;
    for (int t = nb - 1 - bid; t < ntask; t += nb) {
        const int pn = pn_lo + (t >> 2), wc = t & 3;
        const bf16_t* ap = g.A + (size_t)pn * g.a_pn_off + (size_t)(MR + fr) * g.lda + 8 * fq;
        const bf16_t* bp = g.Bt + (size_t)(256 * pn + 32 * wc) * g.ldb + 8 * fq;
        f32x4 acc[2][2];
#pragma unroll
        for (int bj = 0; bj < 2; ++bj)
#pragma unroll
            for (int n = 0; n < 2; ++n) acc[bj][n] = (f32x4){0.f, 0.f, 0.f, 0.f};
#pragma unroll 4
        for (int ks = wid; ks < ksteps; ks += 8) {
            const int k0 = 32 * ks;
            const bf16x8 a = *(const bf16x8*)(ap + k0);
#pragma unroll
            for (int bj = 0; bj < 2; ++bj)
#pragma unroll
                for (int n = 0; n < 2; ++n) {
                    const int brow = Epi::PERM ? perm32(16 * n + fr) : 16 * n + fr;
                    const bf16x8 b = *(const bf16x8*)(bp + (size_t)(128 * bj + brow) * g.ldb + k0);
                    acc[bj][n] = __builtin_amdgcn_mfma_f32_16x16x32_bf16(b, a, acc[bj][n], 0, 0, 0);
                }
        }
#pragma unroll
        for (int i = 0; i < 4; ++i) part[(wid * 64 + lane) * 4 + i] = acc[i >> 1][i & 1];
        __syncthreads();
        if (wid == 0) {
            f32x4 v[2][2];
#pragma unroll
            for (int i = 0; i < 4; ++i) v[i >> 1][i & 1] = (f32x4){0.f, 0.f, 0.f, 0.f};
            if constexpr (Epi::HAS_INIT) E.init_row(MR + fr, pn, wc, fq, v, E.prei(MR + fr, fq), E.colsi(pn, wc, fq));
#pragma unroll
            for (int w = 0; w < 8; ++w)
#pragma unroll
                for (int i = 0; i < 4; ++i) v[i >> 1][i & 1] += part[(w * 64 + lane) * 4 + i];
            E.apply(MR + fr, pn, wc, fq, v, E.pre(MR + fr, fq), E.cols(pn, wc, fq), E.rload(MR + fr, pn, wc, fq));
        }
        __syncthreads();
    }
}

template <class E>
__device__ __forceinline__ void run_gemm(LAS unsigned char* lds, const Gemm g, const E& e, int bid, int nb, bool meta = true, int mlo = 0, int mhi = -1) {
    if (meta) gemm_meta<E>(lds, g, e, bid, nb, mlo, mhi < 0 ? g.N / 256 : mhi);
#if FAST_GEMM
    pg8::StaticOrder S; S.init(g.M, g.N, nb, bid);
    pg8::PgEpi<E> pe{e};
    pg8::gemm_phase<pg8::PgEpi<E>>(lds, g, S, pe);
#else
    gemm_naive<E>(g, e, bid, nb);
#endif
}

constexpr int NWV = 8;

__device__ __forceinline__ void transpose_item(const float* W, int K, int N, bf16_t* WT, int row_off, const float* gk, const float* bk, float* c1, float* c2, LAS float* scr, int item, int lane) {
    const int nblk = N / 32, kb = item / nblk, nbk = item % nblk, k0 = 64 * kb, n0 = 32 * nbk;
    float s1 = 0.f, s2 = 0.f;
    float wv[32];
#pragma unroll
    for (int i = 0; i < 32; ++i) wv[i] = W[(size_t)(k0 + 2 * i + (lane >> 5)) * N + n0 + (lane & 31)];
#pragma unroll
    for (int i = 0; i < 32; ++i) { const int kk = 2 * i + (lane >> 5); float w = wv[i]; if (bk) s2 += bk[k0 + kk] * w; if (gk) w *= gk[k0 + kk]; if (c1) s1 += bfround(w); scr[kk * 33 + (lane & 31)] = w; }
    if (c1) { s1 += __shfl_xor(s1, 32); s2 += __shfl_xor(s2, 32); if (lane < 32) { atomicAdd(c1 + n0 + lane, s1); atomicAdd(c2 + n0 + lane, s2); } }
    asm volatile("s_waitcnt lgkmcnt(0)" ::: "memory");
    const int cch = lane & 7;
#pragma unroll
    for (int j = 0; j < 4; ++j) { const int n = (lane >> 3) + 8 * j; const LAS float* s = scr + (8 * cch) * 33 + n;
        u32x4 o; o.x = pk2(s[0 * 33], s[1 * 33]); o.y = pk2(s[2 * 33], s[3 * 33]); o.z = pk2(s[4 * 33], s[5 * 33]); o.w = pk2(s[6 * 33], s[7 * 33]);
        *(u32x4*)(WT + (size_t)(row_off + n0 + n) * K + k0 + 8 * cch) = o; }
    asm volatile("s_waitcnt lgkmcnt(0)" ::: "memory");
}
__device__ __forceinline__ void transpose_item64(const float* W, int K, int N, bf16_t* WT, int row_off, const float* gk, const float* bk, float* c1, float* c2, LAS float* scr, int item, int lane) {
    const int nblk = N / 64, kb = item / nblk, nbk = item % nblk, k0 = 64 * kb, n0 = 64 * nbk, n4 = 4 * (lane & 15), kq = lane >> 4;
    f32x4 wv[16];
#pragma unroll
    for (int i = 0; i < 16; ++i) wv[i] = *(const f32x4*)(W + (size_t)(k0 + 4 * i + kq) * N + n0 + n4);
    f32x4 s1 = {0.f, 0.f, 0.f, 0.f}, s2 = s1;
#pragma unroll
    for (int i = 0; i < 16; ++i) { const int kk = 4 * i + kq; f32x4 w = wv[i]; if (bk) s2 += w * bk[k0 + kk]; if (gk) w *= gk[k0 + kk];
        if (c1) { s1[0] += bfround(w[0]); s1[1] += bfround(w[1]); s1[2] += bfround(w[2]); s1[3] += bfround(w[3]); }
        LAS float* d = scr + kk * 65 + n4; d[0] = w[0]; d[1] = w[1]; d[2] = w[2]; d[3] = w[3]; }
    if (c1) {
#pragma unroll
        for (int e = 0; e < 4; ++e) { s1[e] += __shfl_xor(s1[e], 16); s1[e] += __shfl_xor(s1[e], 32); s2[e] += __shfl_xor(s2[e], 16); s2[e] += __shfl_xor(s2[e], 32); }
        if (lane < 16) {
#pragma unroll
            for (int e = 0; e < 4; ++e) { atomicAdd(c1 + n0 + n4 + e, s1[e]); atomicAdd(c2 + n0 + n4 + e, s2[e]); } }
    }
    asm volatile("s_waitcnt lgkmcnt(0)" ::: "memory");
    const int cch = lane & 7;
#pragma unroll
    for (int j = 0; j < 8; ++j) { const int n = (lane >> 3) + 8 * j; const LAS float* sp = scr + (8 * cch) * 65 + n;
        u32x4 o; o.x = pk2(sp[0 * 65], sp[1 * 65]); o.y = pk2(sp[2 * 65], sp[3 * 65]); o.z = pk2(sp[4 * 65], sp[5 * 65]); o.w = pk2(sp[6 * 65], sp[7 * 65]);
        *(u32x4*)(WT + (size_t)(row_off + n0 + n) * K + k0 + 8 * cch) = o; }
    asm volatile("s_waitcnt lgkmcnt(0)" ::: "memory");
}
constexpr int C1_UP0 = 0, C2_UP0 = 4096, C1_IN1 = 8192, C2_IN1 = 14336, C1_UP1 = 20480, C2_UP1 = 24576;
struct MatDesc { const float* W; int K, N; bf16_t* WT; int row_off; const float* gk; const float* bk; float* c1; float* c2; };
constexpr int TR_COUNT[18] = {720, 4, 4, 4, 4, 4, 4, 4, 4, 48, 32, 256, 1024, 1024, 1536, 512, 1024, 1024};
constexpr int tr_total() { int s = 0; for (int i = 0; i < 18; ++i) s += TR_COUNT[i]; return s; }
__device__ __forceinline__ MatDesc get_mat(const Ctx& c, int i) {
    MatDesc d; d.gk = nullptr; d.row_off = 0; d.bk = nullptr; d.c1 = nullptr; d.c2 = nullptr; float* cv = c.f32(OFF_C12);
    if (i == 0) { d.W = c.in[2]; d.K = 1024; d.N = EVEN_IN; d.WT = c.b16(OFF_WIN0); }
    else if (i <= 4) { const int h = i - 1; d.W = c.in[5] + h * 16384; d.K = 128; d.N = 128; d.WT = c.b16(OFF_WGATE); d.row_off = h * 256; }
    else if (i <= 8) { const int h = i - 5; d.W = c.in[7] + h * 16384; d.K = 128; d.N = 128; d.WT = c.b16(OFF_WGATE); d.row_off = h * 256 + 128; }
    else if (i == 9) { d.W = c.in[11]; d.K = 256; d.N = 768; d.WT = c.b16(OFF_WUQ); d.gk = c.in[10]; }
    else if (i == 10) { d.W = c.in[13]; d.K = 128; d.N = 1024; d.WT = c.b16(OFF_WUKV); d.gk = c.in[12]; }
    else if (i == 11) { d.W = c.in[14]; d.K = 1024; d.N = 1024; d.WT = c.b16(OFF_WOUT0); }
    else if (i == 12) { d.W = c.in[19]; d.K = 1024; d.N = 4096; d.WT = c.b16(OFF_W1_0); d.gk = c.in[17]; d.bk = c.in[18]; d.c1 = cv + C1_UP0; d.c2 = cv + C2_UP0; }
    else if (i == 13) { d.W = c.in[20]; d.K = 4096; d.N = 1024; d.WT = c.b16(OFF_W2_0); }
    else if (i == 14) { d.W = c.in[15]; d.K = 1024; d.N = 6144; d.WT = c.b16(OFF_WIN1); d.gk = c.in[21]; d.bk = c.in[22]; d.c1 = cv + C1_IN1; d.c2 = cv + C2_IN1; }
    else if (i == 15) { d.W = c.in[16]; d.K = 2048; d.N = 1024; d.WT = c.b16(OFF_WOUT1); }
    else if (i == 16) { d.W = c.in[19] + (size_t)1024 * 4096; d.K = 1024; d.N = 4096; d.WT = c.b16(OFF_W1_1); d.gk = c.in[17] + 1024; d.bk = c.in[18] + 1024; d.c1 = cv + C1_UP1; d.c2 = cv + C2_UP1; }
    else { d.W = c.in[20] + (size_t)4096 * 1024; d.K = 4096; d.N = 1024; d.WT = c.b16(OFF_W2_1); }
    return d;
}
__device__ __forceinline__ void sincos_d(double ang, float& cs, float& sn) {
    const double TWO_PI = 6.283185307179586476925, HALF_PI = 1.5707963267948966192;
    double r = ang - rint(ang / TWO_PI) * TWO_PI;
    const double q = rint(r / HALF_PI); const double y = r - q * HALF_PI; const double y2 = y * y;
    const double s = y * (1.0 + y2 * (-1.0 / 6 + y2 * (1.0 / 120 + y2 * (-1.0 / 5040 + y2 * (1.0 / 362880 + y2 * (-1.0 / 39916800 + y2 * (1.0 / 6227020800.0)))))));
    const double c = 1.0 + y2 * (-0.5 + y2 * (1.0 / 24 + y2 * (-1.0 / 720 + y2 * (1.0 / 40320 + y2 * (-1.0 / 3628800 + y2 * (1.0 / 479001600.0))))));
    const int qi = ((int)q) & 3;
    double cc, ss;
    if (qi == 0) { cc = c; ss = s; } else if (qi == 1) { cc = -s; ss = c; } else if (qi == 2) { cc = -c; ss = -s; } else { cc = s; ss = -c; }
    cs = (float)cc; sn = (float)ss;
}
__device__ __forceinline__ void phase_prologue(const Ctx& c, const Params& p, LAS unsigned char* lds, int bid, int nb, int part = 0) {
    const int tid = opaque_tid(), wid = tid >> 6, lane = tid & 63;
    LAS float* scr = (LAS float*)(lds + wid * 17408);
    const long gw = (long)bid * NWV + wid, NW = (long)nb * NWV;
    constexpr int T_C12 = 0, T_TR = tr_total(), T_ZP = 96, T_XB = (MR + NMETA) / 4, T_ROPE = (TT * 144 + 63) / 64, T_CCH = 8;
    constexpr int TOTAL = T_C12 + T_TR + T_ZP + T_XB + T_ROPE + T_CCH;
    for (long it = gw; it < TOTAL; it += NW) {
        int r = (int)it;
        if (part == 2 && (r < T_TR + T_ZP || r >= T_TR + T_ZP + T_XB)) continue;
        if (r < T_TR) {
            int mi = 0;
#pragma unroll
            for (int i = 0; i < 18; ++i) { if (mi == i && r >= TR_COUNT[i]) { r -= TR_COUNT[i]; mi = i + 1; } }
            const MatDesc d = get_mat(c, mi);
            if (mi == 0) transpose_item(d.W, d.K, d.N, d.WT, d.row_off, d.gk, d.bk, d.c1, d.c2, scr, r, lane);
            else transpose_item64(d.W, d.K, d.N, d.WT, d.row_off, d.gk, d.bk, d.c1, d.c2, scr, r, lane);
            continue;
        }
        r -= T_TR;
        if (r < T_ZP) {
            u32x4* dst = (u32x4*)(c.b16(OFF_WIN0) + (size_t)(EVEN_IN + r) * 1024); dst[lane] = (u32x4){0, 0, 0, 0}; dst[64 + lane] = (u32x4){0, 0, 0, 0};
            continue;
        }
        r -= T_ZP;
        if (r < T_XB) {
            if (part == 1) continue;
            f32x4 v[4][4];
#pragma unroll
            for (int q = 0; q < 4; ++q) { const int row = 4 * r + q;
                const float* src = row < MR ? c.in[0] + (size_t)row * DM : c.in[1] + (size_t)(row - MR) * DM;
#pragma unroll
                for (int j = 0; j < 4; ++j) v[q][j] = *(const f32x4*)(src + 256 * j + 4 * lane); }
#pragma unroll
            for (int q = 0; q < 4; ++q) { u32x2* dst = (u32x2*)(c.b16(OFF_XB) + (size_t)(4 * r + q) * DM);
#pragma unroll
                for (int j = 0; j < 4; ++j) dst[64 * j + lane] = pk4(v[q][j]); }
            continue;
        }
        r -= T_XB;
        if (r < T_ROPE) {
            const int e = r * 64 + lane;
            if (e < TT * 144) {
                const int pos = e / 144, j = e % 144; float cs, sn;
                if (j < 16) { sincos_d((double)pos * p.inv0[j], cs, sn); c.f32(OFF_ROPE0C)[pos * 16 + j] = cs; c.f32(OFF_ROPE0S)[pos * 16 + j] = sn; }
                else { sincos_d((double)pos * p.inv1[j - 16], cs, sn); c.f32(OFF_ROPE1C)[pos * 128 + j - 16] = cs; c.f32(OFF_ROPE1S)[pos * 128 + j - 16] = sn; }
            }
            continue;
        }
        r -= T_ROPE;
        { const int ch = r * 64 + lane; const float lam = c.in[9][ch]; c.f32(OFF_CCH)[ch] = -8.f * log1pf(__expf(-lam)); }
    }
}

__device__ __forceinline__ void phase_conv(const Ctx& c, int bid, int nb) {
    const int tid = opaque_tid(), wid = tid >> 6, lane = tid & 63;
    const bf16_t* p0 = c.b16(OFF_P0); bf16_t* xc = c.b16(OFF_XC); bf16_t* Kb = c.b16(OFF_K);
    const float* cw = c.in[3]; const float* cb = c.in[4];
    const int ch0 = lane * 8;
    const int h = lane >> 3, d0 = (lane & 7) * 4, jj = d0 & 15;
    constexpr int RB = 4;
    for (int r0 = (bid * NWV + wid) * RB; r0 < MR + NMETA; r0 += nb * NWV * RB) {
        u32x4 x[RB][4]; u32x2 k1[RB], k2[RB]; f32x4 cs[RB], sn[RB];
#pragma unroll
        for (int q = 0; q < RB; ++q) {
            const int row = r0 + q;
#pragma unroll
            for (int w = 0; w < 4; ++w) {
                const int d = 3 - w; int srow = -1;
                if (row < MR) { const int sp = (row & (SEQ - 1)) - d; srow = sp >= 0 ? row - d : MR + NMETA + sp; }
                else { srow = (row - MR - d) >= 0 ? row - d : -1; }
                x[q][w] = srow >= 0 ? *(const u32x4*)(p0 + (size_t)srow * N_IN0 + 512 + ch0) : (u32x4){0u, 0u, 0u, 0u};
            }
            const int pos = row_pos(row);
            k1[q] = *(const u32x2*)(p0 + (size_t)row * N_IN0 + 1408 + jj); k2[q] = *(const u32x2*)(p0 + (size_t)row * N_IN0 + 1424 + jj);
            cs[q] = *(const f32x4*)(c.f32(OFF_ROPE0C) + pos * 16 + jj); sn[q] = *(const f32x4*)(c.f32(OFF_ROPE0S) + pos * 16 + jj);
        }
        f32x4 wq[4][2]; f32x4 bq[2];
#pragma unroll
        for (int w = 0; w < 4; ++w) { wq[w][0] = *(const f32x4*)(cw + w * 512 + ch0); wq[w][1] = *(const f32x4*)(cw + w * 512 + ch0 + 4); }
        bq[0] = *(const f32x4*)(cb + ch0); bq[1] = *(const f32x4*)(cb + ch0 + 4);
#pragma unroll
        for (int q = 0; q < RB; ++q) {
            const int row = r0 + q;
            f32x4 a0 = bq[0], a1 = bq[1];
#pragma unroll
            for (int w = 0; w < 4; ++w) { f32x4 lo, hi; unpk8(x[q][w], lo, hi); a0 += wq[w][0] * lo; a1 += wq[w][1] * hi; }
            *(u32x4*)(xc + (size_t)row * LRUW + ch0) = pk8(a0, a1);
            const f32x4 x1 = unpk4(k1[q]), x2 = unpk4(k2[q]);
            *(u32x2*)(Kb + (size_t)row * NQ + h * QKD + 64 + d0) = pk4(d0 < 16 ? x1 * cs[q] - x2 * sn[q] : x1 * sn[q] + x2 * cs[q]);
        }
    }
}

__device__ __forceinline__ f32x2 meta_state2(const Ctx& c, int ch) {
    f32x2 h = {0.f, 0.f}; const unsigned* ab = (const unsigned*)c.f32(OFF_ABMETA) + ch;
#pragma unroll
    for (int i = 0; i < NMETA; ++i) { const u32x2 w = *(const u32x2*)(ab + i * LRUW); h.x = (1.f - bf2f(w.x & 0xffffu)) * h.x + bf2f(w.x >> 16); h.y = (1.f - bf2f(w.y & 0xffffu)) * h.y + bf2f(w.y >> 16); }
    return h;
}
constexpr int SC_CH = 64, SC_NCK = SEQ / SC_CH;
__device__ __forceinline__ void phase_scan1(const Ctx& c, int bid, int nb) {
    const int tid = opaque_tid(), wid = tid >> 6, lane = tid & 63;
    for (int it = bid * NWV + wid; it < NBATCH * SC_NCK * 4; it += nb * NWV) {
        const int chg = it & 3, ck = (it >> 2) & (SC_NCK - 1), b = it >> 7, ch = chg * 128 + 2 * lane, row0 = b * SEQ + ck * SC_CH;
        const unsigned* ab = (const unsigned*)c.out + (size_t)row0 * LRUW + ch;
        f32x2 P = {1.f, 1.f}, S = {0.f, 0.f};
#pragma unroll 16
        for (int t = 0; t < SC_CH; ++t) { const u32x2 w = *(const u32x2*)(ab + (size_t)t * LRUW);
            const float a0 = 1.f - bf2f(w.x & 0xffffu), a1 = 1.f - bf2f(w.y & 0xffffu);
            S.x = a0 * S.x + bf2f(w.x >> 16); S.y = a1 * S.y + bf2f(w.y >> 16); P.x *= a0; P.y *= a1; }
        *(f32x4*)(c.f32(OFF_CARRY) + ((size_t)(b * SC_NCK + ck) * LRUW + ch) * 2) = (f32x4){P.x, S.x, P.y, S.y};
    }
}
__device__ __forceinline__ void scan1_local(const Ctx& c, int bid, int nb) {
    asm volatile("s_waitcnt vmcnt(0)" ::: "memory"); __syncthreads();
    const int tid = opaque_tid(), wid = tid >> 6, lane = tid & 63;
    pg8::StaticOrder S; S.init(MR, 1024, nb, bid);
    pg8::Unit u;
    for (int i = wid >> 2; S.next(i, u); i += 2) {
        const int b = u.pm >> 3, ck = (u.pm & 7) * 4 + (wid & 3), ch = u.pn * 128 + 2 * lane, row0 = b * SEQ + ck * SC_CH;
        const unsigned* ab = (const unsigned*)c.out + (size_t)row0 * LRUW + ch;
        f32x2 P = {1.f, 1.f}, Sm = {0.f, 0.f};
#pragma unroll 16
        for (int t = 0; t < SC_CH; ++t) { const u32x2 w = *(const u32x2*)(ab + (size_t)t * LRUW);
            const float a0 = 1.f - bf2f(w.x & 0xffffu), a1 = 1.f - bf2f(w.y & 0xffffu);
            Sm.x = a0 * Sm.x + bf2f(w.x >> 16); Sm.y = a1 * Sm.y + bf2f(w.y >> 16); P.x *= a0; P.y *= a1; }
        *(f32x4*)(c.f32(OFF_CARRY) + ((size_t)(b * SC_NCK + ck) * LRUW + ch) * 2) = (f32x4){P.x, Sm.x, P.y, Sm.y};
    }
}
__device__ __forceinline__ void phase_scan2(const Ctx& c, int bid, int nb) {
    const int tid = opaque_tid(), wid = tid >> 6, lane = tid & 63;
    const bf16_t* p0 = c.b16(OFF_P0); bf16_t* mix = c.b16(OFF_MIX);
    for (int it = bid * NWV + wid; it < NBATCH * SC_NCK * 4 + 4; it += nb * NWV) {
        if (it >= NBATCH * SC_NCK * 4) {
            const int ch = (it - NBATCH * SC_NCK * 4) * 128 + 2 * lane; f32x2 h = {0.f, 0.f};
            const unsigned* ab = (const unsigned*)c.f32(OFF_ABMETA) + ch;
            for (int i = 0; i < NMETA; ++i) { const u32x2 w = *(const u32x2*)(ab + i * LRUW); h.x = (1.f - bf2f(w.x & 0xffffu)) * h.x + bf2f(w.x >> 16); h.y = (1.f - bf2f(w.y & 0xffffu)) * h.y + bf2f(w.y >> 16);
                const int row = MR + i; const unsigned gt = *(const unsigned*)(p0 + (size_t)row * N_IN0 + ch);
                *(unsigned*)(mix + (size_t)row * DM + ch) = pk2(h.x * gelu_tanh(bf2f(gt & 0xffffu)), h.y * gelu_tanh(bf2f(gt >> 16))); }
            continue;
        }
        const int chg = it & 3, ck = (it >> 2) & (SC_NCK - 1), b = it >> 7, ch = chg * 128 + 2 * lane, row0 = b * SEQ + ck * SC_CH;
        f32x2 h = meta_state2(c, ch);
        const float* cr = c.f32(OFF_CARRY) + ((size_t)(b * SC_NCK) * LRUW + ch) * 2;
        for (int k = 0; k < ck; ++k) { const f32x4 ps = *(const f32x4*)(cr + (size_t)k * LRUW * 2); h.x = ps[0] * h.x + ps[1]; h.y = ps[2] * h.y + ps[3]; }
        const unsigned* ab = (const unsigned*)c.out + (size_t)row0 * LRUW + ch;
        for (int t0 = 0; t0 < SC_CH; t0 += 16) {
            u32x2 w[16]; unsigned gt[16];
#pragma unroll
            for (int t = 0; t < 16; ++t) { w[t] = *(const u32x2*)(ab + (size_t)(t0 + t) * LRUW); gt[t] = *(const unsigned*)(p0 + (size_t)(row0 + t0 + t) * N_IN0 + ch); }
#pragma unroll
            for (int t = 0; t < 16; ++t) {
                h.x = (1.f - bf2f(w[t].x & 0xffffu)) * h.x + bf2f(w[t].x >> 16); h.y = (1.f - bf2f(w[t].y & 0xffffu)) * h.y + bf2f(w[t].y >> 16);
                *(unsigned*)(mix + (size_t)(row0 + t0 + t) * DM + ch) = pk2(h.x * gelu_tanh(bf2f(gt[t] & 0xffffu)), h.y * gelu_tanh(bf2f(gt[t] >> 16)));
            }
        }
    }
}

__device__ __forceinline__ void phase_attn_naive(const Ctx& c, int bid, int nb, bool meta_only) {
    const int tid = opaque_tid(), wid = tid >> 6, lane = tid & 63;
    const bf16_t* Q = c.b16(OFF_Q); const bf16_t* K = c.b16(OFF_K); const bf16_t* V = c.b16(OFF_V); bf16_t* mix = c.b16(OFF_MIX);
    const long nitems = (long)NBATCH * MLA_H * SEQ + MLA_H * NMETA;
    for (long it = (meta_only ? (long)NBATCH * MLA_H * SEQ : 0) + (long)bid * NWV + wid; it < nitems; it += (long)nb * NWV) {
        int b, h, s, qrow;
        if (it < (long)NBATCH * MLA_H * SEQ) { s = (int)(it & (SEQ - 1)); h = (int)((it >> 11) & 7); b = (int)(it >> 14); qrow = b * SEQ + s; }
        else { const int r = (int)(it - (long)NBATCH * MLA_H * SEQ); s = r & 15; h = r >> 4; b = -1; qrow = MR + s; }
        float q[QKD];
#pragma unroll
        for (int j = 0; j < QKD / 8; ++j) { const u32x4 w = *(const u32x4*)(Q + (size_t)qrow * NQ + h * QKD + 8 * j);
            q[8 * j] = bf2f(w.x & 0xffffu); q[8 * j + 1] = bf2f(w.x >> 16); q[8 * j + 2] = bf2f(w.y & 0xffffu); q[8 * j + 3] = bf2f(w.y >> 16);
            q[8 * j + 4] = bf2f(w.z & 0xffffu); q[8 * j + 5] = bf2f(w.z >> 16); q[8 * j + 6] = bf2f(w.w & 0xffffu); q[8 * j + 7] = bf2f(w.w >> 16); }
        float m = -1e30f, l = 0.f, o = 0.f;
        const int ntile = b < 0 ? 1 : 2 + (s >> 6);
        for (int t = 0; t < ntile; ++t) {
            int krow0, nvalid;
            if (t == 0) { krow0 = MR; nvalid = b < 0 ? s + 1 : NMETA; } else { krow0 = b * SEQ + 64 * (t - 1); nvalid = min(64, s + 1 - 64 * (t - 1)); }
            const bool valid = lane < nvalid;
            float sv = 0.f;
            { const bf16_t* kp = K + (size_t)(krow0 + lane) * NQ + h * QKD;
#pragma unroll
              for (int j = 0; j < QKD / 8; ++j) { const u32x4 w = *(const u32x4*)(kp + 8 * j);
                sv += q[8 * j] * bf2f(w.x & 0xffffu) + q[8 * j + 1] * bf2f(w.x >> 16) + q[8 * j + 2] * bf2f(w.y & 0xffffu) + q[8 * j + 3] * bf2f(w.y >> 16)
                    + q[8 * j + 4] * bf2f(w.z & 0xffffu) + q[8 * j + 5] * bf2f(w.z >> 16) + q[8 * j + 6] * bf2f(w.w & 0xffffu) + q[8 * j + 7] * bf2f(w.w >> 16); } }
            if (!valid) sv = -1e30f;
            const float mn = fmaxf(m, wave_max(sv)), f = exp2f(m - mn), pv = valid ? exp2f(sv - mn) : 0.f;
            l = l * f + wave_sum(pv); o *= f; m = mn;
            for (int k = 0; k < nvalid; ++k) { const float pk = __shfl(pv, k); o += pk * bf2f(V[(size_t)(krow0 + k) * NV + h * VD + lane]); }
        }
        mix[(size_t)qrow * DM + 512 + h * VD + lane] = (bf16_t)(pk2(o / l, 0.f) & 0xffffu);
    }
}

typedef float f32x16 __attribute__((ext_vector_type(16)));
typedef short v4i16_t __attribute__((ext_vector_type(4)));
__device__ __forceinline__ int crow(int r, int hi) { return (r & 3) + 8 * (r >> 2) + 4 * hi; }
__device__ __forceinline__ bf16x8 tr_pair(const LAS unsigned char* p0, const LAS unsigned char* p1) {
    const v4i16_t a = __builtin_amdgcn_ds_read_tr16_b64_v4i16((LAS v4i16_t*)p0), b = __builtin_amdgcn_ds_read_tr16_b64_v4i16((LAS v4i16_t*)p1);
    return (bf16x8){a[0], a[1], a[2], a[3], b[0], b[1], b[2], b[3]};
}
constexpr int AT_KPITCH = 208, AT_KBYTES = 64 * AT_KPITCH  , AT_VBYTES = 8192, AT_BUF = AT_KBYTES + AT_VBYTES;
__device__ __forceinline__ void attn_unit(const Ctx& c, LAS unsigned char* lds, int b, int h, int qb) {
    const int tid = opaque_tid(), lane = tid & 63, wid = __builtin_amdgcn_readfirstlane(tid >> 6), r32 = lane & 31, hi = lane >> 5;
    const bf16_t* Q = c.b16(OFF_Q); const bf16_t* K = c.b16(OFF_K) + h * QKD; const bf16_t* V = c.b16(OFF_V) + h * VD; bf16_t* mix = c.b16(OFF_MIX);
    const int qrel = 32 * wid + r32;
    const size_t qrow = (size_t)b * SEQ + 256 * qb + qrel;
    bf16x8 qr[6];
#pragma unroll
    for (int d0 = 0; d0 < 6; ++d0) qr[d0] = *(const bf16x8*)(Q + qrow * NQ + h * QKD + 16 * d0 + 8 * hi);
    const int kp0 = tid, kp1 = tid + 512; const bool k1ok = tid < 256;
    const int kr0 = kp0 / 12, kc0 = kp0 % 12, kr1 = k1ok ? kp1 / 12 : 0, kc1 = k1ok ? kp1 % 12 : 0;
    const int vr = tid >> 3, vc = tid & 7;
    const unsigned kdst0 = kr0 * AT_KPITCH + kc0 * 16, kdst1 = kr1 * AT_KPITCH + kc1 * 16, vdst = AT_KBYTES + (vc >> 2) * 4096 + vr * 64 + (vc & 3) * 16;
    u32x4 kgA0, kgA1, vgA, kgB0, kgB1, vgB;
    const int NT = 4 * qb + 5;
#define AT_GLOAD(t, S) do { const size_t base_ = (t) == 0 ? (size_t)MR : (size_t)b * SEQ + 64 * ((t) - 1); \
        kg##S##0 = *(const u32x4*)(K + (base_ + kr0) * NQ + 8 * kc0); if (k1ok) kg##S##1 = *(const u32x4*)(K + (base_ + kr1) * NQ + 8 * kc1); \
        vg##S = *(const u32x4*)(V + (base_ + vr) * NV + 8 * vc); \
        if ((t) == 0) { const u32x4 z_ = (u32x4){0u, 0u, 0u, 0u}; if (kr0 >= NMETA) kg##S##0 = z_; if (kr1 >= NMETA) kg##S##1 = z_; if (vr >= NMETA) vg##S = z_; } } while (0)
#define AT_LWRITE(buf, S) do { LAS unsigned char* d_ = lds + (buf) * AT_BUF; *(LAS u32x4*)(d_ + kdst0) = kg##S##0; if (k1ok) *(LAS u32x4*)(d_ + kdst1) = kg##S##1; *(LAS u32x4*)(d_ + vdst) = vg##S; } while (0)
#define AT_BAR() do { asm volatile("s_waitcnt lgkmcnt(0)" ::: "memory"); __builtin_amdgcn_s_barrier(); asm volatile("" ::: "memory"); } while (0)
    f32x16 o0, o1;
#pragma unroll
    for (int r = 0; r < 16; ++r) { o0[r] = 0.f; o1[r] = 0.f; }
    float m = -1e30f, l = 0.f;
    AT_GLOAD(0, A); AT_LWRITE(0, A);
    AT_GLOAD(1, A);
    AT_BAR();
    const unsigned kfo = r32 * AT_KPITCH + hi * 16;
    const unsigned vfo = AT_KBYTES + ((lane >> 4) & 1) * 32 + (lane & 3) * 8 + (4 * hi + ((lane & 15) >> 2)) * 64;
#define AT_COMPUTE(t) do { \
        const int jb = (t) - 1 - 4 * qb; \
        if (jb < 0 || 64 * jb <= 32 * wid + 31) { \
            const LAS unsigned char* bufp = lds + ((t) & 1) * AT_BUF; \
            f32x16 p0, p1; \
            _Pragma("unroll") for (int r = 0; r < 16; ++r) { p0[r] = 0.f; p1[r] = 0.f; } \
            _Pragma("unroll") for (int d0 = 0; d0 < 6; ++d0) { \
                const bf16x8 k0 = *(const LAS bf16x8*)(bufp + kfo + d0 * 32), k1 = *(const LAS bf16x8*)(bufp + kfo + 32 * AT_KPITCH + d0 * 32); \
                p0 = __builtin_amdgcn_mfma_f32_32x32x16_bf16(k0, qr[d0], p0, 0, 0, 0); \
                p1 = __builtin_amdgcn_mfma_f32_32x32x16_bf16(k1, qr[d0], p1, 0, 0, 0); } \
            if ((t) == 0) { asm volatile("" ::: "memory"); \
                _Pragma("unroll") for (int r = 0; r < 16; ++r) { if (crow(r, hi) >= NMETA) p0[r] = -1e30f; p1[r] = -1e30f; } \
            } else if (jb >= 0) { asm volatile("" ::: "memory"); \
                _Pragma("unroll") for (int r = 0; r < 16; ++r) { const int kv = 64 * jb + crow(r, hi); if (kv > qrel) p0[r] = -1e30f; if (kv + 32 > qrel) p1[r] = -1e30f; } } \
            float rm = fmaxf(fmaxf(p0[0], p1[0]), fmaxf(p0[1], p1[1])); \
            _Pragma("unroll") for (int r = 2; r < 16; r += 2) rm = fmaxf(rm, fmaxf(fmaxf(p0[r], p1[r]), fmaxf(p0[r + 1], p1[r + 1]))); \
            rm = fmaxf(rm, __shfl_xor(rm, 32)); \
            const float mn = fmaxf(m, rm), f = __builtin_amdgcn_exp2f(m - mn); m = mn; \
            float ls = 0.f; \
            _Pragma("unroll") for (int r = 0; r < 16; ++r) { p0[r] = __builtin_amdgcn_exp2f(p0[r] - mn); p1[r] = __builtin_amdgcn_exp2f(p1[r] - mn); ls += p0[r] + p1[r]; } \
            l = l * f + ls; \
            if (__any(f != 1.f)) { asm volatile("" ::: "memory"); \
                _Pragma("unroll") for (int r = 0; r < 16; ++r) { o0[r] *= f; o1[r] *= f; } } \
            u32x4 pw[4]; \
            _Pragma("unroll") for (int q4 = 0; q4 < 4; ++q4) { pw[0][q4] = pk2(p0[2 * q4], p0[2 * q4 + 1]); pw[1][q4] = pk2(p0[8 + 2 * q4], p0[9 + 2 * q4]); pw[2][q4] = pk2(p1[2 * q4], p1[2 * q4 + 1]); pw[3][q4] = pk2(p1[8 + 2 * q4], p1[9 + 2 * q4]); } \
            _Pragma("unroll") for (int s4 = 0; s4 < 4; ++s4) { \
                const bf16x8 pf = __builtin_bit_cast(bf16x8, pw[s4]); \
                const bf16x8 v0 = tr_pair(bufp + vfo + s4 * 1024, bufp + vfo + s4 * 1024 + 512); \
                const bf16x8 v1 = tr_pair(bufp + vfo + 4096 + s4 * 1024, bufp + vfo + 4096 + s4 * 1024 + 512); \
                o0 = __builtin_amdgcn_mfma_f32_32x32x16_bf16(v0, pf, o0, 0, 0, 0); \
                o1 = __builtin_amdgcn_mfma_f32_32x32x16_bf16(v1, pf, o1, 0, 0, 0); } \
        } } while (0)
    for (int t = 0; t < NT; t += 2) {
        if (t + 2 < NT) AT_GLOAD(t + 2, B);
        AT_COMPUTE(t);
        if (t + 1 < NT) AT_LWRITE((t + 1) & 1, A);
        AT_BAR();
        if (t + 1 < NT) {
            if (t + 3 < NT) AT_GLOAD(t + 3, A);
            AT_COMPUTE(t + 1);
            if (t + 2 < NT) AT_LWRITE((t + 2) & 1, B);
            AT_BAR();
        }
    }
    asm volatile("s_waitcnt vmcnt(0)" ::: "memory");
#undef AT_GLOAD
#undef AT_LWRITE
#undef AT_COMPUTE
#undef AT_BAR
    l += __shfl_xor(l, 32);
    const float inv = frcp(l);
    bf16_t* orow = mix + qrow * DM + 512 + h * VD + 4 * hi;
#pragma unroll
    for (int g = 0; g < 4; ++g) {
        *(u32x2*)(orow + 8 * g) = pk4((f32x4){o0[4 * g] * inv, o0[4 * g + 1] * inv, o0[4 * g + 2] * inv, o0[4 * g + 3] * inv});
        *(u32x2*)(orow + 32 + 8 * g) = pk4((f32x4){o1[4 * g] * inv, o1[4 * g + 1] * inv, o1[4 * g + 2] * inv, o1[4 * g + 3] * inv});
    }
}
__device__ __forceinline__ void phase_attn_fast(const Ctx& c, LAS unsigned char* lds, int bid, int nb) {
    const int vcu = (nb % 8 == 0) ? (bid % 8) * (nb / 8) + bid / 8 : bid;
    for (int slot = vcu; slot < 256; slot += nb) {
        const int bh = slot >> 1;
        for (int i = 0; i < 4; ++i) { const int s_ = 2 * (slot & 1) + (i >> 1), qb = (i & 1) ? s_ : 7 - s_; attn_unit(c, lds, bh >> 3, bh & 7, qb); }
    }
}

__device__ __forceinline__ void phase_ret_naive(const Ctx& c, LAS unsigned char* lds, int bid, int nb) {
    const int tid = opaque_tid(), wid = tid >> 6, lane = tid & 63;
    const bf16_t* Q1 = c.b16(OFF_Q1); const bf16_t* K1 = c.b16(OFF_K1); const bf16_t* V1 = c.b16(OFF_V1); bf16_t* G1 = c.b16(OFF_G1);
    LAS float* qs = (LAS float*)(lds + wid * 1024);
    const long nitems = (long)NBATCH * RET_H * SEQ;
    for (long it = (long)bid * NWV + wid; it < nitems; it += (long)nb * NWV) {
        const int s = (int)(it & (SEQ - 1)), h = (int)((it >> 11) & 3), b = (int)(it >> 13), qrow = b * SEQ + s;
        { const u32x2 w = *(const u32x2*)(Q1 + (size_t)qrow * 1024 + h * RDK + 4 * lane); const f32x4 f = unpk4(w); qs[4 * lane] = f[0]; qs[4 * lane + 1] = f[1]; qs[4 * lane + 2] = f[2]; qs[4 * lane + 3] = f[3]; }
        asm volatile("s_waitcnt lgkmcnt(0)" ::: "memory");
        const float lg2 = log2f(1.f - exp2f(-5.f - (float)h));
        float o[8];
#pragma unroll
        for (int e = 0; e < 8; ++e) o[e] = 0.f;
        const int ntile = 2 + (s >> 6), qpos = NMETA + s;
        for (int t = 0; t < ntile; ++t) {
            int krow0, nvalid, kpos0;
            if (t == 0) { krow0 = MR; nvalid = NMETA; kpos0 = 0; } else { krow0 = b * SEQ + 64 * (t - 1); nvalid = min(64, s + 1 - 64 * (t - 1)); kpos0 = NMETA + 64 * (t - 1); }
            float sv = 0.f;
            { const bf16_t* kp = K1 + (size_t)(krow0 + lane) * 1024 + h * RDK;
#pragma unroll 4
              for (int j = 0; j < RDK / 8; ++j) { const u32x4 w = *(const u32x4*)(kp + 8 * j); const LAS float* qq = qs + 8 * j;
                sv += qq[0] * bf2f(w.x & 0xffffu) + qq[1] * bf2f(w.x >> 16) + qq[2] * bf2f(w.y & 0xffffu) + qq[3] * bf2f(w.y >> 16)
                    + qq[4] * bf2f(w.z & 0xffffu) + qq[5] * bf2f(w.z >> 16) + qq[6] * bf2f(w.w & 0xffffu) + qq[7] * bf2f(w.w >> 16); } }
            const float wv = lane < nvalid ? sv * exp2f(lg2 * (float)(qpos - kpos0 - lane)) : 0.f;
            for (int k = 0; k < nvalid; ++k) { const float wk = __shfl(wv, k); const u32x4 w = *(const u32x4*)(V1 + (size_t)(krow0 + k) * RMIX + h * RDV + 8 * lane);
                o[0] += wk * bf2f(w.x & 0xffffu); o[1] += wk * bf2f(w.x >> 16); o[2] += wk * bf2f(w.y & 0xffffu); o[3] += wk * bf2f(w.y >> 16);
                o[4] += wk * bf2f(w.z & 0xffffu); o[5] += wk * bf2f(w.z >> 16); o[6] += wk * bf2f(w.w & 0xffffu); o[7] += wk * bf2f(w.w >> 16); }
        }
        float ss = 0.f;
#pragma unroll
        for (int e = 0; e < 8; ++e) ss += o[e] * o[e];
        const float rstd = frsq(wave_sum(ss) * (1.f / RDV) + LN_EPS);
        bf16_t* gp = G1 + (size_t)qrow * RMIX + h * RDV + 8 * lane; const u32x4 gw = *(const u32x4*)gp;
        u32x4 r; r.x = pk2(bf2f(gw.x & 0xffffu) * o[0] * rstd, bf2f(gw.x >> 16) * o[1] * rstd); r.y = pk2(bf2f(gw.y & 0xffffu) * o[2] * rstd, bf2f(gw.y >> 16) * o[3] * rstd);
        r.z = pk2(bf2f(gw.z & 0xffffu) * o[4] * rstd, bf2f(gw.z >> 16) * o[5] * rstd); r.w = pk2(bf2f(gw.w & 0xffffu) * o[6] * rstd, bf2f(gw.w >> 16) * o[7] * rstd);
        *(u32x4*)gp = r;
    }
}

__device__ __forceinline__ unsigned off_b(unsigned row, unsigned ch) { return 256u * row + 16u * (ch ^ (((row & 3) << 2) | ((row >> 2) & 3))); }
constexpr int RT_Q = 0, RT_K = 32768, RT_V = 65536, RT_ST = 81920, RT_END = 147456;
__device__ __forceinline__ void ret_unit(const Ctx& c, LAS unsigned char* lds, int b, int h, int sl) {
    const int tid0 = opaque_tid(), wid = __builtin_amdgcn_readfirstlane(tid0 >> 6); int tid = tid0, lane = tid & 63, r32 = lane & 31, hi = lane >> 5;
    const int wi = wid & 1, wdv = wid >> 1;
    const int wk = wid & 3, wd = wid >> 2;
    const bf16_t* Q1 = c.b16(OFF_Q1) + h * RDK; const bf16_t* K1 = c.b16(OFF_K1) + h * RDK; bf16_t* V1 = c.b16(OFF_V1) + h * RDV + sl * 128;
    float* osq = c.out;
    const float lg2 = log2f(1.f - exp2f(-5.f - (float)h));
    const float g64 = exp2f(lg2 * 64.f);
    const int il = 32 * wi + r32;
    const float rowscale = exp2f(lg2 * (float)(il - 63));
    u32x4 gq[4], gk[4], gv[2];
    f32x16 S[2][2];
#pragma unroll
    for (int a = 0; a < 2; ++a)
#pragma unroll
        for (int bb = 0; bb < 2; ++bb)
#pragma unroll
            for (int r = 0; r < 16; ++r) S[a][bb][r] = 0.f;
#define RT_GLOAD(cc) do { const size_t base_ = (cc) == 0 ? (size_t)MR : (size_t)b * SEQ + 64 * ((cc) - 1); \
        _Pragma("unroll") for (int k_ = 0; k_ < 4; ++k_) { const int p_ = tid + 512 * k_; gq[k_] = *(const u32x4*)(Q1 + (base_ + (p_ >> 5)) * 1024 + 8 * (p_ & 31)); gk[k_] = *(const u32x4*)(K1 + (base_ + (p_ >> 5)) * 1024 + 8 * (p_ & 31)); } \
        _Pragma("unroll") for (int k_ = 0; k_ < 2; ++k_) { const int p_ = tid + 512 * k_; gv[k_] = *(const u32x4*)(V1 + (base_ + (p_ >> 4)) * RMIX + 8 * (p_ & 15)); } } while (0)
#define RT_LWRITE(cc) do { const int L_ = (cc) == 0 ? NMETA : 64; \
        _Pragma("unroll") for (int k_ = 0; k_ < 4; ++k_) { const int p_ = tid + 512 * k_, row_ = p_ >> 5, ch_ = p_ & 31; const unsigned o_ = (ch_ >> 4) * 16384 + off_b(row_, ch_ & 15); \
            const bool ok_ = row_ < L_; const u32x4 z_ = (u32x4){0u, 0u, 0u, 0u}; \
            *(LAS u32x4*)(lds + RT_Q + o_) = ok_ ? gq[k_] : z_; *(LAS u32x4*)(lds + RT_K + o_) = ok_ ? gk[k_] : z_; } \
        _Pragma("unroll") for (int k_ = 0; k_ < 2; ++k_) { const int p_ = tid + 512 * k_, row_ = p_ >> 4, ch_ = p_ & 15; \
            const float fc_ = (cc) == 0 ? (row_ < NMETA ? exp2f(lg2 * (float)(NMETA - 1 - row_)) : 0.f) : fcv[k_]; const u32x4 w_ = gv[k_]; u32x4 r_; \
            r_.x = pk2(bf2f(w_.x & 0xffffu) * fc_, bf2f(w_.x >> 16) * fc_); r_.y = pk2(bf2f(w_.y & 0xffffu) * fc_, bf2f(w_.y >> 16) * fc_); \
            r_.z = pk2(bf2f(w_.z & 0xffffu) * fc_, bf2f(w_.z >> 16) * fc_); r_.w = pk2(bf2f(w_.w & 0xffffu) * fc_, bf2f(w_.w >> 16) * fc_); \
            *(LAS u32x4*)(lds + RT_V + off_b(row_, ch_)) = r_; } } while (0)
    const float fcv[2] = {exp2f(lg2 * (float)(63 - (tid0 >> 4))), exp2f(lg2 * (float)(31 - (tid0 >> 4)))};
    for (int i = tid; i < 65536 / 16; i += 512) *(LAS u32x4*)(lds + RT_ST + i * 16) = (u32x4){0u, 0u, 0u, 0u};
    RT_GLOAD(0); RT_LWRITE(0);
    __syncthreads();
    for (int cc = 0; cc <= 32; ++cc) {
        const bool more = cc < 32;
        tid = tid0; asm volatile("" : "+v"(tid)); lane = tid & 63; r32 = lane & 31; hi = lane >> 5;
        const unsigned h5 = lane >> 5, blk = (lane >> 4) & 1, q4 = (lane & 15) >> 2, p3 = lane & 3;
        if (more) RT_GLOAD(cc + 1);
        u32x2 gg[4];
        if (cc > 0) {
            const bf16_t* gp = c.b16(OFF_G1) + ((size_t)b * SEQ + 64 * (cc - 1) + 32 * wi + r32) * RMIX + h * RDV + sl * 128 + 32 * wdv + 4 * hi;
#pragma unroll
            for (int g = 0; g < 4; ++g) gg[g] = *(const u32x2*)(gp + 8 * g);
        }
        f32x16 P0, P1, acc;
#pragma unroll
        for (int r = 0; r < 16; ++r) { P0[r] = 0.f; P1[r] = 0.f; acc[r] = 0.f; }
#pragma unroll
        for (int s = 0; s < 16; ++s) {
            const unsigned hf = (s >> 3) * 16384, ch = 2 * (s & 7) + h5;
            const bf16x8 qf = *(const LAS bf16x8*)(lds + RT_Q + hf + off_b(32 * wi + r32, ch));
            const bf16x8 k0 = *(const LAS bf16x8*)(lds + RT_K + hf + off_b(r32, ch)), k1 = *(const LAS bf16x8*)(lds + RT_K + hf + off_b(32 + r32, ch));
            const bf16x8 sf = *(const LAS bf16x8*)(lds + RT_ST + (s >> 3) * 32768 + off_b(32 * wdv + r32, ch));
            P0 = __builtin_amdgcn_mfma_f32_32x32x16_bf16(k0, qf, P0, 0, 0, 0);
            P1 = __builtin_amdgcn_mfma_f32_32x32x16_bf16(k1, qf, P1, 0, 0, 0);
            acc = __builtin_amdgcn_mfma_f32_32x32x16_bf16(sf, qf, acc, 0, 0, 0);
        }
#pragma unroll
        for (int r = 0; r < 16; ++r) { const int j = crow(r, hi); if (j > il) P0[r] = 0.f; if (j + 32 > il) P1[r] = 0.f; acc[r] *= g64; }
        u32x4 pw[4];
#pragma unroll
        for (int e = 0; e < 4; ++e) { pw[0][e] = pk2(P0[2 * e], P0[2 * e + 1]); pw[1][e] = pk2(P0[8 + 2 * e], P0[9 + 2 * e]); pw[2][e] = pk2(P1[2 * e], P1[2 * e + 1]); pw[3][e] = pk2(P1[8 + 2 * e], P1[9 + 2 * e]); }
#pragma unroll
        for (int ks = 0; ks < 4; ++ks) {
            const unsigned chv = 4 * wdv + 2 * blk + (p3 >> 1);
            const bf16x8 vf = tr_pair(lds + RT_V + off_b(16 * ks + 4 * h5 + q4, chv) + 8 * (p3 & 1), lds + RT_V + off_b(16 * ks + 4 * h5 + 8 + q4, chv) + 8 * (p3 & 1));
            acc = __builtin_amdgcn_mfma_f32_32x32x16_bf16(vf, __builtin_bit_cast(bf16x8, pw[ks]), acc, 0, 0, 0);
        }
        if (cc > 0) {
            const size_t row = (size_t)b * SEQ + 64 * (cc - 1) + il;
            float ss = 0.f;
            bf16_t* orow = V1 + row * RMIX + 32 * wdv + 4 * hi;
#pragma unroll
            for (int g = 0; g < 4; ++g) {
                const f32x4 ov = (f32x4){acc[4 * g] * rowscale, acc[4 * g + 1] * rowscale, acc[4 * g + 2] * rowscale, acc[4 * g + 3] * rowscale};
                ss += ov[0] * ov[0] + ov[1] * ov[1] + ov[2] * ov[2] + ov[3] * ov[3];
                *(u32x2*)(orow + 8 * g) = pk4(ov * unpk4(gg[g]));
            }
            ss += __shfl_xor(ss, 32);
            if (hi == 0) osq[(row * 4 + h) * 16 + sl * 4 + wdv] = ss;
        }
        {
            const float gl = cc == 0 ? 1.f : g64;
#pragma unroll
            for (int a = 0; a < 2; ++a)
#pragma unroll
                for (int bb = 0; bb < 2; ++bb)
#pragma unroll
                    for (int r = 0; r < 16; ++r) S[a][bb][r] *= gl;
#pragma unroll
            for (int ks = 0; ks < 4; ++ks) {
                bf16x8 kf[2], vf[2];
#pragma unroll
                for (int a = 0; a < 2; ++a) {
                    const unsigned chk = 4 * (2 * (wk & 1) + a) + 2 * blk + (p3 >> 1), hfk = (wk >> 1) * 16384;
                    kf[a] = tr_pair(lds + RT_K + hfk + off_b(16 * ks + 8 * h5 + q4, chk) + 8 * (p3 & 1), lds + RT_K + hfk + off_b(16 * ks + 8 * h5 + 4 + q4, chk) + 8 * (p3 & 1));
                    const unsigned chv = 4 * (2 * wd + a) + 2 * blk + (p3 >> 1);
                    vf[a] = tr_pair(lds + RT_V + off_b(16 * ks + 8 * h5 + q4, chv) + 8 * (p3 & 1), lds + RT_V + off_b(16 * ks + 8 * h5 + 4 + q4, chv) + 8 * (p3 & 1));
                }
#pragma unroll
                for (int a = 0; a < 2; ++a)
#pragma unroll
                    for (int bb = 0; bb < 2; ++bb) S[a][bb] = __builtin_amdgcn_mfma_f32_32x32x16_bf16(kf[a], vf[bb], S[a][bb], 0, 0, 0);
            }
        }
        __syncthreads();
        if (more) {
#pragma unroll
            for (int a = 0; a < 2; ++a)
#pragma unroll
                for (int bb = 0; bb < 2; ++bb)
#pragma unroll
                    for (int g = 0; g < 4; ++g) {
                        const unsigned dvr = 64 * wd + 32 * bb + r32, chunk = 8 * (wk & 1) + 4 * a + g;
                        *(LAS u32x2*)(lds + RT_ST + (wk >> 1) * 32768 + off_b(dvr, chunk) + 8 * hi) = pk4((f32x4){S[a][bb][4 * g], S[a][bb][4 * g + 1], S[a][bb][4 * g + 2], S[a][bb][4 * g + 3]});
                    }
            RT_LWRITE(cc + 1);
        }
        __syncthreads();
    }
#undef RT_GLOAD
#undef RT_LWRITE
}
__device__ __forceinline__ void phase_ret_fast(const Ctx& c, LAS unsigned char* lds, int bid, int nb) {
    const int vcu = (nb % 8 == 0) ? (bid % 8) * (nb / 8) + bid / 8 : bid;
    for (int u = vcu; u < 256; u += nb) ret_unit(c, lds, u >> 4, (u >> 2) & 3, u & 3);
}
__device__ __forceinline__ void phase_gatepass(const Ctx& c, int bid, int nb) {
    const int tid = opaque_tid(), wid = tid >> 6, lane = tid & 63;
    const bf16_t* O = c.b16(OFF_V1); bf16_t* G1 = c.b16(OFF_G1); const float* osq = c.out;
    for (int row = bid * NWV + wid; row < MR; row += nb * NWV) {
        float sq = osq[(size_t)row * 64 + lane];
        sq += __shfl_xor(sq, 1); sq += __shfl_xor(sq, 2); sq += __shfl_xor(sq, 4); sq += __shfl_xor(sq, 8);
        const float rs = frsq(sq * (1.f / RDV) + LN_EPS);
#pragma unroll
        for (int k = 0; k < 4; ++k) {
            const float r = __shfl(rs, 16 * k);
            const size_t off = (size_t)row * RMIX + 512 * k + 8 * lane;
            const u32x4 ow = *(const u32x4*)(O + off), gw = *(const u32x4*)(G1 + off);
            u32x4 o;
            o.x = pk2(bf2f(gw.x & 0xffffu) * bf2f(ow.x & 0xffffu) * r, bf2f(gw.x >> 16) * bf2f(ow.x >> 16) * r);
            o.y = pk2(bf2f(gw.y & 0xffffu) * bf2f(ow.y & 0xffffu) * r, bf2f(gw.y >> 16) * bf2f(ow.y >> 16) * r);
            o.z = pk2(bf2f(gw.z & 0xffffu) * bf2f(ow.z & 0xffffu) * r, bf2f(gw.z >> 16) * bf2f(ow.z >> 16) * r);
            o.w = pk2(bf2f(gw.w & 0xffffu) * bf2f(ow.w & 0xffffu) * r, bf2f(gw.w >> 16) * bf2f(ow.w >> 16) * r);
            *(u32x4*)(G1 + off) = o;
        }
    }
}

__device__ __forceinline__ void phase_final(const Ctx& c, int bid, int nb) {
    const int tid = opaque_tid(), wid = tid >> 6, lane = tid & 63;
    const float* g = c.in[21] + 1024; const float* bv = c.in[22] + 1024;
    for (int row = bid * NWV + wid; row < MR; row += nb * NWV) {
        f32x4* zr = (f32x4*)(c.out + (size_t)row * DM) + lane;
        f32x4 v[4]; float s = 0.f;
#pragma unroll
        for (int j = 0; j < 4; ++j) { v[j] = zr[64 * j]; s += (v[j][0] + v[j][1]) + (v[j][2] + v[j][3]); }
        const float mean = wave_sum(s) * (1.f / DM); float s2 = 0.f;
#pragma unroll
        for (int j = 0; j < 4; ++j) { v[j] = v[j] - mean; s2 += (v[j][0] * v[j][0] + v[j][1] * v[j][1]) + (v[j][2] * v[j][2] + v[j][3] * v[j][3]); }
        const float rstd = frsq(wave_sum(s2) * (1.f / DM) + LN_EPS);
#pragma unroll
        for (int j = 0; j < 4; ++j) zr[64 * j] = v[j] * rstd * *(const f32x4*)(g + 256 * j + 4 * lane) + *(const f32x4*)(bv + 256 * j + 4 * lane);
    }
}


#define XB_TMO      128
#define XB_XCNT(j)  (256  + 64 * (j))
#define XB_XSUB(j)  (1280 + 64 * (j))
#define XB_XGEN(j)  (2304 + 64 * (j))
#define XB_TOP      3328
#define XB_TOPGEN   3392
#define XCD_BAR_WORDS 3456
#define XB_SPIN_CAP (1u << 18)
__device__ __forceinline__ unsigned xb_ld(unsigned* p)              { return __hip_atomic_load(p, __ATOMIC_RELAXED, __HIP_MEMORY_SCOPE_AGENT); }
__device__ __forceinline__ unsigned xb_add(unsigned* p, unsigned v) { return __hip_atomic_fetch_add(p, v, __ATOMIC_RELAXED, __HIP_MEMORY_SCOPE_AGENT); }
__device__ __forceinline__ unsigned xb_xcc_id() { return (unsigned)__builtin_amdgcn_s_getreg((3 << 11) | 20) & 0xFu; }
#define XB_SPIN(cond, bar) do { unsigned _sp = 0; while (cond) { __builtin_amdgcn_s_sleep(1); \
    if ((++_sp & 255u) == 0u) { if (xb_ld(&(bar)[XB_TMO])) break; if (_sp > XB_SPIN_CAP) { atomicAdd(&(bar)[XB_TMO], 1u); break; } } } } while (0)
struct XcdBarrier { unsigned* bar; unsigned x; volatile LAS unsigned* st; };
__device__ __forceinline__ XcdBarrier xcd_barrier_post(unsigned* bar, volatile LAS unsigned* st) {
    XcdBarrier b; b.bar = bar; b.x = xb_xcc_id(); b.st = st;
    if (threadIdx.x == 0) (void)xb_add(&bar[XB_XCNT(b.x)], 1u);
    return b;
}
__device__ __forceinline__ void xcd_barrier_complete(unsigned* bar, unsigned x, unsigned& nloc, unsigned& nx) {
    const unsigned G = gridDim.x * gridDim.y * gridDim.z;
    unsigned sum, cnt, mine, sp = 0u;
    for (;;) {
        sum = 0u; cnt = 0u; mine = 0u;
#pragma unroll
        for (unsigned j = 0; j < 16; ++j) { const unsigned c = xb_ld(&bar[XB_XCNT(j)]); sum += c; cnt += (c > 0u) ? 1u : 0u; mine = (j == x) ? c : mine; }
        if (sum == G) break;
        __builtin_amdgcn_s_sleep(1);
        if ((++sp & 255u) == 0u) { if (xb_ld(&bar[XB_TMO])) break; if (sp > XB_SPIN_CAP) { atomicAdd(&bar[XB_TMO], 1u); break; } }
    }
    nloc = mine > 0u ? mine : 1u; nx = cnt > 0u ? cnt : 1u;
}
__device__ __forceinline__ void xcd_barrier(const XcdBarrier& b) {
    asm volatile("s_waitcnt vmcnt(0)" ::: "memory");
    __syncthreads();
    if (threadIdx.x == 0) {
        unsigned* bar = b.bar;
        __builtin_amdgcn_s_waitcnt(0);
        unsigned nloc = b.st[0], nx = b.st[1];
        if (nloc == 0u) { xcd_barrier_complete(bar, b.x, nloc, nx); b.st[0] = nloc; b.st[1] = nx; }
        const unsigned old = xb_add(&bar[XB_XSUB(b.x)], 1u);
        const unsigned gen = old / nloc;
        if (old + 1u == (gen + 1u) * nloc) {
            __builtin_amdgcn_fence(__ATOMIC_RELEASE, "agent");
            asm volatile("s_waitcnt vmcnt(0)" ::: "memory");
            const unsigned og = xb_add(&bar[XB_TOP], 1u);
            const unsigned tg = og / nx;
            if (og + 1u == (tg + 1u) * nx) xb_add(&bar[XB_TOPGEN], 1u);
            else XB_SPIN(xb_ld(&bar[XB_TOPGEN]) == tg, bar);
            __builtin_amdgcn_fence(__ATOMIC_ACQUIRE, "agent");
            xb_add(&bar[XB_XGEN(b.x)], 1u);
            asm volatile("s_waitcnt vmcnt(0)" ::: "memory");
        } else {
            XB_SPIN(xb_ld(&bar[XB_XGEN(b.x)]) == gen, bar);
            __builtin_amdgcn_fence(__ATOMIC_ACQUIRE, "agent");
            asm volatile("s_waitcnt vmcnt(0)" ::: "memory");
        }
    }
    __syncthreads();
}

enum { PH_PRO = 0, PH_IN0, PH_PREP, PH_GATE, PH_ATTN, PH_OUT0, PH_UP0, PH_DOWN0, PH_IN1, PH_RET, PH_OUT1, PH_UP1, PH_DOWN1, NPH };
constexpr int LDS_MISC = 161792, LDS_BYTES = 163840;
static_assert(NPH == 13, "phase list");

__device__ __forceinline__ void run_phase(int ph, const Ctx& c, const Params& p, LAS unsigned char* lds, int bid, int nb) {
    const float* stA = c.f32(OFF_STATA); const float* stB = c.f32(OFF_STATB); const float* cv = c.f32(OFF_C12);
    switch (ph) {
#ifdef PROBE_PRO_SPLIT
    case PH_PRO: { unsigned long long* pts = (unsigned long long*)(c.ws + OFF_CTL + 32768); const bool st = bid == 0 && threadIdx.x == 0;
        if (st) pts[0] = __builtin_amdgcn_s_memrealtime();
        phase_prologue(c, p, lds, bid, nb, 1); cg::this_grid().sync();
        if (st) pts[1] = __builtin_amdgcn_s_memrealtime();
        phase_prologue(c, p, lds, bid, nb, 2); cg::this_grid().sync();
        if (st) pts[2] = __builtin_amdgcn_s_memrealtime(); } break;
#else
    case PH_PRO: phase_prologue(c, p, lds, bid, nb); break;
#endif
    case PH_IN0: {
        Gemm g{c.b16(OFF_XB), c.b16(OFF_WIN0), MR, N_IN0, 1024, 1024, 1024, 0};
        EpiIn0 e{c.b16(OFF_P0), c.f32(OFF_SSQQ), c.f32(OFF_SSQKV)};
        run_gemm(lds, g, e, bid, nb);
    } break;
    case PH_PREP: {
        phase_conv(c, bid, nb);
        { Gemm g{c.b16(OFF_P0) + 1024, c.b16(OFF_WUQ), MR, NQ, QRANK, N_IN0, QRANK, 0};
          EpiQup e{c.b16(OFF_Q), c.f32(OFF_SSQQ), c.f32(OFF_ROPE0C), c.f32(OFF_ROPE0S)}; run_gemm(lds, g, e, bid, nb); }
        { Gemm g{c.b16(OFF_P0) + 1280, c.b16(OFF_WUKV), MR, 1024, KVRANK, N_IN0, KVRANK, 0};
          EpiKVup e{c.b16(OFF_K), c.b16(OFF_V), c.f32(OFF_SSQKV)}; run_gemm(lds, g, e, bid, nb); }
    } break;
    case PH_GATE: {
        Gemm g{c.b16(OFF_XC), c.b16(OFF_WGATE), MR, 1024, 128, LRUW, 128, 128};
        EpiGate e{c, c.b16(OFF_XC), c.f32(OFF_CCH), c.in[6], c.in[8]};
        run_gemm(lds, g, e, bid, nb);
        scan1_local(c, bid, nb);
    } break;
#if FAST_ATTN
    case PH_ATTN: phase_scan2(c, bid, nb); phase_attn_naive(c, bid, nb, true); phase_attn_fast(c, lds, bid, nb); break;
#else
    case PH_ATTN: phase_scan2(c, bid, nb); phase_attn_naive(c, bid, nb, false); break;
#endif
    case PH_OUT0: {
        Gemm g{c.b16(OFF_MIX), c.b16(OFF_WOUT0), MR, 1024, 1024, 1024, 1024, 0};
        EpiRes<0, false> e{c, c.b16(OFF_ZB), nullptr, c.f32(OFF_STATA), nullptr, nullptr, (const float*)c.b16(OFF_XB), nullptr};
        run_gemm(lds, g, e, bid, nb);
    } break;
    case PH_UP0: {
        Gemm g{c.b16(OFF_ZB), c.b16(OFF_W1_0), MR, FF, 1024, 1024, 1024, 0};
        EpiMlpUp e{{stA, cv + C1_UP0, cv + C2_UP0}, c.b16(OFF_HID)};
        run_gemm(lds, g, e, bid, nb);
#ifdef PROBE_NULLGEMM
        { EpiNull en; run_gemm(lds, g, en, bid, nb, false); }
#endif
    } break;
    case PH_DOWN0: {
        Gemm g{c.b16(OFF_HID), c.b16(OFF_W2_0), MR, 1024, FF, FF, FF, 0};
        EpiRes<1, false> e{c, c.b16(OFF_ZB), stA, c.f32(OFF_STATB), c.in[17], c.in[18], nullptr, nullptr};
        run_gemm(lds, g, e, bid, nb);
    } break;
    case PH_IN1: {
        Gemm g{c.b16(OFF_ZB), c.b16(OFF_WIN1), MR, N_IN1, 1024, 1024, 1024, 0};
        EpiIn1 e{{stB, cv + C1_IN1, cv + C2_IN1}, c.b16(OFF_Q1), c.b16(OFF_K1), c.b16(OFF_V1), c.b16(OFF_G1), c.f32(OFF_ROPE1C), c.f32(OFF_ROPE1S)};
        run_gemm(lds, g, e, bid, nb, true, 4, 16);
#ifdef PROBE_NULLGEMM2
        { EpiNull en; run_gemm(lds, g, en, bid, nb, false); }
#endif
    } break;
#if FAST_RET
    case PH_RET: phase_ret_fast(c, lds, bid, nb); break;
#else
    case PH_RET: phase_ret_naive(c, lds, bid, nb); break;
#endif
    case PH_OUT1: {
        Gemm g{c.b16(OFF_V1), c.b16(OFF_WOUT1), MR, 1024, RMIX, RMIX, RMIX, 0};
        EpiResRho e{{c, c.b16(OFF_ZB), stB, c.f32(OFF_STATA), c.in[21], c.in[22], nullptr, nullptr}, c.out};
        run_gemm(lds, g, e, bid, nb, false);
    } break;
    case PH_UP1: {
        Gemm g{c.b16(OFF_ZB), c.b16(OFF_W1_1), MR, FF, 1024, 1024, 1024, 0};
        EpiMlpUp e{{stA, cv + C1_UP1, cv + C2_UP1}, c.b16(OFF_HID)};
        run_gemm(lds, g, e, bid, nb, false);
    } break;
    case PH_DOWN1: {
        Gemm g{c.b16(OFF_HID), c.b16(OFF_W2_1), MR, 1024, FF, FF, FF, 0};
        EpiFinal e{{c, c.b16(OFF_ZB), stA, nullptr, c.in[17] + 1024, c.in[18] + 1024, nullptr, nullptr}, (unsigned long long*)(c.ws + OFF_ZMETA), (unsigned*)(c.ws + OFF_CTL + 32768), c.in[21] + 1024, c.in[22] + 1024};
        run_gemm(lds, g, e, bid, nb, false);
    } break;
    default: break;
    }
}

#if N_LAUNCH_MODE == 1
__global__ void __launch_bounds__(512, 2) k_fwd(Params p) {
    extern __shared__ __attribute__((aligned(16))) unsigned char lds_raw[];
    LAS unsigned char* lds = (LAS unsigned char*)lds_raw;
    Ctx c{p.in, p.out, p.ws};
    const int bid = blockIdx.x, nb = gridDim.x;
    const int lo = (int)p.ph_lo, hi = (int)p.ph_hi;
    volatile LAS unsigned* misc = (volatile LAS unsigned*)(lds + LDS_MISC);
    if (threadIdx.x < 64) misc[threadIdx.x] = 0u;
    __syncthreads();
    const XcdBarrier bar = xcd_barrier_post((unsigned*)(p.ws + OFF_CTL) + 1024, misc);
#ifdef PROBE_PHASE
    unsigned long long pt0 = 0, pt1 = 0;
#define PROBE_T0(k) if ((k) == PROBE_PHASE) pt0 = __builtin_amdgcn_s_memrealtime();
#define PROBE_T1(k) if ((k) == PROBE_PHASE) pt1 = __builtin_amdgcn_s_memrealtime();
#else
#define PROBE_T0(k)
#define PROBE_T1(k)
#endif
#define PHASE(k) if (lo <= (k) && (k) < hi) { PROBE_T0(k) run_phase((k), c, p, lds, bid, nb); if ((k) + 1 < hi) { if (hi > 1000) cg::this_grid().sync(); else xcd_barrier(bar); } PROBE_T1(k) }
    PHASE(0) PHASE(1) PHASE(2) PHASE(3) PHASE(4) PHASE(5) PHASE(6) PHASE(7) PHASE(8) PHASE(9) PHASE(10) PHASE(11) PHASE(12)
#undef PHASE
#ifdef PROBE_PRO_SPLIT
    if (bid == 0 && threadIdx.x == 0) { volatile unsigned long long* pts = (volatile unsigned long long*)(p.ws + OFF_CTL + 32768); const unsigned long long te = __builtin_amdgcn_s_memrealtime(), w = 16ull * (pts[PROBE_PRO_SPLIT] - pts[PROBE_PRO_SPLIT - 1]); while (__builtin_amdgcn_s_memrealtime() - te < w) __builtin_amdgcn_s_sleep(32); }
#endif
#ifdef PROBE_PHASE
    if (bid == 0 && threadIdx.x == 0) { const unsigned long long te = __builtin_amdgcn_s_memrealtime(), w = 16ull * (pt1 - pt0); while (__builtin_amdgcn_s_memrealtime() - te < w) __builtin_amdgcn_s_sleep(32); }
#endif
}
#else
template <int PH> __global__ void __launch_bounds__(512, 2) k_one(Params p) {
    extern __shared__ __attribute__((aligned(16))) unsigned char lds_raw[];
    LAS unsigned char* lds = (LAS unsigned char*)lds_raw;
    Ctx c{p.in, p.out, p.ws};
    run_phase(PH, c, p, lds, blockIdx.x, gridDim.x);
}
template <int PH> static void launch_one(int grid, const Params& p, hipStream_t stream) {
    static bool attr = false;
    if (!attr) { (void)hipFuncSetAttribute((const void*)k_one<PH>, hipFuncAttributeMaxDynamicSharedMemorySize, LDS_BYTES); attr = true; }
    hipLaunchKernelGGL(k_one<PH>, dim3(grid), dim3(512), LDS_BYTES, stream, p);
}
#endif

extern "C" void kernel_launch(void* const* d_in, const int* in_sizes, int n_in, void* d_out, int out_size, void* d_ws, size_t ws_size, hipStream_t stream) {
    static int grid = 0;
    if (grid == 0) {
        int dev = 0, cus = 0;
        if (hipGetDevice(&dev) != hipSuccess || hipDeviceGetAttribute(&cus, hipDeviceAttributeMultiprocessorCount, dev) != hipSuccess) { grid = -1; return; }
#if N_LAUNCH_MODE == 1
        if (hipFuncSetAttribute((const void*)k_fwd, hipFuncAttributeMaxDynamicSharedMemorySize, LDS_BYTES) != hipSuccess) { grid = -1; return; }
        int per_cu = 0;
        if (hipOccupancyMaxActiveBlocksPerMultiprocessor(&per_cu, (const void*)k_fwd, 512, LDS_BYTES) != hipSuccess || per_cu < 1) { fprintf(stderr, "occupancy query: %d\n", per_cu); }
        (void)hipGetLastError();
#endif
        grid = 256;
        if (cus < 256) { fprintf(stderr, "kernel_launch: %d CUs < 256\n", cus); grid = -1; return; }
        if (n_in != 23 || ws_size < WS_END) { fprintf(stderr, "kernel_launch: unexpected n_in %d / ws %zu\n", n_in, ws_size); grid = -1; return; }
    }
    if (grid < 0) return;
    (void)hipMemsetAsync((char*)d_ws + OFF_CTL, 0, SZ_CTL, stream);
    (void)hipMemsetAsync((char*)d_ws + OFF_C12, 0, 128 * KB, stream);
    Params p{};
    for (int i = 0; i < 23; ++i) p.in[i] = (const float*)d_in[i];
    p.out = (float*)d_out; p.ws = (unsigned char*)d_ws;
    for (int j = 0; j < 16; ++j) p.inv0[j] = pow(10000.0, -(double)j / 16.0);
    for (int j = 0; j < 128; ++j) p.inv1[j] = pow(10000.0, -(double)j / 128.0);
#if N_LAUNCH_MODE == 1
    p.ph_lo = 0; p.ph_hi = NPH;
    void* args[] = {&p};
    hipError_t e = hipLaunchCooperativeKernel((const void*)k_fwd, dim3(grid), dim3(512), args, LDS_BYTES, stream);
    if (e != hipSuccess) fprintf(stderr, "cooperative launch failed: %s (grid %d)\n", hipGetErrorString(e), grid);
#else
    launch_one<0>(grid, p, stream); launch_one<1>(grid, p, stream); launch_one<2>(grid, p, stream); launch_one<3>(grid, p, stream); launch_one<4>(grid, p, stream);
    launch_one<5>(grid, p, stream); launch_one<6>(grid, p, stream); launch_one<7>(grid, p, stream); launch_one<8>(grid, p, stream); launch_one<9>(grid, p, stream);
    launch_one<10>(grid, p, stream); launch_one<11>(grid, p, stream); launch_one<12>(grid, p, stream);
#endif
}
```

```cpp
#include <hip/hip_runtime.h>
#include <hip/hip_cooperative_groups.h>
#include <stdint.h>
#include <stdio.h>
namespace cg = cooperative_groups;

#ifndef FAST_GEMM
#define FAST_GEMM 1
#endif
#ifndef FAST_ATTN
#define FAST_ATTN 1
#endif
#ifndef FAST_RET
#define FAST_RET 1
#endif
#ifndef N_LAUNCH_MODE
#define N_LAUNCH_MODE 1
#endif

#define LAS __attribute__((address_space(3)))
typedef unsigned short bf16_t;
typedef short bf16x8 __attribute__((ext_vector_type(8)));
typedef float f32x4 __attribute__((ext_vector_type(4)));
typedef float f32x2 __attribute__((ext_vector_type(2)));
typedef unsigned u32x4 __attribute__((ext_vector_type(4)));
typedef unsigned u32x2 __attribute__((ext_vector_type(2)));
typedef __bf16 bf16x2_t __attribute__((ext_vector_type(2)));

constexpr int DM = 1024, NBATCH = 16, SEQ = 2048, NMETA = 16, TT = SEQ + NMETA;
constexpr int MR = NBATCH * SEQ;
constexpr int MP = MR + 256;
constexpr int LRUW = 512, EVEN_IN = 1440, N_IN0 = 1536, QRANK = 256, KVRANK = 128;
constexpr int MLA_H = 8, QKD = 96, VD = 64, NQ = MLA_H * QKD  , NV = MLA_H * VD  ;
constexpr int FF = 4096, N_IN1 = 6144, RET_H = 4, RDK = 256, RDV = 512, RMIX = 2048;
constexpr float LN_EPS = 1e-5f;
constexpr float DN_ALPHA = 1.41421356237309515f;
constexpr float QSCALE = 0.10206207261596575f * 1.4426950408889634f;

constexpr size_t KB = 1024, MB = 1024 * 1024;
constexpr size_t OFF_CTL = 0;
constexpr size_t SZ_CTL = 64 * KB;
constexpr size_t OFF_ROPE0C = OFF_CTL + SZ_CTL;
constexpr size_t OFF_ROPE0S = OFF_ROPE0C + 132 * KB;
constexpr size_t OFF_ROPE1C = OFF_ROPE0S + 132 * KB;
constexpr size_t OFF_ROPE1S = OFF_ROPE1C + 1056 * KB;
constexpr size_t OFF_CCH = OFF_ROPE1S + 1056 * KB;
constexpr size_t OFF_C12 = OFF_CCH + 4 * KB;
constexpr size_t OFF_SSQQ = OFF_C12 + 128 * KB;
constexpr size_t OFF_SSQKV = OFF_SSQQ + 528 * KB;
constexpr size_t OFF_STATA = OFF_SSQKV + 528 * KB;
constexpr size_t OFF_STATB = OFF_STATA + (size_t)MP * 128;
constexpr size_t OFF_ZMETA = OFF_STATB + (size_t)MP * 128;
constexpr size_t OFF_ABMETA = OFF_ZMETA + MB;
constexpr size_t OFF_CARRY = OFF_ABMETA + MB;
constexpr size_t OFF_W = 18 * MB;
static_assert(OFF_CARRY + 2 * MB <= OFF_W, "small buffers");
constexpr size_t OFF_WIN1 = OFF_W;
constexpr size_t OFF_WOUT1 = OFF_WIN1 + (size_t)6144 * 1024 * 2;
constexpr size_t OFF_W1_1 = OFF_WOUT1 + (size_t)2048 * 1024 * 2;
constexpr size_t OFF_W2_1 = OFF_W1_1 + (size_t)4096 * 1024 * 2;
constexpr size_t OFF_BIG = 50 * MB;
static_assert(OFF_W2_1 + (size_t)4096 * 1024 * 2 <= OFF_BIG, "weights");
constexpr size_t SZ_ROW1K = (size_t)MP * 1024 * 2;
constexpr size_t OFF_XB = OFF_BIG;
constexpr size_t OFF_P0 = OFF_XB + SZ_ROW1K;
constexpr size_t OFF_Q = OFF_P0 + (size_t)MP * 1536 * 2;
constexpr size_t OFF_K = OFF_Q + (size_t)MP * 768 * 2;
constexpr size_t OFF_V = OFF_K + (size_t)MP * 768 * 2;
constexpr size_t OFF_XC = OFF_V + (size_t)MP * 512 * 2;
constexpr size_t OFF_MIX = OFF_XC;
constexpr size_t OFF_HID = OFF_BIG;
constexpr size_t OFF_Q1 = OFF_BIG;
constexpr size_t OFF_K1 = OFF_Q1 + SZ_ROW1K;
constexpr size_t OFF_V1 = OFF_K1 + SZ_ROW1K;
constexpr size_t OFF_G1 = OFF_V1 + 2 * SZ_ROW1K;
constexpr size_t OFF_W0 = 415 * MB;
constexpr size_t OFF_WIN0 = OFF_W0;
constexpr size_t OFF_WGATE = OFF_WIN0 + (size_t)N_IN0 * 1024 * 2;
constexpr size_t OFF_WUQ = OFF_WGATE + 1024 * 128 * 2;
constexpr size_t OFF_WUKV = OFF_WUQ + 768 * 256 * 2;
constexpr size_t OFF_WOUT0 = OFF_WUKV + 1024 * 128 * 2;
constexpr size_t OFF_W1_0 = OFF_WOUT0 + 1024 * 1024 * 2;
constexpr size_t OFF_W2_0 = OFF_W1_0 + (size_t)4096 * 1024 * 2;
constexpr size_t OFF_ZB = 438 * MB;
constexpr size_t WS_END = 504 * MB;
static_assert(OFF_MIX + SZ_ROW1K <= OFF_W0 && OFF_HID + (size_t)MP * 4096 * 2 <= OFF_W0 && OFF_G1 + 2 * SZ_ROW1K <= OFF_ZB && OFF_W2_0 + (size_t)4096 * 1024 * 2 <= OFF_ZB && OFF_ZB + SZ_ROW1K <= WS_END, "ws map");

struct Params { const float* in[23]; float* out; unsigned char* ws; long long ph_lo, ph_hi; double inv0[16]; double inv1[128]; };

__device__ __forceinline__ int opaque_tid() { int t = threadIdx.x; asm volatile("" : "+v"(t)); return t; }
__device__ __forceinline__ float bf2f(unsigned v) { return __uint_as_float(v << 16); }
__device__ __forceinline__ unsigned pk2(float lo, float hi) { f32x2 v = {lo, hi}; bf16x2_t b = __builtin_convertvector(v, bf16x2_t); return __builtin_bit_cast(unsigned, b); }
__device__ __forceinline__ u32x2 pk4(f32x4 v) { u32x2 r; r.x = pk2(v[0], v[1]); r.y = pk2(v[2], v[3]); return r; }
__device__ __forceinline__ f32x4 unpk4(u32x2 w) { return (f32x4){bf2f(w.x & 0xffffu), bf2f(w.x >> 16), bf2f(w.y & 0xffffu), bf2f(w.y >> 16)}; }
__device__ __forceinline__ float bfround(float x) { return bf2f(pk2(x, 0.f) & 0xffffu); }
__device__ __forceinline__ float wave_sum(float v) {
#pragma unroll
    for (int o = 1; o < 64; o <<= 1) v += __shfl_xor(v, o);
    return v;
}
__device__ __forceinline__ float wave_max(float v) {
#pragma unroll
    for (int o = 1; o < 64; o <<= 1) v = fmaxf(v, __shfl_xor(v, o));
    return v;
}
__device__ __forceinline__ float frcp(float x) { return __builtin_amdgcn_rcpf(x); }
__device__ __forceinline__ float frsq(float x) { return __builtin_amdgcn_rsqf(x); }
__device__ __forceinline__ float fsqrt(float x) { return __builtin_amdgcn_sqrtf(x); }
__device__ __forceinline__ float sigmoidf_(float x) { return frcp(1.f + __expf(-x)); }
__device__ __forceinline__ float gelu_tanh(float x) { const float u = 0.7978845608028654f * (x + 0.044715f * x * x * x); const float t = 1.f - 2.f * frcp(1.f + __expf(2.f * u)); return 0.5f * x * (1.f + t); }
__device__ __forceinline__ int row_pos(int row) { return row < MR ? NMETA + (row & (SEQ - 1)) : (row - MR); }

struct Ctx {
    const float* const* in; float* out; unsigned char* ws;
    __device__ __forceinline__ bf16_t* b16(size_t off) const { return (bf16_t*)(ws + off); }
    __device__ __forceinline__ float* f32(size_t off) const { return (float*)(ws + off); }
    __device__ __forceinline__ unsigned* abrow(int row) const { return row < MR ? (unsigned*)out + (size_t)row * LRUW : (unsigned*)f32(OFF_ABMETA) + (size_t)(row - MR) * LRUW; }
};

struct Gemm { const bf16_t* A; const bf16_t* Bt; int M, N, K, lda, ldb, a_pn_off; };

__device__ __forceinline__ void row_stats(const float* st, int row, int fq, float& mean, float& rstd) {
    const f32x4* p = (const f32x4*)(st + (size_t)row * 32 + fq * 8);
    const f32x4 a = p[0], b = p[1];
    float s1 = a[0] + a[2] + b[0] + b[2], s2 = a[1] + a[3] + b[1] + b[3];
    s1 += __shfl_xor(s1, 16); s2 += __shfl_xor(s2, 16); s1 += __shfl_xor(s1, 32); s2 += __shfl_xor(s2, 32);
    mean = s1 * (1.f / DM); const float var = fmaxf(s2 * (1.f / DM) - mean * mean, 0.f); rstd = frsq(var + LN_EPS);
}
__device__ __forceinline__ void put_stats(float* st, int row, int pn, int q0, const f32x4 (&v)[2][2]) {
    float s1 = 0.f, s2 = 0.f;
#pragma unroll
    for (int bj = 0; bj < 2; ++bj)
#pragma unroll
        for (int n = 0; n < 2; ++n)
#pragma unroll
            for (int e = 0; e < 4; ++e) { s1 += v[bj][n][e]; s2 += v[bj][n][e] * v[bj][n][e]; }
    s1 += __shfl_xor(s1, 16); s2 += __shfl_xor(s2, 16); s1 += __shfl_xor(s1, 32); s2 += __shfl_xor(s2, 32);
    if (((q0 >> 2) & 7) == 0) *(f32x2*)(st + (size_t)row * 32 + (pn * 4 + (q0 >> 5)) * 2) = (f32x2){s1, s2};
}

constexpr int ROT_OFF = 131072 + 12 * 2048;
struct RowS { float a, b; };
struct NoCol {}; struct NoRow {};
__device__ __forceinline__ u32x4 pk8(f32x4 a, f32x4 b) { u32x4 r; r.x = pk2(a[0], a[1]); r.y = pk2(a[2], a[3]); r.z = pk2(b[0], b[1]); r.w = pk2(b[2], b[3]); return r; }
__device__ __forceinline__ void unpk8(u32x4 w, f32x4& a, f32x4& b) { a = (f32x4){bf2f(w.x & 0xffffu), bf2f(w.x >> 16), bf2f(w.y & 0xffffu), bf2f(w.y >> 16)}; b = (f32x4){bf2f(w.z & 0xffffu), bf2f(w.z >> 16), bf2f(w.w & 0xffffu), bf2f(w.w >> 16)}; }
__device__ __forceinline__ void put_stats8(float* st, int row, int pn, int wc, int fq, const f32x4 (&v)[2][2]) {
    float s1 = 0.f, s2 = 0.f;
#pragma unroll
    for (int bj = 0; bj < 2; ++bj)
#pragma unroll
        for (int n = 0; n < 2; ++n)
#pragma unroll
            for (int e = 0; e < 4; ++e) { s1 += v[bj][n][e]; s2 += v[bj][n][e] * v[bj][n][e]; }
    s1 += __shfl_xor(s1, 16); s2 += __shfl_xor(s2, 16); s1 += __shfl_xor(s1, 32); s2 += __shfl_xor(s2, 32);
    if (fq == 0) *(f32x2*)(st + (size_t)row * 32 + (pn * 4 + wc) * 2) = (f32x2){s1, s2};
}

struct EpiIn0 {
    static constexpr bool HAS_INIT = false, PERM = true, ROW_AHEAD = true, USE_TAB = false;
    typedef NoCol ColS; typedef NoRow RowL;
    bf16_t* p0; float* ssq_q; float* ssq_kv;
    __device__ __forceinline__ ColS cols(int, int, int) const { return ColS{}; }
    __device__ __forceinline__ RowS pre(int, int) const { return RowS{0.f, 0.f}; }
    __device__ __forceinline__ RowL rload(int, int, int, int) const { return RowL{}; }
    __device__ __forceinline__ void apply(int row, int pn, int wc, int fq, f32x4 (&v)[2][2], RowS, const ColS&, const RowL&) const {
        bf16_t* base = p0 + (size_t)row * N_IN0 + 256 * pn + 32 * wc + 8 * fq;
#pragma unroll
        for (int bj = 0; bj < 2; ++bj) *(u32x4*)(base + 128 * bj) = pk8(v[bj][0], v[bj][1]);
        if (pn == 4 || pn == 5) {
            float s = 0.f;
#pragma unroll
            for (int n = 0; n < 2; ++n)
#pragma unroll
                for (int e = 0; e < 4; ++e) { s += v[0][n][e] * v[0][n][e]; if (pn == 4) s += v[1][n][e] * v[1][n][e]; }
            s += __shfl_xor(s, 16); s += __shfl_xor(s, 32);
            if (fq == 0) (pn == 4 ? ssq_q : ssq_kv)[(size_t)row * 4 + wc] = s;
        }
    }
};
struct EpiQup {
    static constexpr bool HAS_INIT = false, PERM = false, ROW_AHEAD = true, USE_TAB = false;
    typedef NoCol ColS; struct RowL { f32x4 c, s; };
    bf16_t* Q; const float* ssq_q; const float* rc; const float* rs;
    __device__ __forceinline__ ColS cols(int, int, int) const { return ColS{}; }
    __device__ __forceinline__ RowS pre(int row, int) const { const f32x4 sq = *(const f32x4*)(ssq_q + (size_t)row * 4); return RowS{frsq((sq[0] + sq[1] + sq[2] + sq[3]) * (1.f / QRANK) + LN_EPS) * QSCALE, 0.f}; }
    __device__ __forceinline__ RowL rload(int row, int, int, int fq) const { const int pos = row_pos(row); return RowL{*(const f32x4*)(rc + pos * 16 + 4 * fq), *(const f32x4*)(rs + pos * 16 + 4 * fq)}; }
    __device__ __forceinline__ void apply(int row, int pn, int wc, int fq, f32x4 (&v)[2][2], RowS rsv, const ColS&, const RowL& rl) const {
        const float r = rsv.a;
#pragma unroll
        for (int bj = 0; bj < 2; ++bj) {
            f32x4 x1 = v[bj][0] * r, x2 = v[bj][1] * r;
            const int G = 8 * pn + 4 * bj + wc;
            if ((G % 3) == 2) { const f32x4 y1 = x1 * rl.c - x2 * rl.s, y2 = x1 * rl.s + x2 * rl.c; x1 = y1; x2 = y2; }
            bf16_t* base = Q + (size_t)row * NQ + 256 * pn + 128 * bj + 32 * wc + 4 * fq;
            *(u32x2*)(base) = pk4(x1); *(u32x2*)(base + 16) = pk4(x2);
        }
    }
};
struct EpiKVup {
    static constexpr bool HAS_INIT = false, PERM = true, ROW_AHEAD = true, USE_TAB = false;
    typedef NoCol ColS; typedef NoRow RowL;
    bf16_t* K; bf16_t* V; const float* ssq_kv;
    __device__ __forceinline__ ColS cols(int, int, int) const { return ColS{}; }
    __device__ __forceinline__ RowS pre(int row, int) const { const f32x4 sq = *(const f32x4*)(ssq_kv + (size_t)row * 4); return RowS{frsq((sq[0] + sq[1] + sq[2] + sq[3]) * (1.f / KVRANK) + LN_EPS), 0.f}; }
    __device__ __forceinline__ RowL rload(int, int, int, int) const { return RowL{}; }
    __device__ __forceinline__ void apply(int row, int pn, int wc, int fq, f32x4 (&v)[2][2], RowS rsv, const ColS&, const RowL&) const {
        const float r = rsv.a; const int within = 32 * wc + 8 * fq;
#pragma unroll
        for (int bj = 0; bj < 2; ++bj) {
            const int head = 2 * pn + bj;
            bf16_t* dst = (wc < 2) ? K + (size_t)row * NQ + head * QKD + within : V + (size_t)row * NV + head * VD + (within - 64);
            *(u32x4*)dst = pk8(v[bj][0] * r, v[bj][1] * r);
        }
    }
};
struct EpiGate {
    static constexpr bool HAS_INIT = false, PERM = true, ROW_AHEAD = true, USE_TAB = false;
    struct ColS { f32x4 cc[2], va[2], vx[2]; }; struct RowL { u32x4 x; };
    Ctx c; const bf16_t* xc; const float* cch; const float* ba; const float* bx;
    __device__ __forceinline__ ColS cols(int pn, int wc, int fq) const { ColS k;
#pragma unroll
        for (int n = 0; n < 2; ++n) { const int ch = 128 * pn + 32 * wc + 8 * fq + 4 * n; k.cc[n] = *(const f32x4*)(cch + ch); k.va[n] = *(const f32x4*)(ba + ch); k.vx[n] = *(const f32x4*)(bx + ch); }
        return k; }
    __device__ __forceinline__ RowS pre(int, int) const { return RowS{0.f, 0.f}; }
    __device__ __forceinline__ RowL rload(int row, int pn, int wc, int fq) const { return RowL{*(const u32x4*)(xc + (size_t)row * LRUW + 128 * pn + 32 * wc + 8 * fq)}; }
    __device__ __forceinline__ void apply(int row, int pn, int wc, int fq, f32x4 (&v)[2][2], RowS, const ColS& k, const RowL& l) const {
        unsigned* abr = c.abrow(row);
        f32x4 xv[2]; unpk8(l.x, xv[0], xv[1]);
#pragma unroll
        for (int n = 0; n < 2; ++n) {
            const int ch = 128 * pn + 32 * wc + 8 * fq + 4 * n;
            u32x4 o;
#pragma unroll
            for (int e = 0; e < 4; ++e) {
                const float r = sigmoidf_(v[0][n][e] + k.va[n][e]), ig = sigmoidf_(v[1][n][e] + k.vx[n][e]);
                const float la = k.cc[n][e] * r;
                const float ds = -la * (1.f + la * (0.5f + la * (1.f / 6 + la * (1.f / 24 + la * (1.f / 120)))));
                const float d = la > -0.25f ? ds : 1.f - __expf(la);
                o[e] = pk2(d, fsqrt(fmaxf(d * (2.f - d), 0.f)) * (ig * xv[n][e]));
            }
            *(u32x4*)(abr + ch) = o;
        }
    }
};
template <int MODE, bool LAST> struct EpiRes {
    static constexpr bool HAS_INIT = true, PERM = true, ROW_AHEAD = true, USE_TAB = (MODE == 1);
    typedef NoCol ColS; typedef NoRow RowL; struct ColI { f32x4 g[2][2], b[2][2]; };
    Ctx c; bf16_t* zb; const float* st_in; float* st_out; const float* g; const float* b; const float* x; const float* meta;
    __device__ __forceinline__ ColI colsi(int pn, int wc, int fq) const { ColI k;
#pragma unroll
        for (int bj = 0; bj < 2; ++bj)
#pragma unroll
            for (int n = 0; n < 2; ++n) { const int col = 256 * pn + 128 * bj + 32 * wc + 8 * fq + 4 * n;
                if (MODE == 1) { k.g[bj][n] = *(const f32x4*)(g + col); k.b[bj][n] = *(const f32x4*)(b + col); } else { k.g[bj][n] = (f32x4){0.f, 0.f, 0.f, 0.f}; k.b[bj][n] = k.g[bj][n]; } }
        return k; }
    __device__ __forceinline__ RowS prei(int row, int fq) const { RowS r{0.f, 0.f}; if (MODE == 1) row_stats(st_in, row, fq, r.a, r.b); return r; }
    __device__ __forceinline__ void init_row(int row, int pn, int wc, int fq, f32x4 (&v)[2][2], RowS rsv, const ColI& k) const {
        const int cb = 256 * pn + 32 * wc + 8 * fq;
        if (MODE == 1) {
#pragma unroll
            for (int bj = 0; bj < 2; ++bj) { f32x4 z0, z1; unpk8(*(const u32x4*)(zb + (size_t)row * DM + cb + 128 * bj), z0, z1);
                v[bj][0] = ((z0 - rsv.a) * rsv.b * k.g[bj][0] + k.b[bj][0]) * DN_ALPHA; v[bj][1] = ((z1 - rsv.a) * rsv.b * k.g[bj][1] + k.b[bj][1]) * DN_ALPHA; }
        } else {
            const bf16_t* src = (const bf16_t*)x + (size_t)row * DM + cb;
#pragma unroll
            for (int bj = 0; bj < 2; ++bj) { f32x4 z0, z1; unpk8(*(const u32x4*)(src + 128 * bj), z0, z1); v[bj][0] = z0 * DN_ALPHA; v[bj][1] = z1 * DN_ALPHA; }
        }
    }
    __device__ __forceinline__ ColS cols(int, int, int) const { return ColS{}; }
    __device__ __forceinline__ RowS pre(int, int) const { return RowS{0.f, 0.f}; }
    __device__ __forceinline__ RowL rload(int, int, int, int) const { return RowL{}; }
    __device__ __forceinline__ void apply(int row, int pn, int wc, int fq, f32x4 (&v)[2][2], RowS, const ColS&, const RowL&) const {
        const int cb = 256 * pn + 32 * wc + 8 * fq;
#pragma unroll
        for (int bj = 0; bj < 2; ++bj) {
            if (LAST) { float* zr = c.out + (size_t)row * DM + cb + 128 * bj; *(f32x4*)zr = v[bj][0]; *(f32x4*)(zr + 4) = v[bj][1]; }
            else *(u32x4*)(zb + (size_t)row * DM + cb + 128 * bj) = pk8(v[bj][0], v[bj][1]);
        }
        if (!LAST) put_stats8(st_out, row, pn, wc, fq, v);
    }
};
struct EpiResRho : EpiRes<1, false> { static constexpr bool KHOOK = true; const float* osq; };
struct EpiFinal : EpiRes<1, true> { static constexpr bool FUSED_LN = true; unsigned long long* xbuf; unsigned* cnt; const float* gF; const float* bF; };
struct EpiNull {
    static constexpr bool HAS_INIT = false, PERM = true, ROW_AHEAD = true, USE_TAB = false;
    typedef NoCol ColS; typedef NoRow RowL;
    __device__ __forceinline__ ColS cols(int, int, int) const { return ColS{}; }
    __device__ __forceinline__ RowS pre(int, int) const { return RowS{0.f, 0.f}; }
    __device__ __forceinline__ RowL rload(int, int, int, int) const { return RowL{}; }
    __device__ __forceinline__ void apply(int, int, int, int, f32x4 (&v)[2][2], RowS, const ColS&, const RowL&) const { asm volatile("" :: "v"(v[0][0]), "v"(v[0][1]), "v"(v[1][0]), "v"(v[1][1])); }
};
struct LnFoldInit {
    struct ColI { f32x4 c1[2][2], c2[2][2]; };
    const float* st_in; const float* c1; const float* c2;
    __device__ __forceinline__ ColI colsi(int pn, int wc, int fq) const { ColI k;
#pragma unroll
        for (int bj = 0; bj < 2; ++bj)
#pragma unroll
            for (int n = 0; n < 2; ++n) { const int col = 256 * pn + 128 * bj + 32 * wc + 8 * fq + 4 * n; k.c1[bj][n] = *(const f32x4*)(c1 + col); k.c2[bj][n] = *(const f32x4*)(c2 + col); }
        return k; }
    __device__ __forceinline__ RowS prei(int row, int fq) const { RowS r; row_stats(st_in, row, fq, r.a, r.b); return r; }
    __device__ __forceinline__ void init_row(int, int, int, int, f32x4 (&v)[2][2], RowS rs0, const ColI& k) const {
        const RowS rsv{rs0.a, frcp(rs0.b)};
#pragma unroll
        for (int bj = 0; bj < 2; ++bj)
#pragma unroll
            for (int n = 0; n < 2; ++n) v[bj][n] = k.c2[bj][n] * rsv.b - k.c1[bj][n] * rsv.a;
    }
    __device__ __forceinline__ RowS pre(int row, int fq) const { RowS r; row_stats(st_in, row, fq, r.a, r.b); return r; }
};
struct EpiMlpUp : LnFoldInit {
    static constexpr bool HAS_INIT = true, PERM = true, ROW_AHEAD = true, USE_TAB = true;
    typedef NoCol ColS; typedef NoRow RowL;
    bf16_t* hid;
    __device__ __forceinline__ ColS cols(int, int, int) const { return ColS{}; }
    __device__ __forceinline__ RowL rload(int, int, int, int) const { return RowL{}; }
    __device__ __forceinline__ void apply(int row, int pn, int wc, int fq, f32x4 (&v)[2][2], RowS rsv, const ColS&, const RowL&) const {
#pragma unroll
        for (int bj = 0; bj < 2; ++bj) {
            f32x4 u[2];
#pragma unroll
            for (int n = 0; n < 2; ++n) { u[n] = v[bj][n] * rsv.b;
#pragma unroll
                for (int e = 0; e < 4; ++e) { const float r = fmaxf(u[n][e], 0.f); u[n][e] = r * r; } }
            *(u32x4*)(hid + (size_t)row * FF + 256 * pn + 128 * bj + 32 * wc + 8 * fq) = pk8(u[0], u[1]);
        }
    }
};
struct EpiIn1 : LnFoldInit {
    static constexpr bool HAS_INIT = true, PERM = true, ROW_AHEAD = false, USE_TAB = true;
    typedef NoCol ColS; struct RowL { f32x4 cs[2], sn[2]; };
    bf16_t* q1; bf16_t* k1; bf16_t* v1; bf16_t* g1; const float* rc; const float* rs;
    __device__ __forceinline__ ColS cols(int, int, int) const { return ColS{}; }
    static constexpr bool ROT = true;
    __device__ __forceinline__ RowL rload(int row, int pn, int wc, int fq) const { RowL l;
        if (pn < 8) { const int pos = row_pos(row);
#pragma unroll
            for (int n = 0; n < 2; ++n) { l.cs[n] = *(const f32x4*)(rc + pos * 128 + 32 * wc + 8 * fq + 4 * n); l.sn[n] = *(const f32x4*)(rs + pos * 128 + 32 * wc + 8 * fq + 4 * n); } }
        else { l.cs[0] = l.cs[1] = l.sn[0] = l.sn[1] = (f32x4){0.f, 0.f, 0.f, 0.f}; }
        return l; }
    __device__ __forceinline__ void rot_build(LAS unsigned char* lds, int tid) const {
        if (tid < 128) { LAS float* t = (LAS float*)(lds + ROT_OFF); t[tid] = rc[16 * 128 + tid]; t[128 + tid] = rs[16 * 128 + tid]; t[256 + tid] = rc[80 * 128 + tid]; t[384 + tid] = rs[80 * 128 + tid]; }
    }
    __device__ __forceinline__ void rot_step(RowL& l, int which, LAS unsigned char* lds, int wc, int fq) const {
        const LAS float* t = (const LAS float*)(lds + ROT_OFF) + which * 256 + 32 * wc + 8 * fq;
#pragma unroll
        for (int n = 0; n < 2; ++n) { const f32x4 c = *(const LAS f32x4*)(t + 4 * n), sn_ = *(const LAS f32x4*)(t + 128 + 4 * n);
            const f32x4 nc = l.cs[n] * c - l.sn[n] * sn_, ns = l.sn[n] * c + l.cs[n] * sn_; l.cs[n] = nc; l.sn[n] = ns; }
    }
    __device__ __forceinline__ void apply(int row, int pn, int wc, int fq, f32x4 (&v)[2][2], RowS rsv, const ColS&, const RowL& l) const {
        const int q0 = 32 * wc + 8 * fq;
        if (pn < 8) {
            const float sc = rsv.b * (pn < 4 ? 1.f : 0.0625f);
            bf16_t* dst = (pn < 4 ? q1 : k1) + (size_t)row * 1024 + 256 * (pn & 3) + q0;
            f32x4 y1[2], y2[2];
#pragma unroll
            for (int n = 0; n < 2; ++n) { const f32x4 cs = l.cs[n] * sc, sn = l.sn[n] * sc; y1[n] = v[0][n] * cs - v[1][n] * sn; y2[n] = v[0][n] * sn + v[1][n] * cs; }
            *(u32x4*)dst = pk8(y1[0], y1[1]); *(u32x4*)(dst + 128) = pk8(y2[0], y2[1]);
        } else {
            const bool isg = pn >= 16;
            bf16_t* dst = (isg ? g1 : v1) + (size_t)row * RMIX + 256 * (isg ? pn - 16 : pn - 8) + q0;
#pragma unroll
            for (int bj = 0; bj < 2; ++bj) {
                f32x4 u[2];
#pragma unroll
                for (int n = 0; n < 2; ++n) { u[n] = v[bj][n] * rsv.b;
                    if (isg) {
#pragma unroll
                        for (int e = 0; e < 4; ++e) u[n][e] = u[n][e] * sigmoidf_(u[n][e]);
                    } }
                *(u32x4*)(dst + 128 * bj) = pk8(u[0], u[1]);
            }
        }
    }
};

__host__ __device__ __forceinline__ int perm32(int rho) { const int n = rho >> 4, i = rho & 15; return 8 * (i >> 2) + 4 * n + (i & 3); }
template <class Epi>
__device__ __forceinline__ void gemm_naive(const Gemm g, const Epi& E, int bid, int nb) {
    const int tid = opaque_tid(), wid = tid >> 6, lane = tid & 63, fr = lane & 15, fq = lane >> 4;
    const int nN = g.N / 256, units = (g.M / 256) * nN;
    for (long item = (long)bid * 8 + wid; item < (long)units * 64; item += (long)nb * 8) {
        const int unit = (int)(item >> 6), sub = (int)(item & 63), pm = unit / nN, pn = unit % nN, mg = sub >> 2, wc = sub & 3;
        const int row0 = 256 * pm + 16 * mg;
        const bf16_t* ap = g.A + (size_t)pn * g.a_pn_off + (size_t)(row0 + fr) * g.lda + 8 * fq;
        const bf16_t* bp = g.Bt + (size_t)(256 * pn + 32 * wc) * g.ldb + 8 * fq;
        f32x4 acc[2][2];
#pragma unroll
        for (int bj = 0; bj < 2; ++bj)
#pragma unroll
            for (int n = 0; n < 2; ++n) acc[bj][n] = (f32x4){0.f, 0.f, 0.f, 0.f};
        if constexpr (Epi::HAS_INIT) E.init_row(row0 + fr, pn, wc, fq, acc, E.prei(row0 + fr, fq), E.colsi(pn, wc, fq));
        for (int k0 = 0; k0 < g.K; k0 += 32) {
            const bf16x8 a = *(const bf16x8*)(ap + k0);
#pragma unroll
            for (int bj = 0; bj < 2; ++bj)
#pragma unroll
                for (int n = 0; n < 2; ++n) {
                    const int brow = Epi::PERM ? perm32(16 * n + fr) : 16 * n + fr;
                    const bf16x8 b = *(const bf16x8*)(bp + (size_t)(128 * bj + brow) * g.ldb + k0);
                    acc[bj][n] = __builtin_amdgcn_mfma_f32_16x16x32_bf16(b, a, acc[bj][n], 0, 0, 0);
                }
        }
        E.apply(row0 + fr, pn, wc, fq, acc, E.pre(row0 + fr, fq), E.cols(pn, wc, fq), E.rload(row0 + fr, pn, wc, fq));
    }
}

namespace pg8 {
constexpr int BM = 256, BK = 64, HALF = 128, HTB = HALF * BK * 2  , STAGE_BYTES = 8 * HTB, NXCD = 8, WGM = 8;
__host__ __device__ __forceinline__ int lds_byte(int r, int c) { const int st = (r >> 4) * 2 + (c >> 5), rr = r & 15, cc = c & 31, ob = rr * 64 + cc * 2; return st * 1024 + (ob ^ (((ob >> 9) & 1) << 5)); }
__host__ __device__ __forceinline__ void stage_rc(int b, int& R, int& C) { const int st = b / 1024, sb = b % 1024, swz = sb ^ (((sb >> 9) & 1) << 5); R = (st >> 1) * 16 + swz / 64; C = (st & 1) * 32 + (swz % 64) / 2; }
struct Unit { int pm, pn; };
struct StaticOrder {
    int nM, nN, nwg, G, c;
    __host__ __device__ void init(int M, int N, int G_, int c_) { nM = M / BM; nN = N / BM; nwg = nM * nN; G = G_; c = c_; }
    __host__ __device__ bool next(int i, Unit& u) const {
        const long L = (long)i * G + c; if (L >= nwg) return false;
        int wgid = (int)L; { const int q = nwg / NXCD, r = nwg % NXCD, xcd = wgid % NXCD, off = wgid / NXCD; wgid = (xcd < r ? xcd * (q + 1) : r * (q + 1) + (xcd - r) * q) + off; }
        const int nig = WGM * nN, gid = wgid / nig, fm = gid * WGM, gsz = (nM - fm) < WGM ? (nM - fm) : WGM;
        u.pm = fm + ((wgid % nig) % gsz); u.pn = (wgid % nig) / gsz; return true;
    }
};
constexpr int TAB_OFF = 131072, TAB_UNITS = 15;
template <class T, class = void> struct HasFused { static constexpr bool value = false; };
template <class T> struct HasFused<T, decltype((void)T::FUSED_LN)> { static constexpr bool value = T::FUSED_LN; };
constexpr int FIN_OFF = 131072 + 2 * 2048;
template <class T, class = void> struct HasRot { static constexpr bool value = false; };
template <class T> struct HasRot<T, decltype((void)T::ROT)> { static constexpr bool value = T::ROT; };
template <class T, class = void> struct HasKhook { static constexpr bool value = false; };
template <class T> struct HasKhook<T, decltype((void)T::KHOOK)> { static constexpr bool value = T::KHOOK; };
constexpr int RHO_OFF = TAB_OFF + 2 * 2048;
template <class E> struct PgEpi {
    static constexpr bool PERM = E::PERM, KHOOK = HasKhook<E>::value;
    E e;
#define PG_ROW(i) (rbase + ((i) >> 2) * HALF + ((i) & 3) * 16)
#define PG_TROW(i) (wr * 64 + fr + ((i) >> 2) * HALF + ((i) & 3) * 16)
    template <class Sched> __device__ __forceinline__ void build_tab(LAS unsigned char* lds, const Sched& S, int tid) const {
        if constexpr (E::USE_TAB) {
            LAS f32x2* tab = (LAS f32x2*)(lds + TAB_OFF);
            const int r = tid >> 1, hf = tid & 1; Unit u;
            for (int i = 0; i < TAB_UNITS && S.next(i, u); ++i) {
                const f32x4* p = (const f32x4*)(e.st_in + (size_t)(u.pm * BM + r) * 32 + hf * 16);
                const f32x4 a0 = p[0], a1 = p[1], a2 = p[2], a3 = p[3];
                float s1 = (a0[0] + a0[2]) + (a1[0] + a1[2]) + (a2[0] + a2[2]) + (a3[0] + a3[2]), s2 = (a0[1] + a0[3]) + (a1[1] + a1[3]) + (a2[1] + a2[3]) + (a3[1] + a3[3]);
                s1 += __shfl_xor(s1, 1); s2 += __shfl_xor(s2, 1);
                const float mean = s1 * (1.f / DM), var = fmaxf(s2 * (1.f / DM) - mean * mean, 0.f);
                if (hf == 0) tab[i * 256 + r] = (f32x2){mean, frsq(var + LN_EPS)};
            }
            if constexpr (HasRot<E>::value) e.rot_build(lds, tid);
            if constexpr (KHOOK) {
                LAS f32x4* rho = (LAS f32x4*)(lds + RHO_OFF);
                for (int i = 0; i < 2 && S.next(i, u); ++i) {
                    const f32x4* p = (const f32x4*)(e.osq + (size_t)(u.pm * BM + r) * 64 + hf * 32);
                    float sa = 0.f, sb = 0.f;
#pragma unroll
                    for (int k = 0; k < 4; ++k) { const f32x4 a = p[k], b = p[4 + k]; sa += (a[0] + a[1]) + (a[2] + a[3]); sb += (b[0] + b[1]) + (b[2] + b[3]); }
                    const float ra = frsq(sa * (1.f / RDV) + LN_EPS), rb = frsq(sb * (1.f / RDV) + LN_EPS);
                    const float oa = __shfl_xor(ra, 1), ob = __shfl_xor(rb, 1);
                    if (hf == 0) rho[i * 256 + r] = (f32x4){frcp(ra), ra * frcp(rb), rb * frcp(oa), oa * frcp(ob)};
                }
            }
            asm volatile("s_waitcnt lgkmcnt(0)" ::: "memory"); __syncthreads();
        }
    }
    __device__ __forceinline__ void khook(f32x4 (&acc)[2][2][4][2], int ui, int col, LAS unsigned char* lds, int wr, int fr) const {
        if constexpr (KHOOK) {
#pragma unroll
            for (int i = 0; i < 8; ++i) {
                const float sc = ((const LAS float*)(lds + RHO_OFF))[(ui * 256 + PG_TROW(i)) * 4 + col];
                const int ai = i >> 2, m = i & 3;
                acc[ai][0][m][0] *= sc; acc[ai][0][m][1] *= sc; acc[ai][1][m][0] *= sc; acc[ai][1][m][1] *= sc;
            }
        }
    }
    __device__ __forceinline__ void fused_ln(const f32x4 (&acc)[2][2][4][2], const Unit& u, LAS unsigned char* lds, int wr, int wc, int fr, int fq) const {
        if constexpr (HasFused<E>::value) {
            typedef float f2 __attribute__((ext_vector_type(2)));
            LAS f2* P = (LAS f2*)(lds + FIN_OFF); LAS f2* Sx = (LAS f2*)(lds + FIN_OFF + 8192); volatile LAS unsigned* flag = (volatile LAS unsigned*)(lds + FIN_OFF + 10240);
            const int tid = threadIdx.x, lane = tid & 63, wid = tid >> 6;
#pragma unroll
            for (int i = 0; i < 8; ++i) {
                const int ai = i >> 2, m = i & 3; float s1 = 0.f, s2 = 0.f;
#pragma unroll
                for (int bj = 0; bj < 2; ++bj)
#pragma unroll
                    for (int n = 0; n < 2; ++n)
#pragma unroll
                        for (int q = 0; q < 4; ++q) { const float x = acc[ai][bj][m][n][q]; s1 += x; s2 += x * x; }
                s1 += __shfl_xor(s1, 16); s2 += __shfl_xor(s2, 16); s1 += __shfl_xor(s1, 32); s2 += __shfl_xor(s2, 32);
                if (fq == 0) P[(wr * 64 + fr + ai * HALF + m * 16) * 4 + wc] = (f2){s1, s2};
            }
            asm volatile("s_waitcnt lgkmcnt(0)" ::: "memory"); __builtin_amdgcn_s_barrier(); asm volatile("" ::: "memory");
            if (tid < 256) {
                const f2 a = P[tid * 4], b = P[tid * 4 + 1], c2 = P[tid * 4 + 2], d = P[tid * 4 + 3];
                const float s1 = (a.x + b.x) + (c2.x + d.x), s2 = (a.y + b.y) + (c2.y + d.y);
                __hip_atomic_store(e.xbuf + ((size_t)(u.pm * BM + tid) * 4 + u.pn), ((unsigned long long)__float_as_uint(s2) << 32) | __float_as_uint(s1), __ATOMIC_RELAXED, __HIP_MEMORY_SCOPE_AGENT);
                asm volatile("s_waitcnt vmcnt(0)" ::: "memory");
                if (lane == 0) __hip_atomic_fetch_add(e.cnt + 64 * u.pm, 1u, __ATOMIC_RELAXED, __HIP_MEMORY_SCOPE_AGENT);
            }
            if (wid == 0) {
                unsigned sp = 0;
                while ((unsigned)__builtin_amdgcn_readfirstlane(__hip_atomic_load(e.cnt + 64 * u.pm, __ATOMIC_RELAXED, __HIP_MEMORY_SCOPE_AGENT)) < 16u) { __builtin_amdgcn_s_sleep(2); if (++sp > (1u << 22)) break; }
                __builtin_amdgcn_fence(__ATOMIC_ACQUIRE, "agent");
                if (lane == 0) flag[0] = 1u;
            }
            asm volatile("s_waitcnt vmcnt(0) lgkmcnt(0)" ::: "memory"); __builtin_amdgcn_s_barrier(); asm volatile("" ::: "memory");
            if (tid < 256) {
                float s1 = 0.f, s2 = 0.f;
#pragma unroll
                for (int t = 0; t < 4; ++t) { const unsigned long long w = __hip_atomic_load(e.xbuf + ((size_t)(u.pm * BM + tid) * 4 + t), __ATOMIC_RELAXED, __HIP_MEMORY_SCOPE_AGENT); s1 += __uint_as_float((unsigned)w); s2 += __uint_as_float((unsigned)(w >> 32)); }
                const float mean = s1 * (1.f / DM), var = fmaxf(s2 * (1.f / DM) - mean * mean, 0.f);
                Sx[tid] = (f2){mean, frsq(var + LN_EPS)};
            }
            asm volatile("s_waitcnt vmcnt(0) lgkmcnt(0)" ::: "memory"); __builtin_amdgcn_s_barrier(); asm volatile("" ::: "memory");
            f32x4 gv[2][2], bv[2][2];
#pragma unroll
            for (int bj = 0; bj < 2; ++bj)
#pragma unroll
                for (int n = 0; n < 2; ++n) { const int col = 256 * u.pn + 128 * bj + 32 * wc + 8 * fq + 4 * n; gv[bj][n] = *(const f32x4*)(e.gF + col); bv[bj][n] = *(const f32x4*)(e.bF + col); }
#pragma unroll
            for (int i = 0; i < 8; ++i) {
                const int ai = i >> 2, m = i & 3, rt = wr * 64 + fr + ai * HALF + m * 16; const f2 ms = Sx[rt];
                float* orow = e.c.out + (size_t)(u.pm * BM + rt) * DM + 256 * u.pn + 32 * wc + 8 * fq;
#pragma unroll
                for (int bj = 0; bj < 2; ++bj)
#pragma unroll
                    for (int n = 0; n < 2; ++n) *(f32x4*)(orow + 128 * bj + 4 * n) = (acc[ai][bj][m][n] - ms.x) * ms.y * gv[bj][n] + bv[bj][n];
            }
            asm volatile("s_waitcnt lgkmcnt(0)" ::: "memory"); __builtin_amdgcn_s_barrier(); asm volatile("" ::: "memory");
        }
    }
    __device__ __forceinline__ void operator()(const f32x4 (&acc)[2][2][4][2], const Unit& u, int ui, LAS unsigned char* lds, int wr, int wc, int fr, int fq) const {
        if constexpr (HasFused<E>::value) { fused_ln(acc, u, lds, wr, wc, fr, fq); return; }
        const int rbase = u.pm * BM + wr * 64 + fr;
        const typename E::ColS cs = e.cols(u.pn, wc, fq);
        RowS rs[8];
#pragma unroll
        for (int i = 0; i < 8; ++i) {
            if constexpr (E::USE_TAB) { const f32x2 t = ((const LAS f32x2*)(lds + TAB_OFF))[ui * 256 + PG_TROW(i)]; rs[i] = RowS{t.x, t.y}; }
            else rs[i] = e.pre(PG_ROW(i), fq);
        }
        typename E::RowL nxt = e.rload(PG_ROW(0), u.pn, wc, fq);
#pragma unroll
        for (int i = 0; i < 8; ++i) {
            const int ai = i >> 2, m = i & 3;
            typename E::RowL cur;
            if constexpr (HasRot<E>::value) { cur = nxt; if (i + 1 < 8 && u.pn < 8) e.rot_step(nxt, i == 3 ? 1 : 0, lds, wc, fq); }
            else if (E::ROW_AHEAD || i == 0) { cur = nxt; if (E::ROW_AHEAD && i + 1 < 8) nxt = e.rload(PG_ROW(i + 1), u.pn, wc, fq); }
            else cur = e.rload(PG_ROW(i), u.pn, wc, fq);
            f32x4 v[2][2] = {{acc[ai][0][m][0], acc[ai][0][m][1]}, {acc[ai][1][m][0], acc[ai][1][m][1]}};
            if constexpr (KHOOK) { const f32x4 rh = ((const LAS f32x4*)(lds + RHO_OFF))[ui * 256 + PG_TROW(i)]; const float r3 = frcp(rh[0] * rh[1] * rh[2] * rh[3]);
                v[0][0] *= r3; v[0][1] *= r3; v[1][0] *= r3; v[1][1] *= r3; }
            e.apply(PG_ROW(i), u.pn, wc, fq, v, rs[i], cs, cur);
        }
    }
    struct NoCi {};
    template <class T, bool H> struct CiSel { typedef NoCi type; };
    template <class T> struct CiSel<T, true> { typedef typename T::ColI type; };
    typedef typename CiSel<E, E::HAS_INIT>::type Ci;
    __device__ __forceinline__ Ci init_cols(const Unit& u, int wc, int fq) const { if constexpr (E::HAS_INIT) return e.colsi(u.pn, wc, fq); else return Ci{}; }
    __device__ __forceinline__ void init(f32x4 (&acc)[2][2][4][2], const Unit& u, int ui, LAS unsigned char* lds, int wr, int wc, int fr, int fq, const Ci& ci) const {
        if constexpr (E::HAS_INIT) {
            const int rbase = u.pm * BM + wr * 64 + fr;
            RowS rs[8];
#pragma unroll
            for (int i = 0; i < 8; ++i) {
                if constexpr (E::USE_TAB) { const f32x2 t = ((const LAS f32x2*)(lds + TAB_OFF))[ui * 256 + PG_TROW(i)]; rs[i] = RowS{t.x, t.y}; }
                else rs[i] = e.prei(PG_ROW(i), fq);
            }
#pragma unroll
            for (int i = 0; i < 8; ++i) {
                const int ai = i >> 2, m = i & 3; f32x4 v[2][2];
                e.init_row(PG_ROW(i), u.pn, wc, fq, v, rs[i], ci);
                if constexpr (KHOOK) { const float i0 = ((const LAS float*)(lds + RHO_OFF))[(ui * 256 + PG_TROW(i)) * 4]; v[0][0] *= i0; v[0][1] *= i0; v[1][0] *= i0; v[1][1] *= i0; }
                acc[ai][0][m][0] = v[0][0]; acc[ai][0][m][1] = v[0][1]; acc[ai][1][m][0] = v[1][0]; acc[ai][1][m][1] = v[1][1];
            }
        } else {
#pragma unroll
            for (int a = 0; a < 2; ++a)
#pragma unroll
                for (int b = 0; b < 2; ++b)
#pragma unroll
                    for (int m = 0; m < 4; ++m)
#pragma unroll
                        for (int n = 0; n < 2; ++n) acc[a][b][m][n] = (f32x4){0.f, 0.f, 0.f, 0.f};
        }
    }
#undef PG_ROW
#undef PG_TROW
};
template <class Epi>
__device__ __forceinline__ void gemm_phase(LAS unsigned char* lds, const Gemm g, const StaticOrder& S, const Epi& E) {
    const int tid = opaque_tid(), wid = __builtin_amdgcn_readfirstlane(tid >> 6), lane = tid & 63, wr = wid >> 2, wc = wid & 3, fr = lane & 15, fq = lane >> 4;
    int Ko = g.K; asm volatile("" : "+s"(Ko));
    const int K = Ko, nt = K / BK;
    unsigned voffA[2], voffB[2];
#pragma unroll
    for (int i = 0; i < 2; ++i) { int R, C; stage_rc(tid * 16 + i * 8192, R, C); const int Rb = Epi::PERM ? ((R & ~31) + perm32(R & 31)) : R; voffA[i] = (unsigned)(R * g.lda + C) * 2u; voffB[i] = (unsigned)(Rb * g.ldb + C) * 2u; }
    const size_t kstep = (size_t)(BK * 2);
    const size_t hstepA = (size_t)HALF * g.lda * 2, hstepB = (size_t)HALF * g.ldb * 2;
    const size_t tstepA = 2 * hstepA, tstepB = 2 * hstepB;
    const size_t pnA = (size_t)g.a_pn_off * 2;
    const unsigned ldsw = (unsigned)wid * 1024u;
    const int aoff = lds_byte(wr * 64 + fr, fq * 8), boff = lds_byte(wc * 32 + fr, fq * 8);
#define PG8_SA(b, h) (((b) * 2 + (h)) * HTB)
#define PG8_SB(b, h) ((4 + (b) * 2 + (h)) * HTB)
#define PG8_STAGE(bufoff, gbase, voff) do { _Pragma("unroll") for (int _i = 0; _i < 2; ++_i) \
        __builtin_amdgcn_global_load_lds((const unsigned*)((const char*)(gbase) + (voff)[_i]), (LAS unsigned*)(lds + (bufoff) + ldsw + _i * 8192), 16, 0, 0); } while (0)
#define PG8_LDA(dst, b, h) do { _Pragma("unroll") for (int m = 0; m < 4; ++m) _Pragma("unroll") for (int k = 0; k < 2; ++k) dst[m][k] = *(const LAS bf16x8*)(lds + PG8_SA(b, h) + aoff + m * 2048 + k * 1024); } while (0)
#define PG8_LDB(dst, b, h) do { _Pragma("unroll") for (int n = 0; n < 2; ++n) _Pragma("unroll") for (int k = 0; k < 2; ++k) dst[n][k] = *(const LAS bf16x8*)(lds + PG8_SB(b, h) + boff + n * 2048 + k * 1024); } while (0)
#define PG8_MMA(ai, bj, At, Bt) do { __builtin_amdgcn_s_setprio(1); _Pragma("unroll") for (int m = 0; m < 4; ++m) _Pragma("unroll") for (int n = 0; n < 2; ++n) _Pragma("unroll") for (int k = 0; k < 2; ++k) \
        acc[ai][bj][m][n] = __builtin_amdgcn_mfma_f32_16x16x32_bf16(Bt[n][k], At[m][k], acc[ai][bj][m][n], 0, 0, 0); __builtin_amdgcn_s_setprio(0); } while (0)
#define PG8_WAIT_V(n) asm volatile("s_waitcnt vmcnt(" #n ")" ::: "memory")
#define PG8_WAIT_L(n) asm volatile("s_waitcnt lgkmcnt(" #n ")" ::: "memory")
#define PG8_BAR __builtin_amdgcn_s_barrier()
#define PG8_SCHED __builtin_amdgcn_sched_barrier(0)
    Unit cur, nxt; int ui = 0;
    if (!S.next(0, cur)) return;
    E.build_tab(lds, S, tid);
    f32x4 acc[2][2][4][2];
    E.init(acc, cur, 0, lds, wr, wc, fr, fq, E.init_cols(cur, wc, fq));
    bf16x8 At[4][2], B0[2][2], B1[2][2];
    const char* cA = (const char*)g.A + (size_t)cur.pn * pnA + (size_t)cur.pm * tstepA; const char* cB = (const char*)g.Bt + (size_t)cur.pn * tstepB;
    PG8_STAGE(PG8_SB(0, 0), cB, voffB); PG8_STAGE(PG8_SB(0, 1), cB + hstepB, voffB); PG8_STAGE(PG8_SA(0, 0), cA, voffA); PG8_STAGE(PG8_SA(0, 1), cA + hstepA, voffA);
    if (wr == 1) PG8_BAR;
    PG8_WAIT_V(2); PG8_BAR;
    PG8_STAGE(PG8_SB(1, 0), cB + kstep, voffB); PG8_STAGE(PG8_SA(1, 0), cA + kstep, voffA); PG8_STAGE(PG8_SB(1, 1), cB + hstepB + kstep, voffB);
    PG8_WAIT_V(6); PG8_BAR;
    for (;;) {
        const bool has_next = S.next(ui + 1, nxt);
        const char* nA = has_next ? (const char*)g.A + (size_t)nxt.pn * pnA + (size_t)nxt.pm * tstepA : cA; const char* nB = has_next ? (const char*)g.Bt + (size_t)nxt.pn * tstepB : cB;
        for (int t = 0; t < nt; t += 2) {
            if constexpr (Epi::KHOOK) { if (t != 0 && (t & 7) == 0) E.khook(acc, ui, t >> 3, lds, wr, fr); }
            const bool last = (t == nt - 2);
            const char* a1 = cA + (size_t)(t + 1) * kstep;
            const char* a2 = last ? nA : cA + (size_t)(t + 2) * kstep; const char* b2 = last ? nB : cB + (size_t)(t + 2) * kstep;
            const char* a3 = a2 + kstep; const char* b3 = b2 + kstep;
            PG8_LDB(B0, 0, 0); PG8_LDB(B1, 0, 1); PG8_SCHED; PG8_LDA(At, 0, 0); PG8_STAGE(PG8_SA(1, 1), a1 + hstepA, voffA);
            PG8_WAIT_V(8); PG8_WAIT_L(0); PG8_BAR; PG8_MMA(0, 0, At, B0); PG8_MMA(0, 1, At, B1); PG8_BAR; PG8_SCHED;
            PG8_LDA(At, 0, 1); PG8_STAGE(PG8_SB(0, 0), b2, voffB); PG8_STAGE(PG8_SB(0, 1), b2 + hstepB, voffB); PG8_STAGE(PG8_SA(0, 0), a2, voffA);
            PG8_WAIT_V(8); PG8_WAIT_L(0); PG8_BAR; PG8_MMA(1, 0, At, B0); PG8_MMA(1, 1, At, B1); PG8_BAR; PG8_SCHED;
            PG8_LDB(B0, 1, 0); PG8_LDB(B1, 1, 1); PG8_SCHED; PG8_LDA(At, 1, 0); PG8_STAGE(PG8_SA(0, 1), a2 + hstepA, voffA);
            PG8_WAIT_V(8); PG8_WAIT_L(0); PG8_BAR; PG8_MMA(0, 0, At, B0); PG8_MMA(0, 1, At, B1); PG8_BAR; PG8_SCHED;
            PG8_LDA(At, 1, 1); PG8_STAGE(PG8_SB(1, 0), b3, voffB); PG8_STAGE(PG8_SB(1, 1), b3 + hstepB, voffB); PG8_STAGE(PG8_SA(1, 0), a3, voffA);
            PG8_WAIT_V(8); PG8_WAIT_L(0); PG8_BAR; PG8_MMA(1, 0, At, B0); PG8_MMA(1, 1, At, B1); PG8_BAR; PG8_SCHED;
        }
        if (wr == 0) PG8_BAR;
        E(acc, cur, ui, lds, wr, wc, fr, fq);
        if (!has_next) break;
        E.init(acc, nxt, ui + 1, lds, wr, wc, fr, fq, E.init_cols(nxt, wc, fq));
        cur = nxt; cA = nA; cB = nB; ++ui;
        if (wr == 1) PG8_BAR;
    }
    PG8_WAIT_V(0);
    PG8_BAR;
#undef PG8_SA
#undef PG8_SB
#undef PG8_STAGE
#undef PG8_LDA
#undef PG8_LDB
#undef PG8_MMA
#undef PG8_WAIT_V
#undef PG8_WAIT_L
#undef PG8_BAR
#undef PG8_SCHED
}
}

template <class Epi>
__device__ __forceinline__ void gemm_meta(LAS unsigned char* lds, const Gemm g, const Epi& E, int bid, int nb, int pn_lo, int pn_hi) {
    const int tid = opaque_tid(), wid = __builtin_amdgcn_readfirstlane(tid >> 6), lane = tid & 63, fr = lane & 15, fq = lane >> 4;
    const int ntask = (pn_hi - pn_lo) * 4, ksteps = g.K / 32;
    LAS f32x4* part = (LAS f32x4*)lds;
    for (int t = nb - 1 - bid; t < ntask; t += nb) {
        const int pn = pn_lo + (t >> 2), wc = t & 3;
        const bf16_t* ap = g.A + (size_t)pn * g.a_pn_off + (size_t)(MR + fr) * g.lda + 8 * fq;
        const bf16_t* bp = g.Bt + (size_t)(256 * pn + 32 * wc) * g.ldb + 8 * fq;
        f32x4 acc[2][2];
#pragma unroll
        for (int bj = 0; bj < 2; ++bj)
#pragma unroll
            for (int n = 0; n < 2; ++n) acc[bj][n] = (f32x4){0.f, 0.f, 0.f, 0.f};
#pragma unroll 4
        for (int ks = wid; ks < ksteps; ks += 8) {
            const int k0 = 32 * ks;
            const bf16x8 a = *(const bf16x8*)(ap + k0);
#pragma unroll
            for (int bj = 0; bj < 2; ++bj)
#pragma unroll
                for (int n = 0; n < 2; ++n) {
                    const int brow = Epi::PERM ? perm32(16 * n + fr) : 16 * n + fr;
                    const bf16x8 b = *(const bf16x8*)(bp + (size_t)(128 * bj + brow) * g.ldb + k0);
                    acc[bj][n] = __builtin_amdgcn_mfma_f32_16x16x32_bf16(b, a, acc[bj][n], 0, 0, 0);
                }
        }
#pragma unroll
        for (int i = 0; i < 4; ++i) part[(wid * 64 + lane) * 4 + i] = acc[i >> 1][i & 1];
        __syncthreads();
        if (wid == 0) {
            f32x4 v[2][2];
#pragma unroll
            for (int i = 0; i < 4; ++i) v[i >> 1][i & 1] = (f32x4){0.f, 0.f, 0.f, 0.f};
            if constexpr (Epi::HAS_INIT) E.init_row(MR + fr, pn, wc, fq, v, E.prei(MR + fr, fq), E.colsi(pn, wc, fq));
#pragma unroll
            for (int w = 0; w < 8; ++w)
#pragma unroll
                for (int i = 0; i < 4; ++i) v[i >> 1][i & 1] += part[(w * 64 + lane) * 4 + i];
            E.apply(MR + fr, pn, wc, fq, v, E.pre(MR + fr, fq), E.cols(pn, wc, fq), E.rload(MR + fr, pn, wc, fq));
        }
        __syncthreads();
    }
}

template <class E>
__device__ __forceinline__ void run_gemm(LAS unsigned char* lds, const Gemm g, const E& e, int bid, int nb, bool meta = true, int mlo = 0, int mhi = -1) {
    if (meta) gemm_meta<E>(lds, g, e, bid, nb, mlo, mhi < 0 ? g.N / 256 : mhi);
#if FAST_GEMM
    pg8::StaticOrder S; S.init(g.M, g.N, nb, bid);
    pg8::PgEpi<E> pe{e};
    pg8::gemm_phase<pg8::PgEpi<E>>(lds, g, S, pe);
#else
    gemm_naive<E>(g, e, bid, nb);
#endif
}

constexpr int NWV = 8;

__device__ __forceinline__ void transpose_item(const float* W, int K, int N, bf16_t* WT, int row_off, const float* gk, const float* bk, float* c1, float* c2, LAS float* scr, int item, int lane) {
    const int nblk = N / 32, kb = item / nblk, nbk = item % nblk, k0 = 64 * kb, n0 = 32 * nbk;
    float s1 = 0.f, s2 = 0.f;
    float wv[32];
#pragma unroll
    for (int i = 0; i < 32; ++i) wv[i] = __builtin_nontemporal_load(W + (size_t)(k0 + 2 * i + (lane >> 5)) * N + n0 + (lane & 31));
#pragma unroll
    for (int i = 0; i < 32; ++i) { const int kk = 2 * i + (lane >> 5); float w = wv[i]; if (bk) s2 += bk[k0 + kk] * w; if (gk) w *= gk[k0 + kk]; if (c1) s1 += bfround(w); scr[kk * 33 + (lane & 31)] = w; }
    if (c1) { s1 += __shfl_xor(s1, 32); s2 += __shfl_xor(s2, 32); if (lane < 32) { atomicAdd(c1 + n0 + lane, s1); atomicAdd(c2 + n0 + lane, s2); } }
    asm volatile("s_waitcnt lgkmcnt(0)" ::: "memory");
    const int cch = lane & 7;
#pragma unroll
    for (int j = 0; j < 4; ++j) { const int n = (lane >> 3) + 8 * j; const LAS float* s = scr + (8 * cch) * 33 + n;
        u32x4 o; o.x = pk2(s[0 * 33], s[1 * 33]); o.y = pk2(s[2 * 33], s[3 * 33]); o.z = pk2(s[4 * 33], s[5 * 33]); o.w = pk2(s[6 * 33], s[7 * 33]);
        *(u32x4*)(WT + (size_t)(row_off + n0 + n) * K + k0 + 8 * cch) = o; }
    asm volatile("s_waitcnt lgkmcnt(0)" ::: "memory");
}
__device__ __forceinline__ void transpose_item64(const float* W, int K, int N, bf16_t* WT, int row_off, const float* gk, const float* bk, float* c1, float* c2, LAS float* scr, int item, int lane) {
    const int nblk = N / 64, kb = item / nblk, nbk = item % nblk, k0 = 64 * kb, n0 = 64 * nbk, n4 = 4 * (lane & 15), kq = lane >> 4;
    f32x4 wv[16];
#pragma unroll
    for (int i = 0; i < 16; ++i) wv[i] = __builtin_nontemporal_load((const f32x4*)(W + (size_t)(k0 + 4 * i + kq) * N + n0 + n4));
    f32x4 s1 = {0.f, 0.f, 0.f, 0.f}, s2 = s1;
#pragma unroll
    for (int i = 0; i < 16; ++i) { const int kk = 4 * i + kq; f32x4 w = wv[i]; if (bk) s2 += w * bk[k0 + kk]; if (gk) w *= gk[k0 + kk];
        if (c1) { s1[0] += bfround(w[0]); s1[1] += bfround(w[1]); s1[2] += bfround(w[2]); s1[3] += bfround(w[3]); }
        LAS float* d = scr + kk * 65 + n4; d[0] = w[0]; d[1] = w[1]; d[2] = w[2]; d[3] = w[3]; }
    if (c1) {
#pragma unroll
        for (int e = 0; e < 4; ++e) { s1[e] += __shfl_xor(s1[e], 16); s1[e] += __shfl_xor(s1[e], 32); s2[e] += __shfl_xor(s2[e], 16); s2[e] += __shfl_xor(s2[e], 32); }
        if (lane < 16) {
#pragma unroll
            for (int e = 0; e < 4; ++e) { atomicAdd(c1 + n0 + n4 + e, s1[e]); atomicAdd(c2 + n0 + n4 + e, s2[e]); } }
    }
    asm volatile("s_waitcnt lgkmcnt(0)" ::: "memory");
    const int cch = lane & 7;
#pragma unroll
    for (int j = 0; j < 8; ++j) { const int n = (lane >> 3) + 8 * j; const LAS float* sp = scr + (8 * cch) * 65 + n;
        u32x4 o; o.x = pk2(sp[0 * 65], sp[1 * 65]); o.y = pk2(sp[2 * 65], sp[3 * 65]); o.z = pk2(sp[4 * 65], sp[5 * 65]); o.w = pk2(sp[6 * 65], sp[7 * 65]);
        *(u32x4*)(WT + (size_t)(row_off + n0 + n) * K + k0 + 8 * cch) = o; }
    asm volatile("s_waitcnt lgkmcnt(0)" ::: "memory");
}
constexpr int C1_UP0 = 0, C2_UP0 = 4096, C1_IN1 = 8192, C2_IN1 = 14336, C1_UP1 = 20480, C2_UP1 = 24576;
struct MatDesc { const float* W; int K, N; bf16_t* WT; int row_off; const float* gk; const float* bk; float* c1; float* c2; };
constexpr int TR_COUNT[18] = {720, 4, 4, 4, 4, 4, 4, 4, 4, 48, 32, 256, 1024, 1024, 1536, 512, 1024, 1024};
constexpr int tr_total() { int s = 0; for (int i = 0; i < 18; ++i) s += TR_COUNT[i]; return s; }
__device__ __forceinline__ MatDesc get_mat(const Ctx& c, int i) {
    MatDesc d; d.gk = nullptr; d.row_off = 0; d.bk = nullptr; d.c1 = nullptr; d.c2 = nullptr; float* cv = c.f32(OFF_C12);
    if (i == 0) { d.W = c.in[2]; d.K = 1024; d.N = EVEN_IN; d.WT = c.b16(OFF_WIN0); }
    else if (i <= 4) { const int h = i - 1; d.W = c.in[5] + h * 16384; d.K = 128; d.N = 128; d.WT = c.b16(OFF_WGATE); d.row_off = h * 256; }
    else if (i <= 8) { const int h = i - 5; d.W = c.in[7] + h * 16384; d.K = 128; d.N = 128; d.WT = c.b16(OFF_WGATE); d.row_off = h * 256 + 128; }
    else if (i == 9) { d.W = c.in[11]; d.K = 256; d.N = 768; d.WT = c.b16(OFF_WUQ); d.gk = c.in[10]; }
    else if (i == 10) { d.W = c.in[13]; d.K = 128; d.N = 1024; d.WT = c.b16(OFF_WUKV); d.gk = c.in[12]; }
    else if (i == 11) { d.W = c.in[14]; d.K = 1024; d.N = 1024; d.WT = c.b16(OFF_WOUT0); }
    else if (i == 12) { d.W = c.in[19]; d.K = 1024; d.N = 4096; d.WT = c.b16(OFF_W1_0); d.gk = c.in[17]; d.bk = c.in[18]; d.c1 = cv + C1_UP0; d.c2 = cv + C2_UP0; }
    else if (i == 13) { d.W = c.in[20]; d.K = 4096; d.N = 1024; d.WT = c.b16(OFF_W2_0); }
    else if (i == 14) { d.W = c.in[15]; d.K = 1024; d.N = 6144; d.WT = c.b16(OFF_WIN1); d.gk = c.in[21]; d.bk = c.in[22]; d.c1 = cv + C1_IN1; d.c2 = cv + C2_IN1; }
    else if (i == 15) { d.W = c.in[16]; d.K = 2048; d.N = 1024; d.WT = c.b16(OFF_WOUT1); }
    else if (i == 16) { d.W = c.in[19] + (size_t)1024 * 4096; d.K = 1024; d.N = 4096; d.WT = c.b16(OFF_W1_1); d.gk = c.in[17] + 1024; d.bk = c.in[18] + 1024; d.c1 = cv + C1_UP1; d.c2 = cv + C2_UP1; }
    else { d.W = c.in[20] + (size_t)4096 * 1024; d.K = 4096; d.N = 1024; d.WT = c.b16(OFF_W2_1); }
    return d;
}
__device__ __forceinline__ void sincos_d(double ang, float& cs, float& sn) {
    const double TWO_PI = 6.283185307179586476925, HALF_PI = 1.5707963267948966192;
    double r = ang - rint(ang / TWO_PI) * TWO_PI;
    const double q = rint(r / HALF_PI); const double y = r - q * HALF_PI; const double y2 = y * y;
    const double s = y * (1.0 + y2 * (-1.0 / 6 + y2 * (1.0 / 120 + y2 * (-1.0 / 5040 + y2 * (1.0 / 362880 + y2 * (-1.0 / 39916800 + y2 * (1.0 / 6227020800.0)))))));
    const double c = 1.0 + y2 * (-0.5 + y2 * (1.0 / 24 + y2 * (-1.0 / 720 + y2 * (1.0 / 40320 + y2 * (-1.0 / 3628800 + y2 * (1.0 / 479001600.0))))));
    const int qi = ((int)q) & 3;
    double cc, ss;
    if (qi == 0) { cc = c; ss = s; } else if (qi == 1) { cc = -s; ss = c; } else if (qi == 2) { cc = -c; ss = -s; } else { cc = s; ss = -c; }
    cs = (float)cc; sn = (float)ss;
}
__device__ __forceinline__ void phase_prologue(const Ctx& c, const Params& p, LAS unsigned char* lds, int bid, int nb, int part = 0) {
    const int tid = opaque_tid(), wid = tid >> 6, lane = tid & 63;
    LAS float* scr = (LAS float*)(lds + wid * 17408);
    const long gw = (long)bid * NWV + wid, NW = (long)nb * NWV;
    constexpr int T_C12 = 0, T_TR = tr_total(), T_ZP = 96, T_XB = (MR + NMETA) / 4, T_ROPE = (TT * 144 + 63) / 64, T_CCH = 8;
    constexpr int TOTAL = T_C12 + T_TR + T_ZP + T_XB + T_ROPE + T_CCH;
    for (long it = gw; it < TOTAL; it += NW) {
        int r = (int)it;
        if (part == 2 && (r < T_TR + T_ZP || r >= T_TR + T_ZP + T_XB)) continue;
        if (r < T_TR) {
            int mi = 0;
#pragma unroll
            for (int i = 0; i < 18; ++i) { if (mi == i && r >= TR_COUNT[i]) { r -= TR_COUNT[i]; mi = i + 1; } }
            const MatDesc d = get_mat(c, mi);
            if (mi == 0) transpose_item(d.W, d.K, d.N, d.WT, d.row_off, d.gk, d.bk, d.c1, d.c2, scr, r, lane);
            else transpose_item64(d.W, d.K, d.N, d.WT, d.row_off, d.gk, d.bk, d.c1, d.c2, scr, r, lane);
            continue;
        }
        r -= T_TR;
        if (r < T_ZP) {
            u32x4* dst = (u32x4*)(c.b16(OFF_WIN0) + (size_t)(EVEN_IN + r) * 1024); dst[lane] = (u32x4){0, 0, 0, 0}; dst[64 + lane] = (u32x4){0, 0, 0, 0};
            continue;
        }
        r -= T_ZP;
        if (r < T_XB) {
            if (part == 1) continue;
            f32x4 v[4][4];
#pragma unroll
            for (int q = 0; q < 4; ++q) { const int row = 4 * r + q;
                const float* src = row < MR ? c.in[0] + (size_t)row * DM : c.in[1] + (size_t)(row - MR) * DM;
#pragma unroll
                for (int j = 0; j < 4; ++j) v[q][j] = __builtin_nontemporal_load((const f32x4*)(src + 256 * j + 4 * lane)); }
#pragma unroll
            for (int q = 0; q < 4; ++q) { u32x2* dst = (u32x2*)(c.b16(OFF_XB) + (size_t)(4 * r + q) * DM);
#pragma unroll
                for (int j = 0; j < 4; ++j) dst[64 * j + lane] = pk4(v[q][j]); }
            continue;
        }
        r -= T_XB;
        if (r < T_ROPE) {
            const int e = r * 64 + lane;
            if (e < TT * 144) {
                const int pos = e / 144, j = e % 144; float cs, sn;
                if (j < 16) { sincos_d((double)pos * p.inv0[j], cs, sn); c.f32(OFF_ROPE0C)[pos * 16 + j] = cs; c.f32(OFF_ROPE0S)[pos * 16 + j] = sn; }
                else { sincos_d((double)pos * p.inv1[j - 16], cs, sn); c.f32(OFF_ROPE1C)[pos * 128 + j - 16] = cs; c.f32(OFF_ROPE1S)[pos * 128 + j - 16] = sn; }
            }
            continue;
        }
        r -= T_ROPE;
        { const int ch = r * 64 + lane; const float lam = c.in[9][ch]; c.f32(OFF_CCH)[ch] = -8.f * log1pf(__expf(-lam)); }
    }
}

__device__ __forceinline__ void phase_conv(const Ctx& c, int bid, int nb) {
    const int tid = opaque_tid(), wid = tid >> 6, lane = tid & 63;
    const bf16_t* p0 = c.b16(OFF_P0); bf16_t* xc = c.b16(OFF_XC); bf16_t* Kb = c.b16(OFF_K);
    const float* cw = c.in[3]; const float* cb = c.in[4];
    const int ch0 = lane * 8;
    const int h = lane >> 3, d0 = (lane & 7) * 4, jj = d0 & 15;
    constexpr int RB = 4;
    for (int r0 = (bid * NWV + wid) * RB; r0 < MR + NMETA; r0 += nb * NWV * RB) {
        u32x4 x[RB][4]; u32x2 k1[RB], k2[RB]; f32x4 cs[RB], sn[RB];
#pragma unroll
        for (int q = 0; q < RB; ++q) {
            const int row = r0 + q;
#pragma unroll
            for (int w = 0; w < 4; ++w) {
                const int d = 3 - w; int srow = -1;
                if (row < MR) { const int sp = (row & (SEQ - 1)) - d; srow = sp >= 0 ? row - d : MR + NMETA + sp; }
                else { srow = (row - MR - d) >= 0 ? row - d : -1; }
                x[q][w] = srow >= 0 ? *(const u32x4*)(p0 + (size_t)srow * N_IN0 + 512 + ch0) : (u32x4){0u, 0u, 0u, 0u};
            }
            const int pos = row_pos(row);
            k1[q] = *(const u32x2*)(p0 + (size_t)row * N_IN0 + 1408 + jj); k2[q] = *(const u32x2*)(p0 + (size_t)row * N_IN0 + 1424 + jj);
            cs[q] = *(const f32x4*)(c.f32(OFF_ROPE0C) + pos * 16 + jj); sn[q] = *(const f32x4*)(c.f32(OFF_ROPE0S) + pos * 16 + jj);
        }
        f32x4 wq[4][2]; f32x4 bq[2];
#pragma unroll
        for (int w = 0; w < 4; ++w) { wq[w][0] = *(const f32x4*)(cw + w * 512 + ch0); wq[w][1] = *(const f32x4*)(cw + w * 512 + ch0 + 4); }
        bq[0] = *(const f32x4*)(cb + ch0); bq[1] = *(const f32x4*)(cb + ch0 + 4);
#pragma unroll
        for (int q = 0; q < RB; ++q) {
            const int row = r0 + q;
            f32x4 a0 = bq[0], a1 = bq[1];
#pragma unroll
            for (int w = 0; w < 4; ++w) { f32x4 lo, hi; unpk8(x[q][w], lo, hi); a0 += wq[w][0] * lo; a1 += wq[w][1] * hi; }
            *(u32x4*)(xc + (size_t)row * LRUW + ch0) = pk8(a0, a1);
            const f32x4 x1 = unpk4(k1[q]), x2 = unpk4(k2[q]);
            *(u32x2*)(Kb + (size_t)row * NQ + h * QKD + 64 + d0) = pk4(d0 < 16 ? x1 * cs[q] - x2 * sn[q] : x1 * sn[q] + x2 * cs[q]);
        }
    }
}

__device__ __forceinline__ f32x2 meta_state2(const Ctx& c, int ch) {
    f32x2 h = {0.f, 0.f}; const unsigned* ab = (const unsigned*)c.f32(OFF_ABMETA) + ch;
#pragma unroll
    for (int i = 0; i < NMETA; ++i) { const u32x2 w = *(const u32x2*)(ab + i * LRUW); h.x = (1.f - bf2f(w.x & 0xffffu)) * h.x + bf2f(w.x >> 16); h.y = (1.f - bf2f(w.y & 0xffffu)) * h.y + bf2f(w.y >> 16); }
    return h;
}
constexpr int SC_CH = 64, SC_NCK = SEQ / SC_CH;
__device__ __forceinline__ void phase_scan1(const Ctx& c, int bid, int nb) {
    const int tid = opaque_tid(), wid = tid >> 6, lane = tid & 63;
    for (int it = bid * NWV + wid; it < NBATCH * SC_NCK * 4; it += nb * NWV) {
        const int chg = it & 3, ck = (it >> 2) & (SC_NCK - 1), b = it >> 7, ch = chg * 128 + 2 * lane, row0 = b * SEQ + ck * SC_CH;
        const unsigned* ab = (const unsigned*)c.out + (size_t)row0 * LRUW + ch;
        f32x2 P = {1.f, 1.f}, S = {0.f, 0.f};
#pragma unroll 16
        for (int t = 0; t < SC_CH; ++t) { const u32x2 w = *(const u32x2*)(ab + (size_t)t * LRUW);
            const float a0 = 1.f - bf2f(w.x & 0xffffu), a1 = 1.f - bf2f(w.y & 0xffffu);
            S.x = a0 * S.x + bf2f(w.x >> 16); S.y = a1 * S.y + bf2f(w.y >> 16); P.x *= a0; P.y *= a1; }
        *(f32x4*)(c.f32(OFF_CARRY) + ((size_t)(b * SC_NCK + ck) * LRUW + ch) * 2) = (f32x4){P.x, S.x, P.y, S.y};
    }
}
__device__ __forceinline__ void scan1_local(const Ctx& c, int bid, int nb) {
    asm volatile("s_waitcnt vmcnt(0)" ::: "memory"); __syncthreads();
    const int tid = opaque_tid(), wid = tid >> 6, lane = tid & 63;
    pg8::StaticOrder S; S.init(MR, 1024, nb, bid);
    pg8::Unit u;
    for (int i = wid >> 2; S.next(i, u); i += 2) {
        const int b = u.pm >> 3, ck = (u.pm & 7) * 4 + (wid & 3), ch = u.pn * 128 + 2 * lane, row0 = b * SEQ + ck * SC_CH;
        const unsigned* ab = (const unsigned*)c.out + (size_t)row0 * LRUW + ch;
        f32x2 P = {1.f, 1.f}, Sm = {0.f, 0.f};
#pragma unroll 16
        for (int t = 0; t < SC_CH; ++t) { const u32x2 w = *(const u32x2*)(ab + (size_t)t * LRUW);
            const float a0 = 1.f - bf2f(w.x & 0xffffu), a1 = 1.f - bf2f(w.y & 0xffffu);
            Sm.x = a0 * Sm.x + bf2f(w.x >> 16); Sm.y = a1 * Sm.y + bf2f(w.y >> 16); P.x *= a0; P.y *= a1; }
        *(f32x4*)(c.f32(OFF_CARRY) + ((size_t)(b * SC_NCK + ck) * LRUW + ch) * 2) = (f32x4){P.x, Sm.x, P.y, Sm.y};
    }
}
__device__ __forceinline__ void phase_scan2(const Ctx& c, int bid, int nb) {
    const int tid = opaque_tid(), wid = tid >> 6, lane = tid & 63;
    const bf16_t* p0 = c.b16(OFF_P0); bf16_t* mix = c.b16(OFF_MIX);
    for (int it = bid * NWV + wid; it < NBATCH * SC_NCK * 4 + 4; it += nb * NWV) {
        if (it >= NBATCH * SC_NCK * 4) {
            const int ch = (it - NBATCH * SC_NCK * 4) * 128 + 2 * lane; f32x2 h = {0.f, 0.f};
            const unsigned* ab = (const unsigned*)c.f32(OFF_ABMETA) + ch;
            for (int i = 0; i < NMETA; ++i) { const u32x2 w = *(const u32x2*)(ab + i * LRUW); h.x = (1.f - bf2f(w.x & 0xffffu)) * h.x + bf2f(w.x >> 16); h.y = (1.f - bf2f(w.y & 0xffffu)) * h.y + bf2f(w.y >> 16);
                const int row = MR + i; const unsigned gt = *(const unsigned*)(p0 + (size_t)row * N_IN0 + ch);
                *(unsigned*)(mix + (size_t)row * DM + ch) = pk2(h.x * gelu_tanh(bf2f(gt & 0xffffu)), h.y * gelu_tanh(bf2f(gt >> 16))); }
            continue;
        }
        const int chg = it & 3, ck = (it >> 2) & (SC_NCK - 1), b = it >> 7, ch = chg * 128 + 2 * lane, row0 = b * SEQ + ck * SC_CH;
        f32x2 h = meta_state2(c, ch);
        const float* cr = c.f32(OFF_CARRY) + ((size_t)(b * SC_NCK) * LRUW + ch) * 2;
        for (int k = 0; k < ck; ++k) { const f32x4 ps = *(const f32x4*)(cr + (size_t)k * LRUW * 2); h.x = ps[0] * h.x + ps[1]; h.y = ps[2] * h.y + ps[3]; }
        const unsigned* ab = (const unsigned*)c.out + (size_t)row0 * LRUW + ch;
        for (int t0 = 0; t0 < SC_CH; t0 += 16) {
            u32x2 w[16]; unsigned gt[16];
#pragma unroll
            for (int t = 0; t < 16; ++t) { w[t] = *(const u32x2*)(ab + (size_t)(t0 + t) * LRUW); gt[t] = *(const unsigned*)(p0 + (size_t)(row0 + t0 + t) * N_IN0 + ch); }
#pragma unroll
            for (int t = 0; t < 16; ++t) {
                h.x = (1.f - bf2f(w[t].x & 0xffffu)) * h.x + bf2f(w[t].x >> 16); h.y = (1.f - bf2f(w[t].y & 0xffffu)) * h.y + bf2f(w[t].y >> 16);
                *(unsigned*)(mix + (size_t)(row0 + t0 + t) * DM + ch) = pk2(h.x * gelu_tanh(bf2f(gt[t] & 0xffffu)), h.y * gelu_tanh(bf2f(gt[t] >> 16)));
            }
        }
    }
}

__device__ __forceinline__ void phase_attn_naive(const Ctx& c, int bid, int nb, bool meta_only) {
    const int tid = opaque_tid(), wid = tid >> 6, lane = tid & 63;
    const bf16_t* Q = c.b16(OFF_Q); const bf16_t* K = c.b16(OFF_K); const bf16_t* V = c.b16(OFF_V); bf16_t* mix = c.b16(OFF_MIX);
    const long nitems = (long)NBATCH * MLA_H * SEQ + MLA_H * NMETA;
    for (long it = (meta_only ? (long)NBATCH * MLA_H * SEQ : 0) + (long)bid * NWV + wid; it < nitems; it += (long)nb * NWV) {
        int b, h, s, qrow;
        if (it < (long)NBATCH * MLA_H * SEQ) { s = (int)(it & (SEQ - 1)); h = (int)((it >> 11) & 7); b = (int)(it >> 14); qrow = b * SEQ + s; }
        else { const int r = (int)(it - (long)NBATCH * MLA_H * SEQ); s = r & 15; h = r >> 4; b = -1; qrow = MR + s; }
        float q[QKD];
#pragma unroll
        for (int j = 0; j < QKD / 8; ++j) { const u32x4 w = *(const u32x4*)(Q + (size_t)qrow * NQ + h * QKD + 8 * j);
            q[8 * j] = bf2f(w.x & 0xffffu); q[8 * j + 1] = bf2f(w.x >> 16); q[8 * j + 2] = bf2f(w.y & 0xffffu); q[8 * j + 3] = bf2f(w.y >> 16);
            q[8 * j + 4] = bf2f(w.z & 0xffffu); q[8 * j + 5] = bf2f(w.z >> 16); q[8 * j + 6] = bf2f(w.w & 0xffffu); q[8 * j + 7] = bf2f(w.w >> 16); }
        float m = -1e30f, l = 0.f, o = 0.f;
        const int ntile = b < 0 ? 1 : 2 + (s >> 6);
        for (int t = 0; t < ntile; ++t) {
            int krow0, nvalid;
            if (t == 0) { krow0 = MR; nvalid = b < 0 ? s + 1 : NMETA; } else { krow0 = b * SEQ + 64 * (t - 1); nvalid = min(64, s + 1 - 64 * (t - 1)); }
            const bool valid = lane < nvalid;
            float sv = 0.f;
            { const bf16_t* kp = K + (size_t)(krow0 + lane) * NQ + h * QKD;
#pragma unroll
              for (int j = 0; j < QKD / 8; ++j) { const u32x4 w = *(const u32x4*)(kp + 8 * j);
                sv += q[8 * j] * bf2f(w.x & 0xffffu) + q[8 * j + 1] * bf2f(w.x >> 16) + q[8 * j + 2] * bf2f(w.y & 0xffffu) + q[8 * j + 3] * bf2f(w.y >> 16)
                    + q[8 * j + 4] * bf2f(w.z & 0xffffu) + q[8 * j + 5] * bf2f(w.z >> 16) + q[8 * j + 6] * bf2f(w.w & 0xffffu) + q[8 * j + 7] * bf2f(w.w >> 16); } }
            if (!valid) sv = -1e30f;
            const float mn = fmaxf(m, wave_max(sv)), f = exp2f(m - mn), pv = valid ? exp2f(sv - mn) : 0.f;
            l = l * f + wave_sum(pv); o *= f; m = mn;
            for (int k = 0; k < nvalid; ++k) { const float pk = __shfl(pv, k); o += pk * bf2f(V[(size_t)(krow0 + k) * NV + h * VD + lane]); }
        }
        mix[(size_t)qrow * DM + 512 + h * VD + lane] = (bf16_t)(pk2(o / l, 0.f) & 0xffffu);
    }
}

typedef float f32x16 __attribute__((ext_vector_type(16)));
typedef short v4i16_t __attribute__((ext_vector_type(4)));
__device__ __forceinline__ int crow(int r, int hi) { return (r & 3) + 8 * (r >> 2) + 4 * hi; }
__device__ __forceinline__ bf16x8 tr_pair(const LAS unsigned char* p0, const LAS unsigned char* p1) {
    const v4i16_t a = __builtin_amdgcn_ds_read_tr16_b64_v4i16((LAS v4i16_t*)p0), b = __builtin_amdgcn_ds_read_tr16_b64_v4i16((LAS v4i16_t*)p1);
    return (bf16x8){a[0], a[1], a[2], a[3], b[0], b[1], b[2], b[3]};
}
constexpr int AT_KPITCH = 208, AT_KBYTES = 64 * AT_KPITCH  , AT_VBYTES = 8192, AT_BUF = AT_KBYTES + AT_VBYTES;
__device__ __forceinline__ void attn_unit(const Ctx& c, LAS unsigned char* lds, int b, int h, int qb) {
    const int tid = opaque_tid(), lane = tid & 63, wid = __builtin_amdgcn_readfirstlane(tid >> 6), r32 = lane & 31, hi = lane >> 5;
    const bf16_t* Q = c.b16(OFF_Q); const bf16_t* K = c.b16(OFF_K) + h * QKD; const bf16_t* V = c.b16(OFF_V) + h * VD; bf16_t* mix = c.b16(OFF_MIX);
    const int qrel = 32 * wid + r32;
    const size_t qrow = (size_t)b * SEQ + 256 * qb + qrel;
    bf16x8 qr[6];
#pragma unroll
    for (int d0 = 0; d0 < 6; ++d0) qr[d0] = *(const bf16x8*)(Q + qrow * NQ + h * QKD + 16 * d0 + 8 * hi);
    const int kp0 = tid, kp1 = tid + 512; const bool k1ok = tid < 256;
    const int kr0 = kp0 / 12, kc0 = kp0 % 12, kr1 = k1ok ? kp1 / 12 : 0, kc1 = k1ok ? kp1 % 12 : 0;
    const int vr = tid >> 3, vc = tid & 7;
    const unsigned kdst0 = kr0 * AT_KPITCH + kc0 * 16, kdst1 = kr1 * AT_KPITCH + kc1 * 16, vdst = AT_KBYTES + (vc >> 2) * 4096 + vr * 64 + (vc & 3) * 16;
    u32x4 kgA0, kgA1, vgA, kgB0, kgB1, vgB;
    const int NT = 4 * qb + 5;
#define AT_GLOAD(t, S) do { const size_t base_ = (t) == 0 ? (size_t)MR : (size_t)b * SEQ + 64 * ((t) - 1); \
        kg##S##0 = *(const u32x4*)(K + (base_ + kr0) * NQ + 8 * kc0); if (k1ok) kg##S##1 = *(const u32x4*)(K + (base_ + kr1) * NQ + 8 * kc1); \
        vg##S = *(const u32x4*)(V + (base_ + vr) * NV + 8 * vc); \
        if ((t) == 0) { const u32x4 z_ = (u32x4){0u, 0u, 0u, 0u}; if (kr0 >= NMETA) kg##S##0 = z_; if (kr1 >= NMETA) kg##S##1 = z_; if (vr >= NMETA) vg##S = z_; } } while (0)
#define AT_LWRITE(buf, S) do { LAS unsigned char* d_ = lds + (buf) * AT_BUF; *(LAS u32x4*)(d_ + kdst0) = kg##S##0; if (k1ok) *(LAS u32x4*)(d_ + kdst1) = kg##S##1; *(LAS u32x4*)(d_ + vdst) = vg##S; } while (0)
#define AT_BAR() do { asm volatile("s_waitcnt lgkmcnt(0)" ::: "memory"); __builtin_amdgcn_s_barrier(); asm volatile("" ::: "memory"); } while (0)
    f32x16 o0, o1;
#pragma unroll
    for (int r = 0; r < 16; ++r) { o0[r] = 0.f; o1[r] = 0.f; }
    float m = -1e30f, l = 0.f;
    AT_GLOAD(0, A); AT_LWRITE(0, A);
    AT_GLOAD(1, A);
    AT_BAR();
    const unsigned kfo = r32 * AT_KPITCH + hi * 16;
    const unsigned vfo = AT_KBYTES + ((lane >> 4) & 1) * 32 + (lane & 3) * 8 + (4 * hi + ((lane & 15) >> 2)) * 64;
#define AT_COMPUTE(t) do { \
        const int jb = (t) - 1 - 4 * qb; \
        if (jb < 0 || 64 * jb <= 32 * wid + 31) { \
            const LAS unsigned char* bufp = lds + ((t) & 1) * AT_BUF; \
            f32x16 p0, p1; \
            _Pragma("unroll") for (int r = 0; r < 16; ++r) { p0[r] = 0.f; p1[r] = 0.f; } \
            _Pragma("unroll") for (int d0 = 0; d0 < 6; ++d0) { \
                const bf16x8 k0 = *(const LAS bf16x8*)(bufp + kfo + d0 * 32), k1 = *(const LAS bf16x8*)(bufp + kfo + 32 * AT_KPITCH + d0 * 32); \
                p0 = __builtin_amdgcn_mfma_f32_32x32x16_bf16(k0, qr[d0], p0, 0, 0, 0); \
                p1 = __builtin_amdgcn_mfma_f32_32x32x16_bf16(k1, qr[d0], p1, 0, 0, 0); } \
            if ((t) == 0) { asm volatile("" ::: "memory"); \
                _Pragma("unroll") for (int r = 0; r < 16; ++r) { if (crow(r, hi) >= NMETA) p0[r] = -1e30f; p1[r] = -1e30f; } \
            } else if (jb >= 0) { asm volatile("" ::: "memory"); \
                _Pragma("unroll") for (int r = 0; r < 16; ++r) { const int kv = 64 * jb + crow(r, hi); if (kv > qrel) p0[r] = -1e30f; if (kv + 32 > qrel) p1[r] = -1e30f; } } \
            float rm = fmaxf(fmaxf(p0[0], p1[0]), fmaxf(p0[1], p1[1])); \
            _Pragma("unroll") for (int r = 2; r < 16; r += 2) rm = fmaxf(rm, fmaxf(fmaxf(p0[r], p1[r]), fmaxf(p0[r + 1], p1[r + 1]))); \
            rm = fmaxf(rm, __shfl_xor(rm, 32)); \
            const float mn = fmaxf(m, rm), f = __builtin_amdgcn_exp2f(m - mn); m = mn; \
            float ls = 0.f; \
            _Pragma("unroll") for (int r = 0; r < 16; ++r) { p0[r] = __builtin_amdgcn_exp2f(p0[r] - mn); p1[r] = __builtin_amdgcn_exp2f(p1[r] - mn); ls += p0[r] + p1[r]; } \
            l = l * f + ls; \
            if (__any(f != 1.f)) { asm volatile("" ::: "memory"); \
                _Pragma("unroll") for (int r = 0; r < 16; ++r) { o0[r] *= f; o1[r] *= f; } } \
            u32x4 pw[4]; \
            _Pragma("unroll") for (int q4 = 0; q4 < 4; ++q4) { pw[0][q4] = pk2(p0[2 * q4], p0[2 * q4 + 1]); pw[1][q4] = pk2(p0[8 + 2 * q4], p0[9 + 2 * q4]); pw[2][q4] = pk2(p1[2 * q4], p1[2 * q4 + 1]); pw[3][q4] = pk2(p1[8 + 2 * q4], p1[9 + 2 * q4]); } \
            _Pragma("unroll") for (int s4 = 0; s4 < 4; ++s4) { \
                const bf16x8 pf = __builtin_bit_cast(bf16x8, pw[s4]); \
                const bf16x8 v0 = tr_pair(bufp + vfo + s4 * 1024, bufp + vfo + s4 * 1024 + 512); \
                const bf16x8 v1 = tr_pair(bufp + vfo + 4096 + s4 * 1024, bufp + vfo + 4096 + s4 * 1024 + 512); \
                o0 = __builtin_amdgcn_mfma_f32_32x32x16_bf16(v0, pf, o0, 0, 0, 0); \
                o1 = __builtin_amdgcn_mfma_f32_32x32x16_bf16(v1, pf, o1, 0, 0, 0); } \
        } } while (0)
    for (int t = 0; t < NT; t += 2) {
        if (t + 2 < NT) AT_GLOAD(t + 2, B);
        AT_COMPUTE(t);
        if (t + 1 < NT) AT_LWRITE((t + 1) & 1, A);
        AT_BAR();
        if (t + 1 < NT) {
            if (t + 3 < NT) AT_GLOAD(t + 3, A);
            AT_COMPUTE(t + 1);
            if (t + 2 < NT) AT_LWRITE((t + 2) & 1, B);
            AT_BAR();
        }
    }
    asm volatile("s_waitcnt vmcnt(0)" ::: "memory");
#undef AT_GLOAD
#undef AT_LWRITE
#undef AT_COMPUTE
#undef AT_BAR
    l += __shfl_xor(l, 32);
    const float inv = frcp(l);
    bf16_t* orow = mix + qrow * DM + 512 + h * VD + 4 * hi;
#pragma unroll
    for (int g = 0; g < 4; ++g) {
        *(u32x2*)(orow + 8 * g) = pk4((f32x4){o0[4 * g] * inv, o0[4 * g + 1] * inv, o0[4 * g + 2] * inv, o0[4 * g + 3] * inv});
        *(u32x2*)(orow + 32 + 8 * g) = pk4((f32x4){o1[4 * g] * inv, o1[4 * g + 1] * inv, o1[4 * g + 2] * inv, o1[4 * g + 3] * inv});
    }
}
__device__ __forceinline__ void phase_attn_fast(const Ctx& c, LAS unsigned char* lds, int bid, int nb) {
    const int vcu = (nb % 8 == 0) ? (bid % 8) * (nb / 8) + bid / 8 : bid;
    for (int slot = vcu; slot < 256; slot += nb) {
        const int bh = slot >> 1;
        for (int i = 0; i < 4; ++i) { const int s_ = 2 * (slot & 1) + (i >> 1), qb = (i & 1) ? s_ : 7 - s_; attn_unit(c, lds, bh >> 3, bh & 7, qb); }
    }
}

__device__ __forceinline__ void phase_ret_naive(const Ctx& c, LAS unsigned char* lds, int bid, int nb) {
    const int tid = opaque_tid(), wid = tid >> 6, lane = tid & 63;
    const bf16_t* Q1 = c.b16(OFF_Q1); const bf16_t* K1 = c.b16(OFF_K1); const bf16_t* V1 = c.b16(OFF_V1); bf16_t* G1 = c.b16(OFF_G1);
    LAS float* qs = (LAS float*)(lds + wid * 1024);
    const long nitems = (long)NBATCH * RET_H * SEQ;
    for (long it = (long)bid * NWV + wid; it < nitems; it += (long)nb * NWV) {
        const int s = (int)(it & (SEQ - 1)), h = (int)((it >> 11) & 3), b = (int)(it >> 13), qrow = b * SEQ + s;
        { const u32x2 w = *(const u32x2*)(Q1 + (size_t)qrow * 1024 + h * RDK + 4 * lane); const f32x4 f = unpk4(w); qs[4 * lane] = f[0]; qs[4 * lane + 1] = f[1]; qs[4 * lane + 2] = f[2]; qs[4 * lane + 3] = f[3]; }
        asm volatile("s_waitcnt lgkmcnt(0)" ::: "memory");
        const float lg2 = log2f(1.f - exp2f(-5.f - (float)h));
        float o[8];
#pragma unroll
        for (int e = 0; e < 8; ++e) o[e] = 0.f;
        const int ntile = 2 + (s >> 6), qpos = NMETA + s;
        for (int t = 0; t < ntile; ++t) {
            int krow0, nvalid, kpos0;
            if (t == 0) { krow0 = MR; nvalid = NMETA; kpos0 = 0; } else { krow0 = b * SEQ + 64 * (t - 1); nvalid = min(64, s + 1 - 64 * (t - 1)); kpos0 = NMETA + 64 * (t - 1); }
            float sv = 0.f;
            { const bf16_t* kp = K1 + (size_t)(krow0 + lane) * 1024 + h * RDK;
#pragma unroll 4
              for (int j = 0; j < RDK / 8; ++j) { const u32x4 w = *(const u32x4*)(kp + 8 * j); const LAS float* qq = qs + 8 * j;
                sv += qq[0] * bf2f(w.x & 0xffffu) + qq[1] * bf2f(w.x >> 16) + qq[2] * bf2f(w.y & 0xffffu) + qq[3] * bf2f(w.y >> 16)
                    + qq[4] * bf2f(w.z & 0xffffu) + qq[5] * bf2f(w.z >> 16) + qq[6] * bf2f(w.w & 0xffffu) + qq[7] * bf2f(w.w >> 16); } }
            const float wv = lane < nvalid ? sv * exp2f(lg2 * (float)(qpos - kpos0 - lane)) : 0.f;
            for (int k = 0; k < nvalid; ++k) { const float wk = __shfl(wv, k); const u32x4 w = *(const u32x4*)(V1 + (size_t)(krow0 + k) * RMIX + h * RDV + 8 * lane);
                o[0] += wk * bf2f(w.x & 0xffffu); o[1] += wk * bf2f(w.x >> 16); o[2] += wk * bf2f(w.y & 0xffffu); o[3] += wk * bf2f(w.y >> 16);
                o[4] += wk * bf2f(w.z & 0xffffu); o[5] += wk * bf2f(w.z >> 16); o[6] += wk * bf2f(w.w & 0xffffu); o[7] += wk * bf2f(w.w >> 16); }
        }
        float ss = 0.f;
#pragma unroll
        for (int e = 0; e < 8; ++e) ss += o[e] * o[e];
        const float rstd = frsq(wave_sum(ss) * (1.f / RDV) + LN_EPS);
        bf16_t* gp = G1 + (size_t)qrow * RMIX + h * RDV + 8 * lane; const u32x4 gw = *(const u32x4*)gp;
        u32x4 r; r.x = pk2(bf2f(gw.x & 0xffffu) * o[0] * rstd, bf2f(gw.x >> 16) * o[1] * rstd); r.y = pk2(bf2f(gw.y & 0xffffu) * o[2] * rstd, bf2f(gw.y >> 16) * o[3] * rstd);
        r.z = pk2(bf2f(gw.z & 0xffffu) * o[4] * rstd, bf2f(gw.z >> 16) * o[5] * rstd); r.w = pk2(bf2f(gw.w & 0xffffu) * o[6] * rstd, bf2f(gw.w >> 16) * o[7] * rstd);
        *(u32x4*)gp = r;
    }
}

__device__ __forceinline__ unsigned off_b(unsigned row, unsigned ch) { return 256u * row + 16u * (ch ^ (((row & 3) << 2) | ((row >> 2) & 3))); }
constexpr int RT_Q = 0, RT_K = 32768, RT_V = 65536, RT_ST = 81920, RT_END = 147456;
__device__ __forceinline__ void ret_unit(const Ctx& c, LAS unsigned char* lds, int b, int h, int sl) {
    const int tid0 = opaque_tid(), wid = __builtin_amdgcn_readfirstlane(tid0 >> 6); int tid = tid0, lane = tid & 63, r32 = lane & 31, hi = lane >> 5;
    const int wi = wid & 1, wdv = wid >> 1;
    const int wk = wid & 3, wd = wid >> 2;
    const bf16_t* Q1 = c.b16(OFF_Q1) + h * RDK; const bf16_t* K1 = c.b16(OFF_K1) + h * RDK; bf16_t* V1 = c.b16(OFF_V1) + h * RDV + sl * 128;
    float* osq = c.out;
    const float lg2 = log2f(1.f - exp2f(-5.f - (float)h));
    const float g64 = exp2f(lg2 * 64.f);
    const int il = 32 * wi + r32;
    const float rowscale = exp2f(lg2 * (float)(il - 63));
    u32x4 gq[4], gk[4], gv[2];
    f32x16 S[2][2];
#pragma unroll
    for (int a = 0; a < 2; ++a)
#pragma unroll
        for (int bb = 0; bb < 2; ++bb)
#pragma unroll
            for (int r = 0; r < 16; ++r) S[a][bb][r] = 0.f;
#define RT_GLOAD(cc) do { const size_t base_ = (cc) == 0 ? (size_t)MR : (size_t)b * SEQ + 64 * ((cc) - 1); \
        _Pragma("unroll") for (int k_ = 0; k_ < 4; ++k_) { const int p_ = tid + 512 * k_; gq[k_] = *(const u32x4*)(Q1 + (base_ + (p_ >> 5)) * 1024 + 8 * (p_ & 31)); gk[k_] = *(const u32x4*)(K1 + (base_ + (p_ >> 5)) * 1024 + 8 * (p_ & 31)); } \
        _Pragma("unroll") for (int k_ = 0; k_ < 2; ++k_) { const int p_ = tid + 512 * k_; gv[k_] = *(const u32x4*)(V1 + (base_ + (p_ >> 4)) * RMIX + 8 * (p_ & 15)); } } while (0)
#define RT_LWRITE(cc) do { const int L_ = (cc) == 0 ? NMETA : 64; \
        _Pragma("unroll") for (int k_ = 0; k_ < 4; ++k_) { const int p_ = tid + 512 * k_, row_ = p_ >> 5, ch_ = p_ & 31; const unsigned o_ = (ch_ >> 4) * 16384 + off_b(row_, ch_ & 15); \
            const bool ok_ = row_ < L_; const u32x4 z_ = (u32x4){0u, 0u, 0u, 0u}; \
            *(LAS u32x4*)(lds + RT_Q + o_) = ok_ ? gq[k_] : z_; *(LAS u32x4*)(lds + RT_K + o_) = ok_ ? gk[k_] : z_; } \
        _Pragma("unroll") for (int k_ = 0; k_ < 2; ++k_) { const int p_ = tid + 512 * k_, row_ = p_ >> 4, ch_ = p_ & 15; \
            const float fc_ = (cc) == 0 ? (row_ < NMETA ? exp2f(lg2 * (float)(NMETA - 1 - row_)) : 0.f) : fcv[k_]; const u32x4 w_ = gv[k_]; u32x4 r_; \
            r_.x = pk2(bf2f(w_.x & 0xffffu) * fc_, bf2f(w_.x >> 16) * fc_); r_.y = pk2(bf2f(w_.y & 0xffffu) * fc_, bf2f(w_.y >> 16) * fc_); \
            r_.z = pk2(bf2f(w_.z & 0xffffu) * fc_, bf2f(w_.z >> 16) * fc_); r_.w = pk2(bf2f(w_.w & 0xffffu) * fc_, bf2f(w_.w >> 16) * fc_); \
            *(LAS u32x4*)(lds + RT_V + off_b(row_, ch_)) = r_; } } while (0)
    const float fcv[2] = {exp2f(lg2 * (float)(63 - (tid0 >> 4))), exp2f(lg2 * (float)(31 - (tid0 >> 4)))};
    for (int i = tid; i < 65536 / 16; i += 512) *(LAS u32x4*)(lds + RT_ST + i * 16) = (u32x4){0u, 0u, 0u, 0u};
    RT_GLOAD(0); RT_LWRITE(0);
    __syncthreads();
    for (int cc = 0; cc <= 32; ++cc) {
        const bool more = cc < 32;
        tid = tid0; asm volatile("" : "+v"(tid)); lane = tid & 63; r32 = lane & 31; hi = lane >> 5;
        const unsigned h5 = lane >> 5, blk = (lane >> 4) & 1, q4 = (lane & 15) >> 2, p3 = lane & 3;
        if (more) RT_GLOAD(cc + 1);
        u32x2 gg[4];
        if (cc > 0) {
            const bf16_t* gp = c.b16(OFF_G1) + ((size_t)b * SEQ + 64 * (cc - 1) + 32 * wi + r32) * RMIX + h * RDV + sl * 128 + 32 * wdv + 4 * hi;
#pragma unroll
            for (int g = 0; g < 4; ++g) gg[g] = *(const u32x2*)(gp + 8 * g);
        }
        f32x16 P0, P1, acc;
#pragma unroll
        for (int r = 0; r < 16; ++r) { P0[r] = 0.f; P1[r] = 0.f; acc[r] = 0.f; }
#pragma unroll
        for (int s = 0; s < 16; ++s) {
            const unsigned hf = (s >> 3) * 16384, ch = 2 * (s & 7) + h5;
            const bf16x8 qf = *(const LAS bf16x8*)(lds + RT_Q + hf + off_b(32 * wi + r32, ch));
            const bf16x8 k0 = *(const LAS bf16x8*)(lds + RT_K + hf + off_b(r32, ch)), k1 = *(const LAS bf16x8*)(lds + RT_K + hf + off_b(32 + r32, ch));
            const bf16x8 sf = *(const LAS bf16x8*)(lds + RT_ST + (s >> 3) * 32768 + off_b(32 * wdv + r32, ch));
            P0 = __builtin_amdgcn_mfma_f32_32x32x16_bf16(k0, qf, P0, 0, 0, 0);
            P1 = __builtin_amdgcn_mfma_f32_32x32x16_bf16(k1, qf, P1, 0, 0, 0);
            acc = __builtin_amdgcn_mfma_f32_32x32x16_bf16(sf, qf, acc, 0, 0, 0);
        }
#pragma unroll
        for (int r = 0; r < 16; ++r) { const int j = crow(r, hi); if (j > il) P0[r] = 0.f; if (j + 32 > il) P1[r] = 0.f; acc[r] *= g64; }
        u32x4 pw[4];
#pragma unroll
        for (int e = 0; e < 4; ++e) { pw[0][e] = pk2(P0[2 * e], P0[2 * e + 1]); pw[1][e] = pk2(P0[8 + 2 * e], P0[9 + 2 * e]); pw[2][e] = pk2(P1[2 * e], P1[2 * e + 1]); pw[3][e] = pk2(P1[8 + 2 * e], P1[9 + 2 * e]); }
#pragma unroll
        for (int ks = 0; ks < 4; ++ks) {
            const unsigned chv = 4 * wdv + 2 * blk + (p3 >> 1);
            const bf16x8 vf = tr_pair(lds + RT_V + off_b(16 * ks + 4 * h5 + q4, chv) + 8 * (p3 & 1), lds + RT_V + off_b(16 * ks + 4 * h5 + 8 + q4, chv) + 8 * (p3 & 1));
            acc = __builtin_amdgcn_mfma_f32_32x32x16_bf16(vf, __builtin_bit_cast(bf16x8, pw[ks]), acc, 0, 0, 0);
        }
        if (cc > 0) {
            const size_t row = (size_t)b * SEQ + 64 * (cc - 1) + il;
            float ss = 0.f;
            bf16_t* orow = V1 + row * RMIX + 32 * wdv + 4 * hi;
#pragma unroll
            for (int g = 0; g < 4; ++g) {
                const f32x4 ov = (f32x4){acc[4 * g] * rowscale, acc[4 * g + 1] * rowscale, acc[4 * g + 2] * rowscale, acc[4 * g + 3] * rowscale};
                ss += ov[0] * ov[0] + ov[1] * ov[1] + ov[2] * ov[2] + ov[3] * ov[3];
                *(u32x2*)(orow + 8 * g) = pk4(ov * unpk4(gg[g]));
            }
            ss += __shfl_xor(ss, 32);
            if (hi == 0) osq[(row * 4 + h) * 16 + sl * 4 + wdv] = ss;
        }
        {
            const float gl = cc == 0 ? 1.f : g64;
#pragma unroll
            for (int a = 0; a < 2; ++a)
#pragma unroll
                for (int bb = 0; bb < 2; ++bb)
#pragma unroll
                    for (int r = 0; r < 16; ++r) S[a][bb][r] *= gl;
#pragma unroll
            for (int ks = 0; ks < 4; ++ks) {
                bf16x8 kf[2], vf[2];
#pragma unroll
                for (int a = 0; a < 2; ++a) {
                    const unsigned chk = 4 * (2 * (wk & 1) + a) + 2 * blk + (p3 >> 1), hfk = (wk >> 1) * 16384;
                    kf[a] = tr_pair(lds + RT_K + hfk + off_b(16 * ks + 8 * h5 + q4, chk) + 8 * (p3 & 1), lds + RT_K + hfk + off_b(16 * ks + 8 * h5 + 4 + q4, chk) + 8 * (p3 & 1));
                    const unsigned chv = 4 * (2 * wd + a) + 2 * blk + (p3 >> 1);
                    vf[a] = tr_pair(lds + RT_V + off_b(16 * ks + 8 * h5 + q4, chv) + 8 * (p3 & 1), lds + RT_V + off_b(16 * ks + 8 * h5 + 4 + q4, chv) + 8 * (p3 & 1));
                }
#pragma unroll
                for (int a = 0; a < 2; ++a)
#pragma unroll
                    for (int bb = 0; bb < 2; ++bb) S[a][bb] = __builtin_amdgcn_mfma_f32_32x32x16_bf16(kf[a], vf[bb], S[a][bb], 0, 0, 0);
            }
        }
        __syncthreads();
        if (more) {
#pragma unroll
            for (int a = 0; a < 2; ++a)
#pragma unroll
                for (int bb = 0; bb < 2; ++bb)
#pragma unroll
                    for (int g = 0; g < 4; ++g) {
                        const unsigned dvr = 64 * wd + 32 * bb + r32, chunk = 8 * (wk & 1) + 4 * a + g;
                        *(LAS u32x2*)(lds + RT_ST + (wk >> 1) * 32768 + off_b(dvr, chunk) + 8 * hi) = pk4((f32x4){S[a][bb][4 * g], S[a][bb][4 * g + 1], S[a][bb][4 * g + 2], S[a][bb][4 * g + 3]});
                    }
            RT_LWRITE(cc + 1);
        }
        __syncthreads();
    }
#undef RT_GLOAD
#undef RT_LWRITE
}
__device__ __forceinline__ void phase_ret_fast(const Ctx& c, LAS unsigned char* lds, int bid, int nb) {
    const int vcu = (nb % 8 == 0) ? (bid % 8) * (nb / 8) + bid / 8 : bid;
    for (int u = vcu; u < 256; u += nb) ret_unit(c, lds, u >> 4, (u >> 2) & 3, u & 3);
}
__device__ __forceinline__ void phase_gatepass(const Ctx& c, int bid, int nb) {
    const int tid = opaque_tid(), wid = tid >> 6, lane = tid & 63;
    const bf16_t* O = c.b16(OFF_V1); bf16_t* G1 = c.b16(OFF_G1); const float* osq = c.out;
    for (int row = bid * NWV + wid; row < MR; row += nb * NWV) {
        float sq = osq[(size_t)row * 64 + lane];
        sq += __shfl_xor(sq, 1); sq += __shfl_xor(sq, 2); sq += __shfl_xor(sq, 4); sq += __shfl_xor(sq, 8);
        const float rs = frsq(sq * (1.f / RDV) + LN_EPS);
#pragma unroll
        for (int k = 0; k < 4; ++k) {
            const float r = __shfl(rs, 16 * k);
            const size_t off = (size_t)row * RMIX + 512 * k + 8 * lane;
            const u32x4 ow = *(const u32x4*)(O + off), gw = *(const u32x4*)(G1 + off);
            u32x4 o;
            o.x = pk2(bf2f(gw.x & 0xffffu) * bf2f(ow.x & 0xffffu) * r, bf2f(gw.x >> 16) * bf2f(ow.x >> 16) * r);
            o.y = pk2(bf2f(gw.y & 0xffffu) * bf2f(ow.y & 0xffffu) * r, bf2f(gw.y >> 16) * bf2f(ow.y >> 16) * r);
            o.z = pk2(bf2f(gw.z & 0xffffu) * bf2f(ow.z & 0xffffu) * r, bf2f(gw.z >> 16) * bf2f(ow.z >> 16) * r);
            o.w = pk2(bf2f(gw.w & 0xffffu) * bf2f(ow.w & 0xffffu) * r, bf2f(gw.w >> 16) * bf2f(ow.w >> 16) * r);
            *(u32x4*)(G1 + off) = o;
        }
    }
}

__device__ __forceinline__ void phase_final(const Ctx& c, int bid, int nb) {
    const int tid = opaque_tid(), wid = tid >> 6, lane = tid & 63;
    const float* g = c.in[21] + 1024; const float* bv = c.in[22] + 1024;
    for (int row = bid * NWV + wid; row < MR; row += nb * NWV) {
        f32x4* zr = (f32x4*)(c.out + (size_t)row * DM) + lane;
        f32x4 v[4]; float s = 0.f;
#pragma unroll
        for (int j = 0; j < 4; ++j) { v[j] = zr[64 * j]; s += (v[j][0] + v[j][1]) + (v[j][2] + v[j][3]); }
        const float mean = wave_sum(s) * (1.f / DM); float s2 = 0.f;
#pragma unroll
        for (int j = 0; j < 4; ++j) { v[j] = v[j] - mean; s2 += (v[j][0] * v[j][0] + v[j][1] * v[j][1]) + (v[j][2] * v[j][2] + v[j][3] * v[j][3]); }
        const float rstd = frsq(wave_sum(s2) * (1.f / DM) + LN_EPS);
#pragma unroll
        for (int j = 0; j < 4; ++j) zr[64 * j] = v[j] * rstd * *(const f32x4*)(g + 256 * j + 4 * lane) + *(const f32x4*)(bv + 256 * j + 4 * lane);
    }
}


#define XB_TMO      128
#define XB_XCNT(j)  (256  + 64 * (j))
#define XB_XSUB(j)  (1280 + 64 * (j))
#define XB_XGEN(j)  (2304 + 64 * (j))
#define XB_TOP      3328
#define XB_TOPGEN   3392
#define XCD_BAR_WORDS 3456
#define XB_SPIN_CAP (1u << 18)
__device__ __forceinline__ unsigned xb_ld(unsigned* p)              { return __hip_atomic_load(p, __ATOMIC_RELAXED, __HIP_MEMORY_SCOPE_AGENT); }
__device__ __forceinline__ unsigned xb_add(unsigned* p, unsigned v) { return __hip_atomic_fetch_add(p, v, __ATOMIC_RELAXED, __HIP_MEMORY_SCOPE_AGENT); }
__device__ __forceinline__ unsigned xb_xcc_id() { return (unsigned)__builtin_amdgcn_s_getreg((3 << 11) | 20) & 0xFu; }
#define XB_SPIN(cond, bar) do { unsigned _sp = 0; while (cond) { __builtin_amdgcn_s_sleep(1); \
    if ((++_sp & 255u) == 0u) { if (xb_ld(&(bar)[XB_TMO])) break; if (_sp > XB_SPIN_CAP) { atomicAdd(&(bar)[XB_TMO], 1u); break; } } } } while (0)
struct XcdBarrier { unsigned* bar; unsigned x; volatile LAS unsigned* st; };
__device__ __forceinline__ XcdBarrier xcd_barrier_post(unsigned* bar, volatile LAS unsigned* st) {
    XcdBarrier b; b.bar = bar; b.x = xb_xcc_id(); b.st = st;
    if (threadIdx.x == 0) (void)xb_add(&bar[XB_XCNT(b.x)], 1u);
    return b;
}
__device__ __forceinline__ void xcd_barrier_complete(unsigned* bar, unsigned x, unsigned& nloc, unsigned& nx) {
    const unsigned G = gridDim.x * gridDim.y * gridDim.z;
    unsigned sum, cnt, mine, sp = 0u;
    for (;;) {
        sum = 0u; cnt = 0u; mine = 0u;
#pragma unroll
        for (unsigned j = 0; j < 16; ++j) { const unsigned c = xb_ld(&bar[XB_XCNT(j)]); sum += c; cnt += (c > 0u) ? 1u : 0u; mine = (j == x) ? c : mine; }
        if (sum == G) break;
        __builtin_amdgcn_s_sleep(1);
        if ((++sp & 255u) == 0u) { if (xb_ld(&bar[XB_TMO])) break; if (sp > XB_SPIN_CAP) { atomicAdd(&bar[XB_TMO], 1u); break; } }
    }
    nloc = mine > 0u ? mine : 1u; nx = cnt > 0u ? cnt : 1u;
}
__device__ __forceinline__ void xcd_barrier(const XcdBarrier& b) {
    asm volatile("s_waitcnt vmcnt(0)" ::: "memory");
    __syncthreads();
    if (threadIdx.x == 0) {
        unsigned* bar = b.bar;
        __builtin_amdgcn_s_waitcnt(0);
        unsigned nloc = b.st[0], nx = b.st[1];
        if (nloc == 0u) { xcd_barrier_complete(bar, b.x, nloc, nx); b.st[0] = nloc; b.st[1] = nx; }
        const unsigned old = xb_add(&bar[XB_XSUB(b.x)], 1u);
        const unsigned gen = old / nloc;
        if (old + 1u == (gen + 1u) * nloc) {
            __builtin_amdgcn_fence(__ATOMIC_RELEASE, "agent");
            asm volatile("s_waitcnt vmcnt(0)" ::: "memory");
            const unsigned og = xb_add(&bar[XB_TOP], 1u);
            const unsigned tg = og / nx;
            if (og + 1u == (tg + 1u) * nx) xb_add(&bar[XB_TOPGEN], 1u);
            else XB_SPIN(xb_ld(&bar[XB_TOPGEN]) == tg, bar);
            __builtin_amdgcn_fence(__ATOMIC_ACQUIRE, "agent");
            xb_add(&bar[XB_XGEN(b.x)], 1u);
            asm volatile("s_waitcnt vmcnt(0)" ::: "memory");
        } else {
            XB_SPIN(xb_ld(&bar[XB_XGEN(b.x)]) == gen, bar);
            __builtin_amdgcn_fence(__ATOMIC_ACQUIRE, "agent");
            asm volatile("s_waitcnt vmcnt(0)" ::: "memory");
        }
    }
    __syncthreads();
}

enum { PH_PRO = 0, PH_IN0, PH_PREP, PH_GATE, PH_ATTN, PH_OUT0, PH_UP0, PH_DOWN0, PH_IN1, PH_RET, PH_OUT1, PH_UP1, PH_DOWN1, NPH };
constexpr int LDS_MISC = 161792, LDS_BYTES = 163840;
static_assert(NPH == 13, "phase list");

__device__ __forceinline__ void run_phase(int ph, const Ctx& c, const Params& p, LAS unsigned char* lds, int bid, int nb) {
    const float* stA = c.f32(OFF_STATA); const float* stB = c.f32(OFF_STATB); const float* cv = c.f32(OFF_C12);
    switch (ph) {
#ifdef PROBE_PRO_SPLIT
    case PH_PRO: { unsigned long long* pts = (unsigned long long*)(c.ws + OFF_CTL + 32768); const bool st = bid == 0 && threadIdx.x == 0;
        if (st) pts[0] = __builtin_amdgcn_s_memrealtime();
        phase_prologue(c, p, lds, bid, nb, 1); cg::this_grid().sync();
        if (st) pts[1] = __builtin_amdgcn_s_memrealtime();
        phase_prologue(c, p, lds, bid, nb, 2); cg::this_grid().sync();
        if (st) pts[2] = __builtin_amdgcn_s_memrealtime(); } break;
#else
    case PH_PRO: phase_prologue(c, p, lds, bid, nb); break;
#endif
    case PH_IN0: {
        Gemm g{c.b16(OFF_XB), c.b16(OFF_WIN0), MR, N_IN0, 1024, 1024, 1024, 0};
        EpiIn0 e{c.b16(OFF_P0), c.f32(OFF_SSQQ), c.f32(OFF_SSQKV)};
        run_gemm(lds, g, e, bid, nb);
    } break;
    case PH_PREP: {
        phase_conv(c, bid, nb);
        { Gemm g{c.b16(OFF_P0) + 1024, c.b16(OFF_WUQ), MR, NQ, QRANK, N_IN0, QRANK, 0};
          EpiQup e{c.b16(OFF_Q), c.f32(OFF_SSQQ), c.f32(OFF_ROPE0C), c.f32(OFF_ROPE0S)}; run_gemm(lds, g, e, bid, nb); }
        { Gemm g{c.b16(OFF_P0) + 1280, c.b16(OFF_WUKV), MR, 1024, KVRANK, N_IN0, KVRANK, 0};
          EpiKVup e{c.b16(OFF_K), c.b16(OFF_V), c.f32(OFF_SSQKV)}; run_gemm(lds, g, e, bid, nb); }
    } break;
    case PH_GATE: {
        Gemm g{c.b16(OFF_XC), c.b16(OFF_WGATE), MR, 1024, 128, LRUW, 128, 128};
        EpiGate e{c, c.b16(OFF_XC), c.f32(OFF_CCH), c.in[6], c.in[8]};
        run_gemm(lds, g, e, bid, nb);
        scan1_local(c, bid, nb);
    } break;
#if FAST_ATTN
    case PH_ATTN: phase_scan2(c, bid, nb); phase_attn_naive(c, bid, nb, true); phase_attn_fast(c, lds, bid, nb); break;
#else
    case PH_ATTN: phase_scan2(c, bid, nb); phase_attn_naive(c, bid, nb, false); break;
#endif
    case PH_OUT0: {
        Gemm g{c.b16(OFF_MIX), c.b16(OFF_WOUT0), MR, 1024, 1024, 1024, 1024, 0};
        EpiRes<0, false> e{c, c.b16(OFF_ZB), nullptr, c.f32(OFF_STATA), nullptr, nullptr, (const float*)c.b16(OFF_XB), nullptr};
        run_gemm(lds, g, e, bid, nb);
    } break;
    case PH_UP0: {
        Gemm g{c.b16(OFF_ZB), c.b16(OFF_W1_0), MR, FF, 1024, 1024, 1024, 0};
        EpiMlpUp e{{stA, cv + C1_UP0, cv + C2_UP0}, c.b16(OFF_HID)};
        run_gemm(lds, g, e, bid, nb);
#ifdef PROBE_NULLGEMM
        { EpiNull en; run_gemm(lds, g, en, bid, nb, false); }
#endif
    } break;
    case PH_DOWN0: {
        Gemm g{c.b16(OFF_HID), c.b16(OFF_W2_0), MR, 1024, FF, FF, FF, 0};
        EpiRes<1, false> e{c, c.b16(OFF_ZB), stA, c.f32(OFF_STATB), c.in[17], c.in[18], nullptr, nullptr};
        run_gemm(lds, g, e, bid, nb);
    } break;
    case PH_IN1: {
        Gemm g{c.b16(OFF_ZB), c.b16(OFF_WIN1), MR, N_IN1, 1024, 1024, 1024, 0};
        EpiIn1 e{{stB, cv + C1_IN1, cv + C2_IN1}, c.b16(OFF_Q1), c.b16(OFF_K1), c.b16(OFF_V1), c.b16(OFF_G1), c.f32(OFF_ROPE1C), c.f32(OFF_ROPE1S)};
        run_gemm(lds, g, e, bid, nb, true, 4, 16);
#ifdef PROBE_NULLGEMM2
        { EpiNull en; run_gemm(lds, g, en, bid, nb, false); }
#endif
    } break;
#if FAST_RET
    case PH_RET: phase_ret_fast(c, lds, bid, nb); break;
#else
    case PH_RET: phase_ret_naive(c, lds, bid, nb); break;
#endif
    case PH_OUT1: {
        Gemm g{c.b16(OFF_V1), c.b16(OFF_WOUT1), MR, 1024, RMIX, RMIX, RMIX, 0};
        EpiResRho e{{c, c.b16(OFF_ZB), stB, c.f32(OFF_STATA), c.in[21], c.in[22], nullptr, nullptr}, c.out};
        run_gemm(lds, g, e, bid, nb, false);
    } break;
    case PH_UP1: {
        Gemm g{c.b16(OFF_ZB), c.b16(OFF_W1_1), MR, FF, 1024, 1024, 1024, 0};
        EpiMlpUp e{{stA, cv + C1_UP1, cv + C2_UP1}, c.b16(OFF_HID)};
        run_gemm(lds, g, e, bid, nb, false);
    } break;
    case PH_DOWN1: {
        Gemm g{c.b16(OFF_HID), c.b16(OFF_W2_1), MR, 1024, FF, FF, FF, 0};
        EpiFinal e{{c, c.b16(OFF_ZB), stA, nullptr, c.in[17] + 1024, c.in[18] + 1024, nullptr, nullptr}, (unsigned long long*)(c.ws + OFF_ZMETA), (unsigned*)(c.ws + OFF_CTL + 32768), c.in[21] + 1024, c.in[22] + 1024};
        run_gemm(lds, g, e, bid, nb, false);
    } break;
    default: break;
    }
}

#if N_LAUNCH_MODE == 1
__global__ void __launch_bounds__(512, 2) k_fwd(Params p) {
    extern __shared__ __attribute__((aligned(16))) unsigned char lds_raw[];
    LAS unsigned char* lds = (LAS unsigned char*)lds_raw;
    Ctx c{p.in, p.out, p.ws};
    const int bid = blockIdx.x, nb = gridDim.x;
    const int lo = (int)p.ph_lo, hi = (int)p.ph_hi;
    volatile LAS unsigned* misc = (volatile LAS unsigned*)(lds + LDS_MISC);
    if (threadIdx.x < 64) misc[threadIdx.x] = 0u;
    __syncthreads();
    const XcdBarrier bar = xcd_barrier_post((unsigned*)(p.ws + OFF_CTL) + 1024, misc);
#ifdef PROBE_PHASE
    unsigned long long pt0 = 0, pt1 = 0;
#define PROBE_T0(k) if ((k) == PROBE_PHASE) pt0 = __builtin_amdgcn_s_memrealtime();
#define PROBE_T1(k) if ((k) == PROBE_PHASE) pt1 = __builtin_amdgcn_s_memrealtime();
#else
#define PROBE_T0(k)
#define PROBE_T1(k)
#endif
#define PHASE(k) if (lo <= (k) && (k) < hi) { PROBE_T0(k) run_phase((k), c, p, lds, bid, nb); if ((k) + 1 < hi) { if (hi > 1000) cg::this_grid().sync(); else xcd_barrier(bar); } PROBE_T1(k) }
    PHASE(0) PHASE(1) PHASE(2) PHASE(3) PHASE(4) PHASE(5) PHASE(6) PHASE(7) PHASE(8) PHASE(9) PHASE(10) PHASE(11) PHASE(12)
#undef PHASE
#ifdef PROBE_PRO_SPLIT
    if (bid == 0 && threadIdx.x == 0) { volatile unsigned long long* pts = (volatile unsigned long long*)(p.ws + OFF_CTL + 32768); const unsigned long long te = __builtin_amdgcn_s_memrealtime(), w = 16ull * (pts[PROBE_PRO_SPLIT] - pts[PROBE_PRO_SPLIT - 1]); while (__builtin_amdgcn_s_memrealtime() - te < w) __builtin_amdgcn_s_sleep(32); }
#endif
#ifdef PROBE_PHASE
    if (bid == 0 && threadIdx.x == 0) { const unsigned long long te = __builtin_amdgcn_s_memrealtime(), w = 16ull * (pt1 - pt0); while (__builtin_amdgcn_s_memrealtime() - te < w) __builtin_amdgcn_s_sleep(32); }
#endif
}
#else
template <int PH> __global__ void __launch_bounds__(512, 2) k_one(Params p) {
    extern __shared__ __attribute__((aligned(16))) unsigned char lds_raw[];
    LAS unsigned char* lds = (LAS unsigned char*)lds_raw;
    Ctx c{p.in, p.out, p.ws};
    run_phase(PH, c, p, lds, blockIdx.x, gridDim.x);
}
template <int PH> static void launch_one(int grid, const Params& p, hipStream_t stream) {
    static bool attr = false;
    if (!attr) { (void)hipFuncSetAttribute((const void*)k_one<PH>, hipFuncAttributeMaxDynamicSharedMemorySize, LDS_BYTES); attr = true; }
    hipLaunchKernelGGL(k_one<PH>, dim3(grid), dim3(512), LDS_BYTES, stream, p);
}
#endif

extern "C" void kernel_launch(void* const* d_in, const int* in_sizes, int n_in, void* d_out, int out_size, void* d_ws, size_t ws_size, hipStream_t stream) {
    static int grid = 0;
    if (grid == 0) {
        int dev = 0, cus = 0;
        if (hipGetDevice(&dev) != hipSuccess || hipDeviceGetAttribute(&cus, hipDeviceAttributeMultiprocessorCount, dev) != hipSuccess) { grid = -1; return; }
#if N_LAUNCH_MODE == 1
        if (hipFuncSetAttribute((const void*)k_fwd, hipFuncAttributeMaxDynamicSharedMemorySize, LDS_BYTES) != hipSuccess) { grid = -1; return; }
        int per_cu = 0;
        if (hipOccupancyMaxActiveBlocksPerMultiprocessor(&per_cu, (const void*)k_fwd, 512, LDS_BYTES) != hipSuccess || per_cu < 1) { fprintf(stderr, "occupancy query: %d\n", per_cu); }
        (void)hipGetLastError();
#endif
        grid = 256;
        if (cus < 256) { fprintf(stderr, "kernel_launch: %d CUs < 256\n", cus); grid = -1; return; }
        if (n_in != 23 || ws_size < WS_END) { fprintf(stderr, "kernel_launch: unexpected n_in %d / ws %zu\n", n_in, ws_size); grid = -1; return; }
    }
    if (grid < 0) return;
    (void)hipMemsetAsync((char*)d_ws + OFF_CTL, 0, SZ_CTL, stream);
    (void)hipMemsetAsync((char*)d_ws + OFF_C12, 0, 128 * KB, stream);
    Params p{};
    for (int i = 0; i < 23; ++i) p.in[i] = (const float*)d_in[i];
    p.out = (float*)d_out; p.ws = (unsigned char*)d_ws;
    for (int j = 0; j < 16; ++j) p.inv0[j] = pow(10000.0, -(double)j / 16.0);
    for (int j = 0; j < 128; ++j) p.inv1[j] = pow(10000.0, -(double)j / 128.0);
#if N_LAUNCH_MODE == 1
    p.ph_lo = 0; p.ph_hi = NPH;
    void* args[] = {&p};
    hipError_t e = hipLaunchCooperativeKernel((const void*)k_fwd, dim3(grid), dim3(512), args, LDS_BYTES, stream);
    if (e != hipSuccess) fprintf(stderr, "cooperative launch failed: %s (grid %d)\n", hipGetErrorString(e), grid);
#else
    launch_one<0>(grid, p, stream); launch_one<1>(grid, p, stream); launch_one<2>(grid, p, stream); launch_one<3>(grid, p, stream); launch_one<4>(grid, p, stream);
    launch_one<5>(grid, p, stream); launch_one<6>(grid, p, stream); launch_one<7>(grid, p, stream); launch_one<8>(grid, p, stream); launch_one<9>(grid, p, stream);
    launch_one<10>(grid, p, stream); launch_one<11>(grid, p, stream); launch_one<12>(grid, p, stream);
#endif
}
```

```cpp
#include <hip/hip_runtime.h>
#include <hip/hip_cooperative_groups.h>
#include <stdint.h>
#include <stdio.h>
namespace cg = cooperative_groups;

#ifndef FAST_GEMM
#define FAST_GEMM 1
#endif
#ifndef FAST_ATTN
#define FAST_ATTN 1
#endif
#ifndef FAST_RET
#define FAST_RET 1
#endif
#ifndef N_LAUNCH_MODE
#define N_LAUNCH_MODE 1
#endif

#define LAS __attribute__((address_space(3)))
typedef unsigned short bf16_t;
typedef short bf16x8 __attribute__((ext_vector_type(8)));
typedef float f32x4 __attribute__((ext_vector_type(4)));
typedef float f32x2 __attribute__((ext_vector_type(2)));
typedef unsigned u32x4 __attribute__((ext_vector_type(4)));
typedef unsigned u32x2 __attribute__((ext_vector_type(2)));
typedef __bf16 bf16x2_t __attribute__((ext_vector_type(2)));

constexpr int DM = 1024, NBATCH = 16, SEQ = 2048, NMETA = 16, TT = SEQ + NMETA;
constexpr int MR = NBATCH * SEQ;
constexpr int MP = MR + 256;
constexpr int LRUW = 512, EVEN_IN = 1440, N_IN0 = 1536, QRANK = 256, KVRANK = 128;
constexpr int MLA_H = 8, QKD = 96, VD = 64, NQ = MLA_H * QKD  , NV = MLA_H * VD  ;
constexpr int FF = 4096, N_IN1 = 6144, RET_H = 4, RDK = 256, RDV = 512, RMIX = 2048;
constexpr float LN_EPS = 1e-5f;
constexpr float DN_ALPHA = 1.41421356237309515f;
constexpr float QSCALE = 0.10206207261596575f * 1.4426950408889634f;

constexpr size_t KB = 1024, MB = 1024 * 1024;
constexpr size_t OFF_CTL = 0;
constexpr size_t SZ_CTL = 64 * KB;
constexpr size_t OFF_ROPE0C = OFF_CTL + SZ_CTL;
constexpr size_t OFF_ROPE0S = OFF_ROPE0C + 132 * KB;
constexpr size_t OFF_ROPE1C = OFF_ROPE0S + 132 * KB;
constexpr size_t OFF_ROPE1S = OFF_ROPE1C + 1056 * KB;
constexpr size_t OFF_CCH = OFF_ROPE1S + 1056 * KB;
constexpr size_t OFF_C12 = OFF_CCH + 4 * KB;
constexpr size_t OFF_SSQQ = OFF_C12 + 128 * KB;
constexpr size_t OFF_SSQKV = OFF_SSQQ + 528 * KB;
constexpr size_t OFF_STATA = OFF_SSQKV + 528 * KB;
constexpr size_t OFF_STATB = OFF_STATA + (size_t)MP * 128;
constexpr size_t OFF_ZMETA = OFF_STATB + (size_t)MP * 128;
constexpr size_t OFF_ABMETA = OFF_ZMETA + MB;
constexpr size_t OFF_CARRY = OFF_ABMETA + MB;
constexpr size_t OFF_W = 18 * MB;
static_assert(OFF_CARRY + 2 * MB <= OFF_W, "small buffers");
constexpr size_t OFF_WIN1 = OFF_W;
constexpr size_t OFF_WOUT1 = OFF_WIN1 + (size_t)6144 * 1024 * 2;
constexpr size_t OFF_W1_1 = OFF_WOUT1 + (size_t)2048 * 1024 * 2;
constexpr size_t OFF_W2_1 = OFF_W1_1 + (size_t)4096 * 1024 * 2;
constexpr size_t OFF_BIG = 50 * MB;
static_assert(OFF_W2_1 + (size_t)4096 * 1024 * 2 <= OFF_BIG, "weights");
constexpr size_t SZ_ROW1K = (size_t)MP * 1024 * 2;
constexpr size_t OFF_XB = OFF_BIG;
constexpr size_t OFF_P0 = OFF_XB + SZ_ROW1K;
constexpr size_t OFF_Q = OFF_P0 + (size_t)MP * 1536 * 2;
constexpr size_t OFF_K = OFF_Q + (size_t)MP * 768 * 2;
constexpr size_t OFF_V = OFF_K + (size_t)MP * 768 * 2;
constexpr size_t OFF_XC = OFF_V + (size_t)MP * 512 * 2;
constexpr size_t OFF_MIX = OFF_XC;
constexpr size_t OFF_HID = OFF_BIG;
constexpr size_t OFF_Q1 = OFF_BIG;
constexpr size_t OFF_K1 = OFF_Q1 + SZ_ROW1K;
constexpr size_t OFF_V1 = OFF_K1 + SZ_ROW1K;
constexpr size_t OFF_G1 = OFF_V1 + 2 * SZ_ROW1K;
constexpr size_t OFF_W0 = 415 * MB;
constexpr size_t OFF_WIN0 = OFF_W0;
constexpr size_t OFF_WGATE = OFF_WIN0 + (size_t)N_IN0 * 1024 * 2;
constexpr size_t OFF_WUQ = OFF_WGATE + 1024 * 128 * 2;
constexpr size_t OFF_WUKV = OFF_WUQ + 768 * 256 * 2;
constexpr size_t OFF_WOUT0 = OFF_WUKV + 1024 * 128 * 2;
constexpr size_t OFF_W1_0 = OFF_WOUT0 + 1024 * 1024 * 2;
constexpr size_t OFF_W2_0 = OFF_W1_0 + (size_t)4096 * 1024 * 2;
constexpr size_t OFF_ZB = 438 * MB;
constexpr size_t WS_END = 504 * MB;
static_assert(OFF_MIX + SZ_ROW1K <= OFF_W0 && OFF_HID + (size_t)MP * 4096 * 2 <= OFF_W0 && OFF_G1 + 2 * SZ_ROW1K <= OFF_ZB && OFF_W2_0 + (size_t)4096 * 1024 * 2 <= OFF_ZB && OFF_ZB + SZ_ROW1K <= WS_END, "ws map");

struct Params { const float* in[23]; float* out; unsigned char* ws; long long ph_lo, ph_hi; double inv0[16]; double inv1[128]; };

__device__ __forceinline__ int opaque_tid() { int t = threadIdx.x; asm volatile("" : "+v"(t)); return t; }
__device__ __forceinline__ float bf2f(unsigned v) { return __uint_as_float(v << 16); }
__device__ __forceinline__ unsigned pk2(float lo, float hi) { f32x2 v = {lo, hi}; bf16x2_t b = __builtin_convertvector(v, bf16x2_t); return __builtin_bit_cast(unsigned, b); }
__device__ __forceinline__ u32x2 pk4(f32x4 v) { u32x2 r; r.x = pk2(v[0], v[1]); r.y = pk2(v[2], v[3]); return r; }
__device__ __forceinline__ f32x4 unpk4(u32x2 w) { return (f32x4){bf2f(w.x & 0xffffu), bf2f(w.x >> 16), bf2f(w.y & 0xffffu), bf2f(w.y >> 16)}; }
__device__ __forceinline__ float bfround(float x) { return bf2f(pk2(x, 0.f) & 0xffffu); }
__device__ __forceinline__ float wave_sum(float v) {
#pragma unroll
    for (int o = 1; o < 64; o <<= 1) v += __shfl_xor(v, o);
    return v;
}
__device__ __forceinline__ float wave_max(float v) {
#pragma unroll
    for (int o = 1; o < 64; o <<= 1) v = fmaxf(v, __shfl_xor(v, o));
    return v;
}
__device__ __forceinline__ float frcp(float x) { return __builtin_amdgcn_rcpf(x); }
__device__ __forceinline__ float frsq(float x) { return __builtin_amdgcn_rsqf(x); }
__device__ __forceinline__ float fsqrt(float x) { return __builtin_amdgcn_sqrtf(x); }
__device__ __forceinline__ float sigmoidf_(float x) { return frcp(1.f + __expf(-x)); }
__device__ __forceinline__ float gelu_tanh(float x) { const float u = 0.7978845608028654f * (x + 0.044715f * x * x * x); const float t = 1.f - 2.f * frcp(1.f + __expf(2.f * u)); return 0.5f * x * (1.f + t); }
__device__ __forceinline__ int row_pos(int row) { return row < MR ? NMETA + (row & (SEQ - 1)) : (row - MR); }

struct Ctx {
    const float* const* in; float* out; unsigned char* ws;
    __device__ __forceinline__ bf16_t* b16(size_t off) const { return (bf16_t*)(ws + off); }
    __device__ __forceinline__ float* f32(size_t off) const { return (float*)(ws + off); }
    __device__ __forceinline__ unsigned* abrow(int row) const { return row < MR ? (unsigned*)out + (size_t)row * LRUW : (unsigned*)f32(OFF_ABMETA) + (size_t)(row - MR) * LRUW; }
};

struct Gemm { const bf16_t* A; const bf16_t* Bt; int M, N, K, lda, ldb, a_pn_off; };

__device__ __forceinline__ void row_stats(const float* st, int row, int fq, float& mean, float& rstd) {
    const f32x4* p = (const f32x4*)(st + (size_t)row * 32 + fq * 8);
    const f32x4 a = p[0], b = p[1];
    float s1 = a[0] + a[2] + b[0] + b[2], s2 = a[1] + a[3] + b[1] + b[3];
    s1 += __shfl_xor(s1, 16); s2 += __shfl_xor(s2, 16); s1 += __shfl_xor(s1, 32); s2 += __shfl_xor(s2, 32);
    mean = s1 * (1.f / DM); const float var = fmaxf(s2 * (1.f / DM) - mean * mean, 0.f); rstd = frsq(var + LN_EPS);
}
__device__ __forceinline__ void put_stats(float* st, int row, int pn, int q0, const f32x4 (&v)[2][2]) {
    float s1 = 0.f, s2 = 0.f;
#pragma unroll
    for (int bj = 0; bj < 2; ++bj)
#pragma unroll
        for (int n = 0; n < 2; ++n)
#pragma unroll
            for (int e = 0; e < 4; ++e) { s1 += v[bj][n][e]; s2 += v[bj][n][e] * v[bj][n][e]; }
    s1 += __shfl_xor(s1, 16); s2 += __shfl_xor(s2, 16); s1 += __shfl_xor(s1, 32); s2 += __shfl_xor(s2, 32);
    if (((q0 >> 2) & 7) == 0) *(f32x2*)(st + (size_t)row * 32 + (pn * 4 + (q0 >> 5)) * 2) = (f32x2){s1, s2};
}

constexpr int ROT_OFF = 131072 + 12 * 2048;
struct RowS { float a, b; };
struct NoCol {}; struct NoRow {};
__device__ __forceinline__ u32x4 pk8(f32x4 a, f32x4 b) { u32x4 r; r.x = pk2(a[0], a[1]); r.y = pk2(a[2], a[3]); r.z = pk2(b[0], b[1]); r.w = pk2(b[2], b[3]); return r; }
__device__ __forceinline__ void unpk8(u32x4 w, f32x4& a, f32x4& b) { a = (f32x4){bf2f(w.x & 0xffffu), bf2f(w.x >> 16), bf2f(w.y & 0xffffu), bf2f(w.y >> 16)}; b = (f32x4){bf2f(w.z & 0xffffu), bf2f(w.z >> 16), bf2f(w.w & 0xffffu), bf2f(w.w >> 16)}; }
__device__ __forceinline__ void put_stats8(float* st, int row, int pn, int wc, int fq, const f32x4 (&v)[2][2]) {
    float s1 = 0.f, s2 = 0.f;
#pragma unroll
    for (int bj = 0; bj < 2; ++bj)
#pragma unroll
        for (int n = 0; n < 2; ++n)
#pragma unroll
            for (int e = 0; e < 4; ++e) { s1 += v[bj][n][e]; s2 += v[bj][n][e] * v[bj][n][e]; }
    s1 += __shfl_xor(s1, 16); s2 += __shfl_xor(s2, 16); s1 += __shfl_xor(s1, 32); s2 += __shfl_xor(s2, 32);
    if (fq == 0) *(f32x2*)(st + (size_t)row * 32 + (pn * 4 + wc) * 2) = (f32x2){s1, s2};
}

struct EpiIn0 {
    static constexpr bool HAS_INIT = false, PERM = true, ROW_AHEAD = true, USE_TAB = false;
    typedef NoCol ColS; typedef NoRow RowL;
    bf16_t* p0; float* ssq_q; float* ssq_kv;
    __device__ __forceinline__ ColS cols(int, int, int) const { return ColS{}; }
    __device__ __forceinline__ RowS pre(int, int) const { return RowS{0.f, 0.f}; }
    __device__ __forceinline__ RowL rload(int, int, int, int) const { return RowL{}; }
    __device__ __forceinline__ void apply(int row, int pn, int wc, int fq, f32x4 (&v)[2][2], RowS, const ColS&, const RowL&) const {
        bf16_t* base = p0 + (size_t)row * N_IN0 + 256 * pn + 32 * wc + 8 * fq;
#pragma unroll
        for (int bj = 0; bj < 2; ++bj) *(u32x4*)(base + 128 * bj) = pk8(v[bj][0], v[bj][1]);
        if (pn == 4 || pn == 5) {
            float s = 0.f;
#pragma unroll
            for (int n = 0; n < 2; ++n)
#pragma unroll
                for (int e = 0; e < 4; ++e) { s += v[0][n][e] * v[0][n][e]; if (pn == 4) s += v[1][n][e] * v[1][n][e]; }
            s += __shfl_xor(s, 16); s += __shfl_xor(s, 32);
            if (fq == 0) (pn == 4 ? ssq_q : ssq_kv)[(size_t)row * 4 + wc] = s;
        }
    }
};
struct EpiQup {
    static constexpr bool HAS_INIT = false, PERM = true, ROW_AHEAD = true, USE_TAB = false;
    typedef NoCol ColS; struct RowL { f32x4 c[2], s[2]; };
    bf16_t* Q; const float* ssq_q; const float* rc; const float* rs;
    __device__ __forceinline__ ColS cols(int, int, int) const { return ColS{}; }
    __device__ __forceinline__ RowS pre(int row, int) const { const f32x4 sq = *(const f32x4*)(ssq_q + (size_t)row * 4); return RowS{frsq((sq[0] + sq[1] + sq[2] + sq[3]) * (1.f / QRANK) + LN_EPS) * QSCALE, 0.f}; }
    __device__ __forceinline__ RowL rload(int row, int, int, int fq) const { const int pos = row_pos(row); const float* pc = rc + pos * 16 + 8 * (fq & 1); const float* ps = rs + pos * 16 + 8 * (fq & 1);
        RowL l; l.c[0] = *(const f32x4*)pc; l.c[1] = *(const f32x4*)(pc + 4); l.s[0] = *(const f32x4*)ps; l.s[1] = *(const f32x4*)(ps + 4);
        if (fq < 2) { l.s[0] = -l.s[0]; l.s[1] = -l.s[1]; }
        return l; }
    static constexpr bool ROT = true;
    __device__ __forceinline__ void rot_build(LAS unsigned char* lds, int tid) const {
        if (tid < 128) { LAS float* t = (LAS float*)(lds + ROT_OFF); const int sg = tid >> 6, st = (tid >> 5) & 1, isn = (tid >> 4) & 1, j = tid & 15, pos = st ? 80 : 16;
            const float val = isn ? rs[pos * 16 + j] : rc[pos * 16 + j]; t[tid] = (isn && sg == 0) ? -val : val; }
    }
    __device__ __forceinline__ void rot_step(RowL& l, int which, LAS unsigned char* lds, int, int fq) const {
        const LAS float* t = (const LAS float*)(lds + ROT_OFF) + (fq < 2 ? 0 : 64) + which * 32 + 8 * (fq & 1);
#pragma unroll
        for (int n = 0; n < 2; ++n) { const f32x4 cd = *(const LAS f32x4*)(t + 4 * n), sd = *(const LAS f32x4*)(t + 16 + 4 * n);
            const f32x4 nc = l.c[n] * cd - l.s[n] * sd, ns = l.s[n] * cd + l.c[n] * sd; l.c[n] = nc; l.s[n] = ns; }
    }
    __device__ __forceinline__ void apply(int row, int pn, int wc, int fq, f32x4 (&v)[2][2], RowS rsv, const ColS&, const RowL& rl) const {
        const float r = rsv.a;
#pragma unroll
        for (int bj = 0; bj < 2; ++bj) {
            f32x4 x[2] = {v[bj][0] * r, v[bj][1] * r};
            const int G = 8 * pn + 4 * bj + wc;
            if ((G % 3) == 2) {
#pragma unroll
                for (int n = 0; n < 2; ++n) { f32x4 pr;
#pragma unroll
                    for (int e = 0; e < 4; ++e) { const u32x2 sw = __builtin_amdgcn_permlane32_swap(__float_as_uint(x[n][e]), __float_as_uint(x[n][e]), false, false); pr[e] = __uint_as_float(fq < 2 ? sw.y : sw.x); }
                    x[n] = x[n] * rl.c[n] + pr * rl.s[n]; }
            }
            *(u32x4*)(Q + (size_t)row * NQ + 256 * pn + 128 * bj + 32 * wc + 8 * fq) = pk8(x[0], x[1]);
        }
    }
};
struct EpiKVup {
    static constexpr bool HAS_INIT = false, PERM = true, ROW_AHEAD = true, USE_TAB = false;
    typedef NoCol ColS; typedef NoRow RowL;
    bf16_t* K; bf16_t* V; const float* ssq_kv;
    __device__ __forceinline__ ColS cols(int, int, int) const { return ColS{}; }
    __device__ __forceinline__ RowS pre(int row, int) const { const f32x4 sq = *(const f32x4*)(ssq_kv + (size_t)row * 4); return RowS{frsq((sq[0] + sq[1] + sq[2] + sq[3]) * (1.f / KVRANK) + LN_EPS), 0.f}; }
    __device__ __forceinline__ RowL rload(int, int, int, int) const { return RowL{}; }
    __device__ __forceinline__ void apply(int row, int pn, int wc, int fq, f32x4 (&v)[2][2], RowS rsv, const ColS&, const RowL&) const {
        const float r = rsv.a; const int within = 32 * wc + 8 * fq;
#pragma unroll
        for (int bj = 0; bj < 2; ++bj) {
            const int head = 2 * pn + bj;
            bf16_t* dst = (wc < 2) ? K + (size_t)row * NQ + head * QKD + within : V + (size_t)row * NV + head * VD + (within - 64);
            *(u32x4*)dst = pk8(v[bj][0] * r, v[bj][1] * r);
        }
    }
};
struct EpiGate {
    static constexpr bool HAS_INIT = false, PERM = true, ROW_AHEAD = true, USE_TAB = false;
    struct ColS { f32x4 cc[2], va[2], vx[2]; }; struct RowL { u32x4 x; };
    Ctx c; const bf16_t* xc; const float* cch; const float* ba; const float* bx;
    __device__ __forceinline__ ColS cols(int pn, int wc, int fq) const { ColS k;
#pragma unroll
        for (int n = 0; n < 2; ++n) { const int ch = 128 * pn + 32 * wc + 8 * fq + 4 * n; k.cc[n] = *(const f32x4*)(cch + ch); k.va[n] = *(const f32x4*)(ba + ch); k.vx[n] = *(const f32x4*)(bx + ch); }
        return k; }
    __device__ __forceinline__ RowS pre(int, int) const { return RowS{0.f, 0.f}; }
    __device__ __forceinline__ RowL rload(int row, int pn, int wc, int fq) const { return RowL{*(const u32x4*)(xc + (size_t)row * LRUW + 128 * pn + 32 * wc + 8 * fq)}; }
    __device__ __forceinline__ void apply(int row, int pn, int wc, int fq, f32x4 (&v)[2][2], RowS, const ColS& k, const RowL& l) const {
        unsigned* abr = c.abrow(row);
        f32x4 xv[2]; unpk8(l.x, xv[0], xv[1]);
#pragma unroll
        for (int n = 0; n < 2; ++n) {
            const int ch = 128 * pn + 32 * wc + 8 * fq + 4 * n;
            u32x4 o;
#pragma unroll
            for (int e = 0; e < 4; ++e) {
                const float r = sigmoidf_(v[0][n][e] + k.va[n][e]), ig = sigmoidf_(v[1][n][e] + k.vx[n][e]);
                const float la = k.cc[n][e] * r;
                const float ds = -la * (1.f + la * (0.5f + la * (1.f / 6 + la * (1.f / 24 + la * (1.f / 120)))));
                const float d = la > -0.25f ? ds : 1.f - __expf(la);
                o[e] = pk2(d, fsqrt(fmaxf(d * (2.f - d), 0.f)) * (ig * xv[n][e]));
            }
            *(u32x4*)(abr + ch) = o;
        }
    }
};
template <int MODE, bool LAST> struct EpiRes {
    static constexpr bool HAS_INIT = true, PERM = true, ROW_AHEAD = true, USE_TAB = (MODE == 1);
    typedef NoCol ColS; typedef NoRow RowL; struct ColI { f32x4 g[2][2], b[2][2]; };
    Ctx c; bf16_t* zb; const float* st_in; float* st_out; const float* g; const float* b; const float* x; const float* meta;
    __device__ __forceinline__ ColI colsi(int pn, int wc, int fq) const { ColI k;
#pragma unroll
        for (int bj = 0; bj < 2; ++bj)
#pragma unroll
            for (int n = 0; n < 2; ++n) { const int col = 256 * pn + 128 * bj + 32 * wc + 8 * fq + 4 * n;
                if (MODE == 1) { k.g[bj][n] = *(const f32x4*)(g + col); k.b[bj][n] = *(const f32x4*)(b + col); } else { k.g[bj][n] = (f32x4){0.f, 0.f, 0.f, 0.f}; k.b[bj][n] = k.g[bj][n]; } }
        return k; }
    __device__ __forceinline__ RowS prei(int row, int fq) const { RowS r{0.f, 0.f}; if (MODE == 1) row_stats(st_in, row, fq, r.a, r.b); return r; }
    __device__ __forceinline__ void init_row(int row, int pn, int wc, int fq, f32x4 (&v)[2][2], RowS rsv, const ColI& k) const {
        const int cb = 256 * pn + 32 * wc + 8 * fq;
        if (MODE == 1) {
#pragma unroll
            for (int bj = 0; bj < 2; ++bj) { f32x4 z0, z1; unpk8(*(const u32x4*)(zb + (size_t)row * DM + cb + 128 * bj), z0, z1);
                v[bj][0] = ((z0 - rsv.a) * rsv.b * k.g[bj][0] + k.b[bj][0]) * DN_ALPHA; v[bj][1] = ((z1 - rsv.a) * rsv.b * k.g[bj][1] + k.b[bj][1]) * DN_ALPHA; }
        } else {
            const bf16_t* src = (const bf16_t*)x + (size_t)row * DM + cb;
#pragma unroll
            for (int bj = 0; bj < 2; ++bj) { f32x4 z0, z1; unpk8(*(const u32x4*)(src + 128 * bj), z0, z1); v[bj][0] = z0 * DN_ALPHA; v[bj][1] = z1 * DN_ALPHA; }
        }
    }
    __device__ __forceinline__ ColS cols(int, int, int) const { return ColS{}; }
    __device__ __forceinline__ RowS pre(int, int) const { return RowS{0.f, 0.f}; }
    __device__ __forceinline__ RowL rload(int, int, int, int) const { return RowL{}; }
    __device__ __forceinline__ void apply(int row, int pn, int wc, int fq, f32x4 (&v)[2][2], RowS, const ColS&, const RowL&) const {
        const int cb = 256 * pn + 32 * wc + 8 * fq;
#pragma unroll
        for (int bj = 0; bj < 2; ++bj) {
            if (LAST) { float* zr = c.out + (size_t)row * DM + cb + 128 * bj; *(f32x4*)zr = v[bj][0]; *(f32x4*)(zr + 4) = v[bj][1]; }
            else *(u32x4*)(zb + (size_t)row * DM + cb + 128 * bj) = pk8(v[bj][0], v[bj][1]);
        }
        if (!LAST) put_stats8(st_out, row, pn, wc, fq, v);
    }
};
struct EpiResRho : EpiRes<1, false> { static constexpr bool KHOOK = true; const float* osq; };
struct EpiFinal : EpiRes<1, true> { static constexpr bool FUSED_LN = true; unsigned long long* xbuf; unsigned* cnt; const float* gF; const float* bF; };
struct EpiNull {
    static constexpr bool HAS_INIT = false, PERM = true, ROW_AHEAD = true, USE_TAB = false;
    typedef NoCol ColS; typedef NoRow RowL;
    __device__ __forceinline__ ColS cols(int, int, int) const { return ColS{}; }
    __device__ __forceinline__ RowS pre(int, int) const { return RowS{0.f, 0.f}; }
    __device__ __forceinline__ RowL rload(int, int, int, int) const { return RowL{}; }
    __device__ __forceinline__ void apply(int, int, int, int, f32x4 (&v)[2][2], RowS, const ColS&, const RowL&) const { asm volatile("" :: "v"(v[0][0]), "v"(v[0][1]), "v"(v[1][0]), "v"(v[1][1])); }
};
struct LnFoldInit {
    struct ColI { f32x4 c1[2][2], c2[2][2]; };
    const float* st_in; const float* c1; const float* c2;
    __device__ __forceinline__ ColI colsi(int pn, int wc, int fq) const { ColI k;
#pragma unroll
        for (int bj = 0; bj < 2; ++bj)
#pragma unroll
            for (int n = 0; n < 2; ++n) { const int col = 256 * pn + 128 * bj + 32 * wc + 8 * fq + 4 * n; k.c1[bj][n] = *(const f32x4*)(c1 + col); k.c2[bj][n] = *(const f32x4*)(c2 + col); }
        return k; }
    __device__ __forceinline__ RowS prei(int row, int fq) const { RowS r; row_stats(st_in, row, fq, r.a, r.b); return r; }
    __device__ __forceinline__ void init_row(int, int, int, int, f32x4 (&v)[2][2], RowS rs0, const ColI& k) const {
        const RowS rsv{rs0.a, frcp(rs0.b)};
#pragma unroll
        for (int bj = 0; bj < 2; ++bj)
#pragma unroll
            for (int n = 0; n < 2; ++n) v[bj][n] = k.c2[bj][n] * rsv.b - k.c1[bj][n] * rsv.a;
    }
    __device__ __forceinline__ RowS pre(int row, int fq) const { RowS r; row_stats(st_in, row, fq, r.a, r.b); return r; }
};
struct EpiMlpUp : LnFoldInit {
    static constexpr bool HAS_INIT = true, PERM = true, ROW_AHEAD = true, USE_TAB = true;
    typedef NoCol ColS; typedef NoRow RowL;
    bf16_t* hid;
    __device__ __forceinline__ ColS cols(int, int, int) const { return ColS{}; }
    __device__ __forceinline__ RowL rload(int, int, int, int) const { return RowL{}; }
    __device__ __forceinline__ void apply(int row, int pn, int wc, int fq, f32x4 (&v)[2][2], RowS rsv, const ColS&, const RowL&) const {
#pragma unroll
        for (int bj = 0; bj < 2; ++bj) {
            f32x4 u[2];
#pragma unroll
            for (int n = 0; n < 2; ++n) { u[n] = v[bj][n] * rsv.b;
#pragma unroll
                for (int e = 0; e < 4; ++e) { const float r = fmaxf(u[n][e], 0.f); u[n][e] = r * r; } }
            *(u32x4*)(hid + (size_t)row * FF + 256 * pn + 128 * bj + 32 * wc + 8 * fq) = pk8(u[0], u[1]);
        }
    }
};
struct EpiIn1 : LnFoldInit {
    static constexpr bool HAS_INIT = true, PERM = true, ROW_AHEAD = false, USE_TAB = true;
    typedef NoCol ColS; struct RowL { f32x4 cs[2], sn[2]; };
    bf16_t* q1; bf16_t* k1; bf16_t* v1; bf16_t* g1; const float* rc; const float* rs;
    __device__ __forceinline__ ColS cols(int, int, int) const { return ColS{}; }
    static constexpr bool ROT = true;
    __device__ __forceinline__ RowL rload(int row, int pn, int wc, int fq) const { RowL l;
        if (pn < 8) { const int pos = row_pos(row);
#pragma unroll
            for (int n = 0; n < 2; ++n) { l.cs[n] = *(const f32x4*)(rc + pos * 128 + 32 * wc + 8 * fq + 4 * n); l.sn[n] = *(const f32x4*)(rs + pos * 128 + 32 * wc + 8 * fq + 4 * n); } }
        else { l.cs[0] = l.cs[1] = l.sn[0] = l.sn[1] = (f32x4){0.f, 0.f, 0.f, 0.f}; }
        return l; }
    __device__ __forceinline__ void rot_build(LAS unsigned char* lds, int tid) const {
        if (tid < 128) { LAS float* t = (LAS float*)(lds + ROT_OFF); t[tid] = rc[16 * 128 + tid]; t[128 + tid] = rs[16 * 128 + tid]; t[256 + tid] = rc[80 * 128 + tid]; t[384 + tid] = rs[80 * 128 + tid]; }
    }
    __device__ __forceinline__ void rot_step(RowL& l, int which, LAS unsigned char* lds, int wc, int fq) const {
        const LAS float* t = (const LAS float*)(lds + ROT_OFF) + which * 256 + 32 * wc + 8 * fq;
#pragma unroll
        for (int n = 0; n < 2; ++n) { const f32x4 c = *(const LAS f32x4*)(t + 4 * n), sn_ = *(const LAS f32x4*)(t + 128 + 4 * n);
            const f32x4 nc = l.cs[n] * c - l.sn[n] * sn_, ns = l.sn[n] * c + l.cs[n] * sn_; l.cs[n] = nc; l.sn[n] = ns; }
    }
    __device__ __forceinline__ void apply(int row, int pn, int wc, int fq, f32x4 (&v)[2][2], RowS rsv, const ColS&, const RowL& l) const {
        const int q0 = 32 * wc + 8 * fq;
        if (pn < 8) {
            const float sc = rsv.b * (pn < 4 ? 1.f : 0.0625f);
            bf16_t* dst = (pn < 4 ? q1 : k1) + (size_t)row * 1024 + 256 * (pn & 3) + q0;
            f32x4 y1[2], y2[2];
#pragma unroll
            for (int n = 0; n < 2; ++n) { const f32x4 cs = l.cs[n] * sc, sn = l.sn[n] * sc; y1[n] = v[0][n] * cs - v[1][n] * sn; y2[n] = v[0][n] * sn + v[1][n] * cs; }
            *(u32x4*)dst = pk8(y1[0], y1[1]); *(u32x4*)(dst + 128) = pk8(y2[0], y2[1]);
        } else {
            const bool isg = pn >= 16;
            bf16_t* dst = (isg ? g1 : v1) + (size_t)row * RMIX + 256 * (isg ? pn - 16 : pn - 8) + q0;
#pragma unroll
            for (int bj = 0; bj < 2; ++bj) {
                f32x4 u[2];
#pragma unroll
                for (int n = 0; n < 2; ++n) { u[n] = v[bj][n] * rsv.b;
                    if (isg) {
#pragma unroll
                        for (int e = 0; e < 4; ++e) u[n][e] = u[n][e] * sigmoidf_(u[n][e]);
                    } }
                *(u32x4*)(dst + 128 * bj) = pk8(u[0], u[1]);
            }
        }
    }
};

__host__ __device__ __forceinline__ int perm32(int rho) { const int n = rho >> 4, i = rho & 15; return 8 * (i >> 2) + 4 * n + (i & 3); }
template <class Epi>
__device__ __forceinline__ void gemm_naive(const Gemm g, const Epi& E, int bid, int nb) {
    const int tid = opaque_tid(), wid = tid >> 6, lane = tid & 63, fr = lane & 15, fq = lane >> 4;
    const int nN = g.N / 256, units = (g.M / 256) * nN;
    for (long item = (long)bid * 8 + wid; item < (long)units * 64; item += (long)nb * 8) {
        const int unit = (int)(item >> 6), sub = (int)(item & 63), pm = unit / nN, pn = unit % nN, mg = sub >> 2, wc = sub & 3;
        const int row0 = 256 * pm + 16 * mg;
        const bf16_t* ap = g.A + (size_t)pn * g.a_pn_off + (size_t)(row0 + fr) * g.lda + 8 * fq;
        const bf16_t* bp = g.Bt + (size_t)(256 * pn + 32 * wc) * g.ldb + 8 * fq;
        f32x4 acc[2][2];
#pragma unroll
        for (int bj = 0; bj < 2; ++bj)
#pragma unroll
            for (int n = 0; n < 2; ++n) acc[bj][n] = (f32x4){0.f, 0.f, 0.f, 0.f};
        if constexpr (Epi::HAS_INIT) E.init_row(row0 + fr, pn, wc, fq, acc, E.prei(row0 + fr, fq), E.colsi(pn, wc, fq));
        for (int k0 = 0; k0 < g.K; k0 += 32) {
            const bf16x8 a = *(const bf16x8*)(ap + k0);
#pragma unroll
            for (int bj = 0; bj < 2; ++bj)
#pragma unroll
                for (int n = 0; n < 2; ++n) {
                    const int brow = Epi::PERM ? perm32(16 * n + fr) : 16 * n + fr;
                    const bf16x8 b = *(const bf16x8*)(bp + (size_t)(128 * bj + brow) * g.ldb + k0);
                    acc[bj][n] = __builtin_amdgcn_mfma_f32_16x16x32_bf16(b, a, acc[bj][n], 0, 0, 0);
                }
        }
        E.apply(row0 + fr, pn, wc, fq, acc, E.pre(row0 + fr, fq), E.cols(pn, wc, fq), E.rload(row0 + fr, pn, wc, fq));
    }
}

namespace pg8 {
constexpr int BM = 256, BK = 64, HALF = 128, HTB = HALF * BK * 2  , STAGE_BYTES = 8 * HTB, NXCD = 8, WGM = 8;
__host__ __device__ __forceinline__ int lds_byte(int r, int c) { const int st = (r >> 4) * 2 + (c >> 5), rr = r & 15, cc = c & 31, ob = rr * 64 + cc * 2; return st * 1024 + (ob ^ (((ob >> 9) & 1) << 5)); }
__host__ __device__ __forceinline__ void stage_rc(int b, int& R, int& C) { const int st = b / 1024, sb = b % 1024, swz = sb ^ (((sb >> 9) & 1) << 5); R = (st >> 1) * 16 + swz / 64; C = (st & 1) * 32 + (swz % 64) / 2; }
struct Unit { int pm, pn; };
struct StaticOrder {
    int nM, nN, nwg, G, c;
    __host__ __device__ void init(int M, int N, int G_, int c_) { nM = M / BM; nN = N / BM; nwg = nM * nN; G = G_; c = c_; }
    __host__ __device__ bool next(int i, Unit& u) const {
        const long L = (long)i * G + c; if (L >= nwg) return false;
        int wgid = (int)L; { const int q = nwg / NXCD, r = nwg % NXCD, xcd = wgid % NXCD, off = wgid / NXCD; wgid = (xcd < r ? xcd * (q + 1) : r * (q + 1) + (xcd - r) * q) + off; }
        const int nig = WGM * nN, gid = wgid / nig, fm = gid * WGM, gsz = (nM - fm) < WGM ? (nM - fm) : WGM;
        u.pm = fm + ((wgid % nig) % gsz); u.pn = (wgid % nig) / gsz; return true;
    }
};
constexpr int TAB_OFF = 131072, TAB_UNITS = 15;
template <class T, class = void> struct HasFused { static constexpr bool value = false; };
template <class T> struct HasFused<T, decltype((void)T::FUSED_LN)> { static constexpr bool value = T::FUSED_LN; };
constexpr int FIN_OFF = 131072 + 2 * 2048;
template <class T, class = void> struct HasRot { static constexpr bool value = false; };
template <class T> struct HasRot<T, decltype((void)T::ROT)> { static constexpr bool value = T::ROT; };
template <class T, class = void> struct HasKhook { static constexpr bool value = false; };
template <class T> struct HasKhook<T, decltype((void)T::KHOOK)> { static constexpr bool value = T::KHOOK; };
constexpr int RHO_OFF = TAB_OFF + 2 * 2048;
template <class E> struct PgEpi {
    static constexpr bool PERM = E::PERM, KHOOK = HasKhook<E>::value;
    E e;
#define PG_ROW(i) (rbase + ((i) >> 2) * HALF + ((i) & 3) * 16)
#define PG_TROW(i) (wr * 64 + fr + ((i) >> 2) * HALF + ((i) & 3) * 16)
    template <class Sched> __device__ __forceinline__ void build_tab(LAS unsigned char* lds, const Sched& S, int tid) const {
        if constexpr (E::USE_TAB) {
            LAS f32x2* tab = (LAS f32x2*)(lds + TAB_OFF);
            const int r = tid >> 1, hf = tid & 1; Unit u;
            for (int i = 0; i < TAB_UNITS && S.next(i, u); ++i) {
                const f32x4* p = (const f32x4*)(e.st_in + (size_t)(u.pm * BM + r) * 32 + hf * 16);
                const f32x4 a0 = p[0], a1 = p[1], a2 = p[2], a3 = p[3];
                float s1 = (a0[0] + a0[2]) + (a1[0] + a1[2]) + (a2[0] + a2[2]) + (a3[0] + a3[2]), s2 = (a0[1] + a0[3]) + (a1[1] + a1[3]) + (a2[1] + a2[3]) + (a3[1] + a3[3]);
                s1 += __shfl_xor(s1, 1); s2 += __shfl_xor(s2, 1);
                const float mean = s1 * (1.f / DM), var = fmaxf(s2 * (1.f / DM) - mean * mean, 0.f);
                if (hf == 0) tab[i * 256 + r] = (f32x2){mean, frsq(var + LN_EPS)};
            }
            if constexpr (HasRot<E>::value) e.rot_build(lds, tid);
            if constexpr (KHOOK) {
                LAS f32x4* rho = (LAS f32x4*)(lds + RHO_OFF);
                for (int i = 0; i < 2 && S.next(i, u); ++i) {
                    const f32x4* p = (const f32x4*)(e.osq + (size_t)(u.pm * BM + r) * 64 + hf * 32);
                    float sa = 0.f, sb = 0.f;
#pragma unroll
                    for (int k = 0; k < 4; ++k) { const f32x4 a = p[k], b = p[4 + k]; sa += (a[0] + a[1]) + (a[2] + a[3]); sb += (b[0] + b[1]) + (b[2] + b[3]); }
                    const float ra = frsq(sa * (1.f / RDV) + LN_EPS), rb = frsq(sb * (1.f / RDV) + LN_EPS);
                    const float oa = __shfl_xor(ra, 1), ob = __shfl_xor(rb, 1);
                    if (hf == 0) rho[i * 256 + r] = (f32x4){frcp(ra), ra * frcp(rb), rb * frcp(oa), oa * frcp(ob)};
                }
            }
            asm volatile("s_waitcnt lgkmcnt(0)" ::: "memory"); __syncthreads();
        } else if constexpr (HasRot<E>::value) { e.rot_build(lds, tid); asm volatile("s_waitcnt lgkmcnt(0)" ::: "memory"); __syncthreads(); }
    }
    __device__ __forceinline__ void khook(f32x4 (&acc)[2][2][4][2], int ui, int col, LAS unsigned char* lds, int wr, int fr) const {
        if constexpr (KHOOK) {
#pragma unroll
            for (int i = 0; i < 8; ++i) {
                const float sc = ((const LAS float*)(lds + RHO_OFF))[(ui * 256 + PG_TROW(i)) * 4 + col];
                const int ai = i >> 2, m = i & 3;
                acc[ai][0][m][0] *= sc; acc[ai][0][m][1] *= sc; acc[ai][1][m][0] *= sc; acc[ai][1][m][1] *= sc;
            }
        }
    }
    __device__ __forceinline__ void fused_ln(const f32x4 (&acc)[2][2][4][2], const Unit& u, LAS unsigned char* lds, int wr, int wc, int fr, int fq) const {
        if constexpr (HasFused<E>::value) {
            typedef float f2 __attribute__((ext_vector_type(2)));
            LAS f2* P = (LAS f2*)(lds + FIN_OFF); LAS f2* Sx = (LAS f2*)(lds + FIN_OFF + 8192); volatile LAS unsigned* flag = (volatile LAS unsigned*)(lds + FIN_OFF + 10240);
            const int tid = threadIdx.x, lane = tid & 63, wid = tid >> 6;
#pragma unroll
            for (int i = 0; i < 8; ++i) {
                const int ai = i >> 2, m = i & 3; float s1 = 0.f, s2 = 0.f;
#pragma unroll
                for (int bj = 0; bj < 2; ++bj)
#pragma unroll
                    for (int n = 0; n < 2; ++n)
#pragma unroll
                        for (int q = 0; q < 4; ++q) { const float x = acc[ai][bj][m][n][q]; s1 += x; s2 += x * x; }
                s1 += __shfl_xor(s1, 16); s2 += __shfl_xor(s2, 16); s1 += __shfl_xor(s1, 32); s2 += __shfl_xor(s2, 32);
                if (fq == 0) P[(wr * 64 + fr + ai * HALF + m * 16) * 4 + wc] = (f2){s1, s2};
            }
            asm volatile("s_waitcnt lgkmcnt(0)" ::: "memory"); __builtin_amdgcn_s_barrier(); asm volatile("" ::: "memory");
            if (tid < 256) {
                const f2 a = P[tid * 4], b = P[tid * 4 + 1], c2 = P[tid * 4 + 2], d = P[tid * 4 + 3];
                const float s1 = (a.x + b.x) + (c2.x + d.x), s2 = (a.y + b.y) + (c2.y + d.y);
                __hip_atomic_store(e.xbuf + ((size_t)(u.pm * BM + tid) * 4 + u.pn), ((unsigned long long)__float_as_uint(s2) << 32) | __float_as_uint(s1), __ATOMIC_RELAXED, __HIP_MEMORY_SCOPE_AGENT);
                asm volatile("s_waitcnt vmcnt(0)" ::: "memory");
                if (lane == 0) __hip_atomic_fetch_add(e.cnt + 64 * u.pm, 1u, __ATOMIC_RELAXED, __HIP_MEMORY_SCOPE_AGENT);
            }
            if (wid == 0) {
                unsigned sp = 0;
                while ((unsigned)__builtin_amdgcn_readfirstlane(__hip_atomic_load(e.cnt + 64 * u.pm, __ATOMIC_RELAXED, __HIP_MEMORY_SCOPE_AGENT)) < 16u) { __builtin_amdgcn_s_sleep(2); if (++sp > (1u << 22)) break; }
                __builtin_amdgcn_fence(__ATOMIC_ACQUIRE, "agent");
                if (lane == 0) flag[0] = 1u;
            }
            asm volatile("s_waitcnt vmcnt(0) lgkmcnt(0)" ::: "memory"); __builtin_amdgcn_s_barrier(); asm volatile("" ::: "memory");
            if (tid < 256) {
                float s1 = 0.f, s2 = 0.f;
#pragma unroll
                for (int t = 0; t < 4; ++t) { const unsigned long long w = __hip_atomic_load(e.xbuf + ((size_t)(u.pm * BM + tid) * 4 + t), __ATOMIC_RELAXED, __HIP_MEMORY_SCOPE_AGENT); s1 += __uint_as_float((unsigned)w); s2 += __uint_as_float((unsigned)(w >> 32)); }
                const float mean = s1 * (1.f / DM), var = fmaxf(s2 * (1.f / DM) - mean * mean, 0.f);
                Sx[tid] = (f2){mean, frsq(var + LN_EPS)};
            }
            asm volatile("s_waitcnt vmcnt(0) lgkmcnt(0)" ::: "memory"); __builtin_amdgcn_s_barrier(); asm volatile("" ::: "memory");
            f32x4 gv[2][2], bv[2][2];
#pragma unroll
            for (int bj = 0; bj < 2; ++bj)
#pragma unroll
                for (int n = 0; n < 2; ++n) { const int col = 256 * u.pn + 128 * bj + 32 * wc + 8 * fq + 4 * n; gv[bj][n] = *(const f32x4*)(e.gF + col); bv[bj][n] = *(const f32x4*)(e.bF + col); }
#pragma unroll
            for (int i = 0; i < 8; ++i) {
                const int ai = i >> 2, m = i & 3, rt = wr * 64 + fr + ai * HALF + m * 16; const f2 ms = Sx[rt];
                float* orow = e.c.out + (size_t)(u.pm * BM + rt) * DM + 256 * u.pn + 32 * wc + 8 * fq;
#pragma unroll
                for (int bj = 0; bj < 2; ++bj)
#pragma unroll
                    for (int n = 0; n < 2; ++n) *(f32x4*)(orow + 128 * bj + 4 * n) = (acc[ai][bj][m][n] - ms.x) * ms.y * gv[bj][n] + bv[bj][n];
            }
            asm volatile("s_waitcnt lgkmcnt(0)" ::: "memory"); __builtin_amdgcn_s_barrier(); asm volatile("" ::: "memory");
        }
    }
    __device__ __forceinline__ void operator()(const f32x4 (&acc)[2][2][4][2], const Unit& u, int ui, LAS unsigned char* lds, int wr, int wc, int fr, int fq) const {
        if constexpr (HasFused<E>::value) { fused_ln(acc, u, lds, wr, wc, fr, fq); return; }
        const int rbase = u.pm * BM + wr * 64 + fr;
        const typename E::ColS cs = e.cols(u.pn, wc, fq);
        RowS rs[8];
#pragma unroll
        for (int i = 0; i < 8; ++i) {
            if constexpr (E::USE_TAB) { const f32x2 t = ((const LAS f32x2*)(lds + TAB_OFF))[ui * 256 + PG_TROW(i)]; rs[i] = RowS{t.x, t.y}; }
            else rs[i] = e.pre(PG_ROW(i), fq);
        }
        typename E::RowL nxt = e.rload(PG_ROW(0), u.pn, wc, fq);
#pragma unroll
        for (int i = 0; i < 8; ++i) {
            const int ai = i >> 2, m = i & 3;
            typename E::RowL cur;
            if constexpr (HasRot<E>::value) { cur = nxt; if (i + 1 < 8 && u.pn < 8) e.rot_step(nxt, i == 3 ? 1 : 0, lds, wc, fq); }
            else if (E::ROW_AHEAD || i == 0) { cur = nxt; if (E::ROW_AHEAD && i + 1 < 8) nxt = e.rload(PG_ROW(i + 1), u.pn, wc, fq); }
            else cur = e.rload(PG_ROW(i), u.pn, wc, fq);
            f32x4 v[2][2] = {{acc[ai][0][m][0], acc[ai][0][m][1]}, {acc[ai][1][m][0], acc[ai][1][m][1]}};
            if constexpr (KHOOK) { const f32x4 rh = ((const LAS f32x4*)(lds + RHO_OFF))[ui * 256 + PG_TROW(i)]; const float r3 = frcp(rh[0] * rh[1] * rh[2] * rh[3]);
                v[0][0] *= r3; v[0][1] *= r3; v[1][0] *= r3; v[1][1] *= r3; }
            e.apply(PG_ROW(i), u.pn, wc, fq, v, rs[i], cs, cur);
        }
    }
    struct NoCi {};
    template <class T, bool H> struct CiSel { typedef NoCi type; };
    template <class T> struct CiSel<T, true> { typedef typename T::ColI type; };
    typedef typename CiSel<E, E::HAS_INIT>::type Ci;
    __device__ __forceinline__ Ci init_cols(const Unit& u, int wc, int fq) const { if constexpr (E::HAS_INIT) return e.colsi(u.pn, wc, fq); else return Ci{}; }
    __device__ __forceinline__ void init(f32x4 (&acc)[2][2][4][2], const Unit& u, int ui, LAS unsigned char* lds, int wr, int wc, int fr, int fq, const Ci& ci) const {
        if constexpr (E::HAS_INIT) {
            const int rbase = u.pm * BM + wr * 64 + fr;
            RowS rs[8];
#pragma unroll
            for (int i = 0; i < 8; ++i) {
                if constexpr (E::USE_TAB) { const f32x2 t = ((const LAS f32x2*)(lds + TAB_OFF))[ui * 256 + PG_TROW(i)]; rs[i] = RowS{t.x, t.y}; }
                else rs[i] = e.prei(PG_ROW(i), fq);
            }
#pragma unroll
            for (int i = 0; i < 8; ++i) {
                const int ai = i >> 2, m = i & 3; f32x4 v[2][2];
                e.init_row(PG_ROW(i), u.pn, wc, fq, v, rs[i], ci);
                if constexpr (KHOOK) { const float i0 = ((const LAS float*)(lds + RHO_OFF))[(ui * 256 + PG_TROW(i)) * 4]; v[0][0] *= i0; v[0][1] *= i0; v[1][0] *= i0; v[1][1] *= i0; }
                acc[ai][0][m][0] = v[0][0]; acc[ai][0][m][1] = v[0][1]; acc[ai][1][m][0] = v[1][0]; acc[ai][1][m][1] = v[1][1];
            }
        } else {
#pragma unroll
            for (int a = 0; a < 2; ++a)
#pragma unroll
                for (int b = 0; b < 2; ++b)
#pragma unroll
                    for (int m = 0; m < 4; ++m)
#pragma unroll
                        for (int n = 0; n < 2; ++n) acc[a][b][m][n] = (f32x4){0.f, 0.f, 0.f, 0.f};
        }
    }
#undef PG_ROW
#undef PG_TROW
};
template <class Epi>
__device__ __forceinline__ void gemm_phase(LAS unsigned char* lds, const Gemm g, const StaticOrder& S, const Epi& E) {
    const int tid = opaque_tid(), wid = __builtin_amdgcn_readfirstlane(tid >> 6), lane = tid & 63, wr = wid >> 2, wc = wid & 3, fr = lane & 15, fq = lane >> 4;
    int Ko = g.K; asm volatile("" : "+s"(Ko));
    const int K = Ko, nt = K / BK;
    unsigned voffA[2], voffB[2];
#pragma unroll
    for (int i = 0; i < 2; ++i) { int R, C; stage_rc(tid * 16 + i * 8192, R, C); const int Rb = Epi::PERM ? ((R & ~31) + perm32(R & 31)) : R; voffA[i] = (unsigned)(R * g.lda + C) * 2u; voffB[i] = (unsigned)(Rb * g.ldb + C) * 2u; }
    const size_t kstep = (size_t)(BK * 2);
    const size_t hstepA = (size_t)HALF * g.lda * 2, hstepB = (size_t)HALF * g.ldb * 2;
    const size_t tstepA = 2 * hstepA, tstepB = 2 * hstepB;
    const size_t pnA = (size_t)g.a_pn_off * 2;
    const unsigned ldsw = (unsigned)wid * 1024u;
    const int aoff = lds_byte(wr * 64 + fr, fq * 8), boff = lds_byte(wc * 32 + fr, fq * 8);
#define PG8_SA(b, h) (((b) * 2 + (h)) * HTB)
#define PG8_SB(b, h) ((4 + (b) * 2 + (h)) * HTB)
#define PG8_STAGE(bufoff, gbase, voff) do { _Pragma("unroll") for (int _i = 0; _i < 2; ++_i) \
        __builtin_amdgcn_global_load_lds((const unsigned*)((const char*)(gbase) + (voff)[_i]), (LAS unsigned*)(lds + (bufoff) + ldsw + _i * 8192), 16, 0, 0); } while (0)
#define PG8_LDA(dst, b, h) do { _Pragma("unroll") for (int m = 0; m < 4; ++m) _Pragma("unroll") for (int k = 0; k < 2; ++k) dst[m][k] = *(const LAS bf16x8*)(lds + PG8_SA(b, h) + aoff + m * 2048 + k * 1024); } while (0)
#define PG8_LDB(dst, b, h) do { _Pragma("unroll") for (int n = 0; n < 2; ++n) _Pragma("unroll") for (int k = 0; k < 2; ++k) dst[n][k] = *(const LAS bf16x8*)(lds + PG8_SB(b, h) + boff + n * 2048 + k * 1024); } while (0)
#define PG8_MMA(ai, bj, At, Bt) do { __builtin_amdgcn_s_setprio(1); _Pragma("unroll") for (int m = 0; m < 4; ++m) _Pragma("unroll") for (int n = 0; n < 2; ++n) _Pragma("unroll") for (int k = 0; k < 2; ++k) \
        acc[ai][bj][m][n] = __builtin_amdgcn_mfma_f32_16x16x32_bf16(Bt[n][k], At[m][k], acc[ai][bj][m][n], 0, 0, 0); __builtin_amdgcn_s_setprio(0); } while (0)
#define PG8_WAIT_V(n) asm volatile("s_waitcnt vmcnt(" #n ")" ::: "memory")
#define PG8_WAIT_L(n) asm volatile("s_waitcnt lgkmcnt(" #n ")" ::: "memory")
#define PG8_BAR __builtin_amdgcn_s_barrier()
#define PG8_SCHED __builtin_amdgcn_sched_barrier(0)
    Unit cur, nxt; int ui = 0;
    if (!S.next(0, cur)) return;
    E.build_tab(lds, S, tid);
    f32x4 acc[2][2][4][2];
    bf16x8 At[4][2], B0[2][2], B1[2][2];
    const char* cA = (const char*)g.A + (size_t)cur.pn * pnA + (size_t)cur.pm * tstepA; const char* cB = (const char*)g.Bt + (size_t)cur.pn * tstepB;
    PG8_STAGE(PG8_SB(0, 0), cB, voffB); PG8_STAGE(PG8_SB(0, 1), cB + hstepB, voffB); PG8_STAGE(PG8_SA(0, 0), cA, voffA); PG8_STAGE(PG8_SA(0, 1), cA + hstepA, voffA);
    PG8_SCHED;
    E.init(acc, cur, 0, lds, wr, wc, fr, fq, E.init_cols(cur, wc, fq));
    PG8_SCHED;
    if (wr == 1) PG8_BAR;
    PG8_WAIT_V(2); PG8_BAR;
    PG8_STAGE(PG8_SB(1, 0), cB + kstep, voffB); PG8_STAGE(PG8_SA(1, 0), cA + kstep, voffA); PG8_STAGE(PG8_SB(1, 1), cB + hstepB + kstep, voffB);
    PG8_WAIT_V(6); PG8_BAR;
    for (;;) {
        const bool has_next = S.next(ui + 1, nxt);
        const char* nA = has_next ? (const char*)g.A + (size_t)nxt.pn * pnA + (size_t)nxt.pm * tstepA : cA; const char* nB = has_next ? (const char*)g.Bt + (size_t)nxt.pn * tstepB : cB;
        for (int t = 0; t < nt; t += 2) {
            if constexpr (Epi::KHOOK) { if (t != 0 && (t & 7) == 0) E.khook(acc, ui, t >> 3, lds, wr, fr); }
            const bool last = (t == nt - 2);
            const char* a1 = cA + (size_t)(t + 1) * kstep;
            const char* a2 = last ? nA : cA + (size_t)(t + 2) * kstep; const char* b2 = last ? nB : cB + (size_t)(t + 2) * kstep;
            const char* a3 = a2 + kstep; const char* b3 = b2 + kstep;
            PG8_LDB(B0, 0, 0); PG8_LDB(B1, 0, 1); PG8_SCHED; PG8_LDA(At, 0, 0); PG8_STAGE(PG8_SA(1, 1), a1 + hstepA, voffA);
            PG8_WAIT_V(8); PG8_WAIT_L(0); PG8_BAR; PG8_MMA(0, 0, At, B0); PG8_MMA(0, 1, At, B1); PG8_BAR; PG8_SCHED;
            PG8_LDA(At, 0, 1); PG8_STAGE(PG8_SB(0, 0), b2, voffB); PG8_STAGE(PG8_SB(0, 1), b2 + hstepB, voffB); PG8_STAGE(PG8_SA(0, 0), a2, voffA);
            PG8_WAIT_V(8); PG8_WAIT_L(0); PG8_BAR; PG8_MMA(1, 0, At, B0); PG8_MMA(1, 1, At, B1); PG8_BAR; PG8_SCHED;
            PG8_LDB(B0, 1, 0); PG8_LDB(B1, 1, 1); PG8_SCHED; PG8_LDA(At, 1, 0); PG8_STAGE(PG8_SA(0, 1), a2 + hstepA, voffA);
            PG8_WAIT_V(8); PG8_WAIT_L(0); PG8_BAR; PG8_MMA(0, 0, At, B0); PG8_MMA(0, 1, At, B1); PG8_BAR; PG8_SCHED;
            PG8_LDA(At, 1, 1); PG8_STAGE(PG8_SB(1, 0), b3, voffB); PG8_STAGE(PG8_SB(1, 1), b3 + hstepB, voffB); PG8_STAGE(PG8_SA(1, 0), a3, voffA);
            PG8_WAIT_V(8); PG8_WAIT_L(0); PG8_BAR; PG8_MMA(1, 0, At, B0); PG8_MMA(1, 1, At, B1); PG8_BAR; PG8_SCHED;
        }
        if (wr == 0) PG8_BAR;
        E(acc, cur, ui, lds, wr, wc, fr, fq);
        if (!has_next) break;
        E.init(acc, nxt, ui + 1, lds, wr, wc, fr, fq, E.init_cols(nxt, wc, fq));
        cur = nxt; cA = nA; cB = nB; ++ui;
        if (wr == 1) PG8_BAR;
    }
    PG8_WAIT_V(0);
    PG8_BAR;
#undef PG8_SA
#undef PG8_SB
#undef PG8_STAGE
#undef PG8_LDA
#undef PG8_LDB
#undef PG8_MMA
#undef PG8_WAIT_V
#undef PG8_WAIT_L
#undef PG8_BAR
#undef PG8_SCHED
}
}

template <class Epi>
__device__ __forceinline__ void gemm_meta(LAS unsigned char* lds, const Gemm g, const Epi& E, int bid, int nb, int pn_lo, int pn_hi) {
    const int tid = opaque_tid(), wid = __builtin_amdgcn_readfirstlane(tid >> 6), lane = tid & 63, fr = lane & 15, fq = lane >> 4;
    const int ntask = (pn_hi - pn_lo) * 4, ksteps = g.K / 32;
    LAS f32x4* part = (LAS f32x4*)lds;
    for (int t = nb - 1 - bid; t < ntask; t += nb) {
        const int pn = pn_lo + (t >> 2), wc = t & 3;
        const bf16_t* ap = g.A + (size_t)pn * g.a_pn_off + (size_t)(MR + fr) * g.lda + 8 * fq;
        const bf16_t* bp = g.Bt + (size_t)(256 * pn + 32 * wc) * g.ldb + 8 * fq;
        f32x4 acc[2][2];
#pragma unroll
        for (int bj = 0; bj < 2; ++bj)
#pragma unroll
            for (int n = 0; n < 2; ++n) acc[bj][n] = (f32x4){0.f, 0.f, 0.f, 0.f};
        f32x4 v[2][2];
#pragma unroll
        for (int i = 0; i < 4; ++i) v[i >> 1][i & 1] = (f32x4){0.f, 0.f, 0.f, 0.f};
        RowS epr{0.f, 0.f}; typename Epi::ColS ecs{}; typename Epi::RowL erl{};
        if (wid == 0) {
            if constexpr (Epi::HAS_INIT) E.init_row(MR + fr, pn, wc, fq, v, E.prei(MR + fr, fq), E.colsi(pn, wc, fq));
            epr = E.pre(MR + fr, fq); ecs = E.cols(pn, wc, fq); erl = E.rload(MR + fr, pn, wc, fq);
        }
#pragma unroll 4
        for (int ks = wid; ks < ksteps; ks += 8) {
            const int k0 = 32 * ks;
            const bf16x8 a = *(const bf16x8*)(ap + k0);
#pragma unroll
            for (int bj = 0; bj < 2; ++bj)
#pragma unroll
                for (int n = 0; n < 2; ++n) {
                    const int brow = Epi::PERM ? perm32(16 * n + fr) : 16 * n + fr;
                    const bf16x8 b = *(const bf16x8*)(bp + (size_t)(128 * bj + brow) * g.ldb + k0);
                    acc[bj][n] = __builtin_amdgcn_mfma_f32_16x16x32_bf16(b, a, acc[bj][n], 0, 0, 0);
                }
        }
#pragma unroll
        for (int i = 0; i < 4; ++i) part[(wid * 64 + lane) * 4 + i] = acc[i >> 1][i & 1];
        __syncthreads();
        if (wid == 0) {
#pragma unroll
            for (int w = 0; w < 8; ++w)
#pragma unroll
                for (int i = 0; i < 4; ++i) v[i >> 1][i & 1] += part[(w * 64 + lane) * 4 + i];
            E.apply(MR + fr, pn, wc, fq, v, epr, ecs, erl);
        }
        __syncthreads();
    }
}

template <class E>
__device__ __forceinline__ void run_gemm(LAS unsigned char* lds, const Gemm g, const E& e, int bid, int nb, bool meta = true, int mlo = 0, int mhi = -1) {
    if (meta) gemm_meta<E>(lds, g, e, bid, nb, mlo, mhi < 0 ? g.N / 256 : mhi);
#if FAST_GEMM
    pg8::StaticOrder S; S.init(g.M, g.N, nb, bid);
    pg8::PgEpi<E> pe{e};
    pg8::gemm_phase<pg8::PgEpi<E>>(lds, g, S, pe);
#else
    gemm_naive<E>(g, e, bid, nb);
#endif
}

constexpr int NWV = 8;

__device__ __forceinline__ void transpose_item(const float* W, int K, int N, bf16_t* WT, int row_off, const float* gk, const float* bk, float* c1, float* c2, LAS float* scr, int item, int lane) {
    const int nblk = N / 32, kb = item / nblk, nbk = item % nblk, k0 = 64 * kb, n0 = 32 * nbk;
    float s1 = 0.f, s2 = 0.f;
    float wv[32];
#pragma unroll
    for (int i = 0; i < 32; ++i) wv[i] = __builtin_nontemporal_load(W + (size_t)(k0 + 2 * i + (lane >> 5)) * N + n0 + (lane & 31));
#pragma unroll
    for (int i = 0; i < 32; ++i) { const int kk = 2 * i + (lane >> 5); float w = wv[i]; if (bk) s2 += bk[k0 + kk] * w; if (gk) w *= gk[k0 + kk]; if (c1) s1 += bfround(w); scr[kk * 33 + (lane & 31)] = w; }
    if (c1) { s1 += __shfl_xor(s1, 32); s2 += __shfl_xor(s2, 32); if (lane < 32) { atomicAdd(c1 + n0 + lane, s1); atomicAdd(c2 + n0 + lane, s2); } }
    asm volatile("s_waitcnt lgkmcnt(0)" ::: "memory");
    const int cch = lane & 7;
#pragma unroll
    for (int j = 0; j < 4; ++j) { const int n = (lane >> 3) + 8 * j; const LAS float* s = scr + (8 * cch) * 33 + n;
        u32x4 o; o.x = pk2(s[0 * 33], s[1 * 33]); o.y = pk2(s[2 * 33], s[3 * 33]); o.z = pk2(s[4 * 33], s[5 * 33]); o.w = pk2(s[6 * 33], s[7 * 33]);
        *(u32x4*)(WT + (size_t)(row_off + n0 + n) * K + k0 + 8 * cch) = o; }
    asm volatile("s_waitcnt lgkmcnt(0)" ::: "memory");
}
__device__ __forceinline__ void transpose_item64(const float* W, int K, int N, bf16_t* WT, int row_off, const float* gk, const float* bk, float* c1, float* c2, LAS float* scr, int item, int lane) {
    const int nblk = N / 64, kb = item / nblk, nbk = item % nblk, k0 = 64 * kb, n0 = 64 * nbk, n4 = 4 * (lane & 15), kq = lane >> 4;
    f32x4 wv[16];
#pragma unroll
    for (int i = 0; i < 16; ++i) wv[i] = __builtin_nontemporal_load((const f32x4*)(W + (size_t)(k0 + 4 * i + kq) * N + n0 + n4));
    f32x4 s1 = {0.f, 0.f, 0.f, 0.f}, s2 = s1;
#pragma unroll
    for (int i = 0; i < 16; ++i) { const int kk = 4 * i + kq; f32x4 w = wv[i]; if (bk) s2 += w * bk[k0 + kk]; if (gk) w *= gk[k0 + kk];
        if (c1) { s1[0] += bfround(w[0]); s1[1] += bfround(w[1]); s1[2] += bfround(w[2]); s1[3] += bfround(w[3]); }
        LAS float* d = scr + kk * 65 + n4; d[0] = w[0]; d[1] = w[1]; d[2] = w[2]; d[3] = w[3]; }
    if (c1) {
#pragma unroll
        for (int e = 0; e < 4; ++e) { s1[e] += __shfl_xor(s1[e], 16); s1[e] += __shfl_xor(s1[e], 32); s2[e] += __shfl_xor(s2[e], 16); s2[e] += __shfl_xor(s2[e], 32); }
        if (lane < 16) {
#pragma unroll
            for (int e = 0; e < 4; ++e) { atomicAdd(c1 + n0 + n4 + e, s1[e]); atomicAdd(c2 + n0 + n4 + e, s2[e]); } }
    }
    asm volatile("s_waitcnt lgkmcnt(0)" ::: "memory");
    const int cch = lane & 7;
#pragma unroll
    for (int j = 0; j < 8; ++j) { const int n = (lane >> 3) + 8 * j; const LAS float* sp = scr + (8 * cch) * 65 + n;
        u32x4 o; o.x = pk2(sp[0 * 65], sp[1 * 65]); o.y = pk2(sp[2 * 65], sp[3 * 65]); o.z = pk2(sp[4 * 65], sp[5 * 65]); o.w = pk2(sp[6 * 65], sp[7 * 65]);
        *(u32x4*)(WT + (size_t)(row_off + n0 + n) * K + k0 + 8 * cch) = o; }
    asm volatile("s_waitcnt lgkmcnt(0)" ::: "memory");
}
constexpr int C1_UP0 = 0, C2_UP0 = 4096, C1_IN1 = 8192, C2_IN1 = 14336, C1_UP1 = 20480, C2_UP1 = 24576;
struct MatDesc { const float* W; int K, N; bf16_t* WT; int row_off; const float* gk; const float* bk; float* c1; float* c2; };
constexpr int TR_COUNT[18] = {720, 4, 4, 4, 4, 4, 4, 4, 4, 48, 32, 256, 1024, 1024, 1536, 512, 1024, 1024};
constexpr int tr_total() { int s = 0; for (int i = 0; i < 18; ++i) s += TR_COUNT[i]; return s; }
__device__ __forceinline__ MatDesc get_mat(const Ctx& c, int i) {
    MatDesc d; d.gk = nullptr; d.row_off = 0; d.bk = nullptr; d.c1 = nullptr; d.c2 = nullptr; float* cv = c.f32(OFF_C12);
    if (i == 0) { d.W = c.in[2]; d.K = 1024; d.N = EVEN_IN; d.WT = c.b16(OFF_WIN0); }
    else if (i <= 4) { const int h = i - 1; d.W = c.in[5] + h * 16384; d.K = 128; d.N = 128; d.WT = c.b16(OFF_WGATE); d.row_off = h * 256; }
    else if (i <= 8) { const int h = i - 5; d.W = c.in[7] + h * 16384; d.K = 128; d.N = 128; d.WT = c.b16(OFF_WGATE); d.row_off = h * 256 + 128; }
    else if (i == 9) { d.W = c.in[11]; d.K = 256; d.N = 768; d.WT = c.b16(OFF_WUQ); d.gk = c.in[10]; }
    else if (i == 10) { d.W = c.in[13]; d.K = 128; d.N = 1024; d.WT = c.b16(OFF_WUKV); d.gk = c.in[12]; }
    else if (i == 11) { d.W = c.in[14]; d.K = 1024; d.N = 1024; d.WT = c.b16(OFF_WOUT0); }
    else if (i == 12) { d.W = c.in[19]; d.K = 1024; d.N = 4096; d.WT = c.b16(OFF_W1_0); d.gk = c.in[17]; d.bk = c.in[18]; d.c1 = cv + C1_UP0; d.c2 = cv + C2_UP0; }
    else if (i == 13) { d.W = c.in[20]; d.K = 4096; d.N = 1024; d.WT = c.b16(OFF_W2_0); }
    else if (i == 14) { d.W = c.in[15]; d.K = 1024; d.N = 6144; d.WT = c.b16(OFF_WIN1); d.gk = c.in[21]; d.bk = c.in[22]; d.c1 = cv + C1_IN1; d.c2 = cv + C2_IN1; }
    else if (i == 15) { d.W = c.in[16]; d.K = 2048; d.N = 1024; d.WT = c.b16(OFF_WOUT1); }
    else if (i == 16) { d.W = c.in[19] + (size_t)1024 * 4096; d.K = 1024; d.N = 4096; d.WT = c.b16(OFF_W1_1); d.gk = c.in[17] + 1024; d.bk = c.in[18] + 1024; d.c1 = cv + C1_UP1; d.c2 = cv + C2_UP1; }
    else { d.W = c.in[20] + (size_t)4096 * 1024; d.K = 4096; d.N = 1024; d.WT = c.b16(OFF_W2_1); }
    return d;
}
__device__ __forceinline__ void sincos_d(double ang, float& cs, float& sn) {
    const double TWO_PI = 6.283185307179586476925, HALF_PI = 1.5707963267948966192, INV_TWO_PI = 0.15915494309189533577, INV_HALF_PI = 0.63661977236758134308;
    double r = ang - rint(ang * INV_TWO_PI) * TWO_PI;
    const double q = rint(r * INV_HALF_PI); const double y = r - q * HALF_PI; const double y2 = y * y;
    const double s = y * (1.0 + y2 * (-1.0 / 6 + y2 * (1.0 / 120 + y2 * (-1.0 / 5040 + y2 * (1.0 / 362880 + y2 * (-1.0 / 39916800 + y2 * (1.0 / 6227020800.0)))))));
    const double c = 1.0 + y2 * (-0.5 + y2 * (1.0 / 24 + y2 * (-1.0 / 720 + y2 * (1.0 / 40320 + y2 * (-1.0 / 3628800 + y2 * (1.0 / 479001600.0))))));
    const int qi = ((int)q) & 3;
    double cc, ss;
    if (qi == 0) { cc = c; ss = s; } else if (qi == 1) { cc = -s; ss = c; } else if (qi == 2) { cc = -c; ss = -s; } else { cc = s; ss = -c; }
    cs = (float)cc; sn = (float)ss;
}
__device__ __forceinline__ void phase_prologue(const Ctx& c, const Params& p, LAS unsigned char* lds, int bid, int nb, int part = 0) {
    const int tid = opaque_tid(), wid = tid >> 6, lane = tid & 63;
    LAS float* scr = (LAS float*)(lds + wid * 17408);
    const long gw = (long)bid * NWV + wid, NW = (long)nb * NWV;
    constexpr int T_C12 = 0, T_TR = tr_total(), T_ZP = 96, T_XB = (MR + NMETA) / 4, T_ROPE = (TT * 144 + 63) / 64, T_CCH = 8;
    constexpr int TOTAL = T_C12 + T_TR + T_ZP + T_XB + T_ROPE + T_CCH;
    for (long it = gw; it < TOTAL; it += NW) {
        int r = (int)it;
        if (part == 2 && (r < T_TR + T_ZP || r >= T_TR + T_ZP + T_XB)) continue;
        if (r < T_TR) {
            int mi = 0;
#pragma unroll
            for (int i = 0; i < 18; ++i) { if (mi == i && r >= TR_COUNT[i]) { r -= TR_COUNT[i]; mi = i + 1; } }
            const MatDesc d = get_mat(c, mi);
            if (mi == 0) transpose_item(d.W, d.K, d.N, d.WT, d.row_off, d.gk, d.bk, d.c1, d.c2, scr, r, lane);
            else transpose_item64(d.W, d.K, d.N, d.WT, d.row_off, d.gk, d.bk, d.c1, d.c2, scr, r, lane);
            continue;
        }
        r -= T_TR;
        if (r < T_ZP) {
            u32x4* dst = (u32x4*)(c.b16(OFF_WIN0) + (size_t)(EVEN_IN + r) * 1024); dst[lane] = (u32x4){0, 0, 0, 0}; dst[64 + lane] = (u32x4){0, 0, 0, 0};
            continue;
        }
        r -= T_ZP;
        if (r < T_XB) {
            if (part == 1) continue;
            f32x4 v[4][4];
#pragma unroll
            for (int q = 0; q < 4; ++q) { const int row = 4 * r + q;
                const float* src = row < MR ? c.in[0] + (size_t)row * DM : c.in[1] + (size_t)(row - MR) * DM;
#pragma unroll
                for (int j = 0; j < 4; ++j) v[q][j] = __builtin_nontemporal_load((const f32x4*)(src + 256 * j + 4 * lane)); }
#pragma unroll
            for (int q = 0; q < 4; ++q) { u32x2* dst = (u32x2*)(c.b16(OFF_XB) + (size_t)(4 * r + q) * DM);
#pragma unroll
                for (int j = 0; j < 4; ++j) dst[64 * j + lane] = pk4(v[q][j]); }
            continue;
        }
        r -= T_XB;
        if (r < T_ROPE) {
            const int e = r * 64 + lane;
            if (e < TT * 144) {
                const int pos = e / 144, j = e % 144; float cs, sn;
                if (j < 16) { sincos_d((double)pos * p.inv0[j], cs, sn); c.f32(OFF_ROPE0C)[pos * 16 + j] = cs; c.f32(OFF_ROPE0S)[pos * 16 + j] = sn; }
                else { sincos_d((double)pos * p.inv1[j - 16], cs, sn); c.f32(OFF_ROPE1C)[pos * 128 + j - 16] = cs; c.f32(OFF_ROPE1S)[pos * 128 + j - 16] = sn; }
            }
            continue;
        }
        r -= T_ROPE;
        { const int ch = r * 64 + lane; const float lam = c.in[9][ch]; c.f32(OFF_CCH)[ch] = -8.f * log1pf(__expf(-lam)); }
    }
}

__device__ __forceinline__ void phase_conv(const Ctx& c, int bid, int nb) {
    const int tid = opaque_tid(), wid = tid >> 6, lane = tid & 63;
    const bf16_t* p0 = c.b16(OFF_P0); bf16_t* xc = c.b16(OFF_XC); bf16_t* Kb = c.b16(OFF_K);
    const float* cw = c.in[3]; const float* cb = c.in[4];
    const int ch0 = lane * 8;
    const int h = lane >> 3, d0 = (lane & 7) * 4, jj = d0 & 15;
    constexpr int RB = 4;
    for (int r0 = (bid * NWV + wid) * RB; r0 < MR + NMETA; r0 += nb * NWV * RB) {
        u32x4 x[RB][4]; u32x2 k1[RB], k2[RB]; f32x4 cs[RB], sn[RB];
#pragma unroll
        for (int q = 0; q < RB; ++q) {
            const int row = r0 + q;
#pragma unroll
            for (int w = 0; w < 4; ++w) {
                const int d = 3 - w; int srow = -1;
                if (row < MR) { const int sp = (row & (SEQ - 1)) - d; srow = sp >= 0 ? row - d : MR + NMETA + sp; }
                else { srow = (row - MR - d) >= 0 ? row - d : -1; }
                x[q][w] = srow >= 0 ? *(const u32x4*)(p0 + (size_t)srow * N_IN0 + 512 + ch0) : (u32x4){0u, 0u, 0u, 0u};
            }
            const int pos = row_pos(row);
            k1[q] = *(const u32x2*)(p0 + (size_t)row * N_IN0 + 1408 + jj); k2[q] = *(const u32x2*)(p0 + (size_t)row * N_IN0 + 1424 + jj);
            cs[q] = *(const f32x4*)(c.f32(OFF_ROPE0C) + pos * 16 + jj); sn[q] = *(const f32x4*)(c.f32(OFF_ROPE0S) + pos * 16 + jj);
        }
        f32x4 wq[4][2]; f32x4 bq[2];
#pragma unroll
        for (int w = 0; w < 4; ++w) { wq[w][0] = *(const f32x4*)(cw + w * 512 + ch0); wq[w][1] = *(const f32x4*)(cw + w * 512 + ch0 + 4); }
        bq[0] = *(const f32x4*)(cb + ch0); bq[1] = *(const f32x4*)(cb + ch0 + 4);
#pragma unroll
        for (int q = 0; q < RB; ++q) {
            const int row = r0 + q;
            f32x4 a0 = bq[0], a1 = bq[1];
#pragma unroll
            for (int w = 0; w < 4; ++w) { f32x4 lo, hi; unpk8(x[q][w], lo, hi); a0 += wq[w][0] * lo; a1 += wq[w][1] * hi; }
            *(u32x4*)(xc + (size_t)row * LRUW + ch0) = pk8(a0, a1);
            const f32x4 x1 = unpk4(k1[q]), x2 = unpk4(k2[q]);
            *(u32x2*)(Kb + (size_t)row * NQ + h * QKD + 64 + d0) = pk4(d0 < 16 ? x1 * cs[q] - x2 * sn[q] : x1 * sn[q] + x2 * cs[q]);
        }
    }
}

__device__ __forceinline__ f32x2 meta_state2(const Ctx& c, int ch) {
    f32x2 h = {0.f, 0.f}; const unsigned* ab = (const unsigned*)c.f32(OFF_ABMETA) + ch;
#pragma unroll
    for (int i = 0; i < NMETA; ++i) { const u32x2 w = *(const u32x2*)(ab + i * LRUW); h.x = (1.f - bf2f(w.x & 0xffffu)) * h.x + bf2f(w.x >> 16); h.y = (1.f - bf2f(w.y & 0xffffu)) * h.y + bf2f(w.y >> 16); }
    return h;
}
constexpr int SC_CH = 64, SC_NCK = SEQ / SC_CH;
__device__ __forceinline__ void phase_scan1(const Ctx& c, int bid, int nb) {
    const int tid = opaque_tid(), wid = tid >> 6, lane = tid & 63;
    for (int it = bid * NWV + wid; it < NBATCH * SC_NCK * 4; it += nb * NWV) {
        const int chg = it & 3, ck = (it >> 2) & (SC_NCK - 1), b = it >> 7, ch = chg * 128 + 2 * lane, row0 = b * SEQ + ck * SC_CH;
        const unsigned* ab = (const unsigned*)c.out + (size_t)row0 * LRUW + ch;
        f32x2 P = {1.f, 1.f}, S = {0.f, 0.f};
#pragma unroll 16
        for (int t = 0; t < SC_CH; ++t) { const u32x2 w = *(const u32x2*)(ab + (size_t)t * LRUW);
            const float a0 = 1.f - bf2f(w.x & 0xffffu), a1 = 1.f - bf2f(w.y & 0xffffu);
            S.x = a0 * S.x + bf2f(w.x >> 16); S.y = a1 * S.y + bf2f(w.y >> 16); P.x *= a0; P.y *= a1; }
        *(f32x4*)(c.f32(OFF_CARRY) + ((size_t)(b * SC_NCK + ck) * LRUW + ch) * 2) = (f32x4){P.x, S.x, P.y, S.y};
    }
}
__device__ __forceinline__ void scan1_local(const Ctx& c, int bid, int nb) {
    asm volatile("s_waitcnt vmcnt(0)" ::: "memory"); __syncthreads();
    const int tid = opaque_tid(), wid = tid >> 6, lane = tid & 63;
    pg8::StaticOrder S; S.init(MR, 1024, nb, bid);
    pg8::Unit u;
    for (int i = wid >> 2; S.next(i, u); i += 2) {
        const int b = u.pm >> 3, ck = (u.pm & 7) * 4 + (wid & 3), ch = u.pn * 128 + 2 * lane, row0 = b * SEQ + ck * SC_CH;
        const unsigned* ab = (const unsigned*)c.out + (size_t)row0 * LRUW + ch;
        f32x2 P = {1.f, 1.f}, Sm = {0.f, 0.f};
#pragma unroll 16
        for (int t = 0; t < SC_CH; ++t) { const u32x2 w = *(const u32x2*)(ab + (size_t)t * LRUW);
            const float a0 = 1.f - bf2f(w.x & 0xffffu), a1 = 1.f - bf2f(w.y & 0xffffu);
            Sm.x = a0 * Sm.x + bf2f(w.x >> 16); Sm.y = a1 * Sm.y + bf2f(w.y >> 16); P.x *= a0; P.y *= a1; }
        *(f32x4*)(c.f32(OFF_CARRY) + ((size_t)(b * SC_NCK + ck) * LRUW + ch) * 2) = (f32x4){P.x, Sm.x, P.y, Sm.y};
    }
}
__device__ __forceinline__ void phase_scan2(const Ctx& c, int bid, int nb) {
    const int tid = opaque_tid(), wid = tid >> 6, lane = tid & 63;
    const bf16_t* p0 = c.b16(OFF_P0); bf16_t* mix = c.b16(OFF_MIX);
    for (int it = bid * NWV + wid; it < NBATCH * SC_NCK * 4 + 4; it += nb * NWV) {
        if (it >= NBATCH * SC_NCK * 4) {
            const int ch = (it - NBATCH * SC_NCK * 4) * 128 + 2 * lane; f32x2 h = {0.f, 0.f};
            const unsigned* ab = (const unsigned*)c.f32(OFF_ABMETA) + ch;
            for (int i = 0; i < NMETA; ++i) { const u32x2 w = *(const u32x2*)(ab + i * LRUW); h.x = (1.f - bf2f(w.x & 0xffffu)) * h.x + bf2f(w.x >> 16); h.y = (1.f - bf2f(w.y & 0xffffu)) * h.y + bf2f(w.y >> 16);
                const int row = MR + i; const unsigned gt = *(const unsigned*)(p0 + (size_t)row * N_IN0 + ch);
                *(unsigned*)(mix + (size_t)row * DM + ch) = pk2(h.x * gelu_tanh(bf2f(gt & 0xffffu)), h.y * gelu_tanh(bf2f(gt >> 16))); }
            continue;
        }
        const int chg = it & 3, ck = (it >> 2) & (SC_NCK - 1), b = it >> 7, ch = chg * 128 + 2 * lane, row0 = b * SEQ + ck * SC_CH;
        f32x2 h = meta_state2(c, ch);
        const float* cr = c.f32(OFF_CARRY) + ((size_t)(b * SC_NCK) * LRUW + ch) * 2;
        for (int k0 = 0; k0 < ck; k0 += 8) {
            f32x4 ps[8];
#pragma unroll
            for (int j = 0; j < 8; ++j) ps[j] = *(const f32x4*)(cr + (size_t)min(k0 + j, SC_NCK - 1) * LRUW * 2);
#pragma unroll
            for (int j = 0; j < 8; ++j) if (k0 + j < ck) { h.x = ps[j][0] * h.x + ps[j][1]; h.y = ps[j][2] * h.y + ps[j][3]; }
        }
        const unsigned* ab = (const unsigned*)c.out + (size_t)row0 * LRUW + ch;
        for (int t0 = 0; t0 < SC_CH; t0 += 16) {
            u32x2 w[16]; unsigned gt[16];
#pragma unroll
            for (int t = 0; t < 16; ++t) { w[t] = *(const u32x2*)(ab + (size_t)(t0 + t) * LRUW); gt[t] = *(const unsigned*)(p0 + (size_t)(row0 + t0 + t) * N_IN0 + ch); }
#pragma unroll
            for (int t = 0; t < 16; ++t) {
                h.x = (1.f - bf2f(w[t].x & 0xffffu)) * h.x + bf2f(w[t].x >> 16); h.y = (1.f - bf2f(w[t].y & 0xffffu)) * h.y + bf2f(w[t].y >> 16);
                *(unsigned*)(mix + (size_t)(row0 + t0 + t) * DM + ch) = pk2(h.x * gelu_tanh(bf2f(gt[t] & 0xffffu)), h.y * gelu_tanh(bf2f(gt[t] >> 16)));
            }
        }
    }
}

__device__ __forceinline__ void phase_attn_naive(const Ctx& c, int bid, int nb, bool meta_only) {
    const int tid = opaque_tid(), wid = tid >> 6, lane = tid & 63;
    const bf16_t* Q = c.b16(OFF_Q); const bf16_t* K = c.b16(OFF_K); const bf16_t* V = c.b16(OFF_V); bf16_t* mix = c.b16(OFF_MIX);
    const long nitems = (long)NBATCH * MLA_H * SEQ + MLA_H * NMETA;
    for (long it = (meta_only ? (long)NBATCH * MLA_H * SEQ : 0) + (long)bid * NWV + wid; it < nitems; it += (long)nb * NWV) {
        int b, h, s, qrow;
        if (it < (long)NBATCH * MLA_H * SEQ) { s = (int)(it & (SEQ - 1)); h = (int)((it >> 11) & 7); b = (int)(it >> 14); qrow = b * SEQ + s; }
        else { const int r = (int)(it - (long)NBATCH * MLA_H * SEQ); s = r & 15; h = r >> 4; b = -1; qrow = MR + s; }
        float q[QKD];
#pragma unroll
        for (int j = 0; j < QKD / 8; ++j) { const u32x4 w = *(const u32x4*)(Q + (size_t)qrow * NQ + h * QKD + 8 * j);
            q[8 * j] = bf2f(w.x & 0xffffu); q[8 * j + 1] = bf2f(w.x >> 16); q[8 * j + 2] = bf2f(w.y & 0xffffu); q[8 * j + 3] = bf2f(w.y >> 16);
            q[8 * j + 4] = bf2f(w.z & 0xffffu); q[8 * j + 5] = bf2f(w.z >> 16); q[8 * j + 6] = bf2f(w.w & 0xffffu); q[8 * j + 7] = bf2f(w.w >> 16); }
        float m = -1e30f, l = 0.f, o = 0.f;
        const int ntile = b < 0 ? 1 : 2 + (s >> 6);
        for (int t = 0; t < ntile; ++t) {
            int krow0, nvalid;
            if (t == 0) { krow0 = MR; nvalid = b < 0 ? s + 1 : NMETA; } else { krow0 = b * SEQ + 64 * (t - 1); nvalid = min(64, s + 1 - 64 * (t - 1)); }
            const bool valid = lane < nvalid;
            float sv = 0.f;
            { const bf16_t* kp = K + (size_t)(krow0 + lane) * NQ + h * QKD;
#pragma unroll
              for (int j = 0; j < QKD / 8; ++j) { const u32x4 w = *(const u32x4*)(kp + 8 * j);
                sv += q[8 * j] * bf2f(w.x & 0xffffu) + q[8 * j + 1] * bf2f(w.x >> 16) + q[8 * j + 2] * bf2f(w.y & 0xffffu) + q[8 * j + 3] * bf2f(w.y >> 16)
                    + q[8 * j + 4] * bf2f(w.z & 0xffffu) + q[8 * j + 5] * bf2f(w.z >> 16) + q[8 * j + 6] * bf2f(w.w & 0xffffu) + q[8 * j + 7] * bf2f(w.w >> 16); } }
            if (!valid) sv = -1e30f;
            const float mn = fmaxf(m, wave_max(sv)), f = exp2f(m - mn), pv = valid ? exp2f(sv - mn) : 0.f;
            l = l * f + wave_sum(pv); o *= f; m = mn;
            for (int k = 0; k < nvalid; ++k) { const float pk = __shfl(pv, k); o += pk * bf2f(V[(size_t)(krow0 + k) * NV + h * VD + lane]); }
        }
        mix[(size_t)qrow * DM + 512 + h * VD + lane] = (bf16_t)(pk2(o / l, 0.f) & 0xffffu);
    }
}

typedef float f32x16 __attribute__((ext_vector_type(16)));
typedef short v4i16_t __attribute__((ext_vector_type(4)));
__device__ __forceinline__ int crow(int r, int hi) { return (r & 3) + 8 * (r >> 2) + 4 * hi; }
__device__ __forceinline__ float max_x32(float v) { const u32x2 r = __builtin_amdgcn_permlane32_swap(__float_as_uint(v), __float_as_uint(v), false, false); return fmaxf(__uint_as_float(r.x), __uint_as_float(r.y)); }
__device__ __forceinline__ float sum_x32(float v) { const u32x2 r = __builtin_amdgcn_permlane32_swap(__float_as_uint(v), __float_as_uint(v), false, false); return __uint_as_float(r.x) + __uint_as_float(r.y); }
__device__ __forceinline__ bf16x8 tr_pair(const LAS unsigned char* p0, const LAS unsigned char* p1) {
    const v4i16_t a = __builtin_amdgcn_ds_read_tr16_b64_v4i16((LAS v4i16_t*)p0), b = __builtin_amdgcn_ds_read_tr16_b64_v4i16((LAS v4i16_t*)p1);
    return (bf16x8){a[0], a[1], a[2], a[3], b[0], b[1], b[2], b[3]};
}
constexpr int AT_KPITCH = 208, AT_KBYTES = 64 * AT_KPITCH  , AT_VBYTES = 8192, AT_BUF = AT_KBYTES + AT_VBYTES;
__device__ __forceinline__ void attn_unit(const Ctx& c, LAS unsigned char* lds, int b, int h, int qbA) {
    const int tid = opaque_tid(), lane = tid & 63, wid = __builtin_amdgcn_readfirstlane(tid >> 6), r32 = lane & 31, hi = lane >> 5;
    const bf16_t* Q = c.b16(OFF_Q); const bf16_t* K = c.b16(OFF_K) + h * QKD; const bf16_t* V = c.b16(OFF_V) + h * VD; bf16_t* mix = c.b16(OFF_MIX);
    const int qbB = qbA - 1;
    const int qrel = 32 * wid + r32;
    const size_t qrowA = (size_t)b * SEQ + 256 * qbA + qrel, qrowB = qrowA - 256;
    bf16x8 qA[6], qB[6];
#pragma unroll
    for (int d0 = 0; d0 < 6; ++d0) { qA[d0] = *(const bf16x8*)(Q + qrowA * NQ + h * QKD + 16 * d0 + 8 * hi); qB[d0] = *(const bf16x8*)(Q + qrowB * NQ + h * QKD + 16 * d0 + 8 * hi); }
    const int kp0 = tid, kp1 = tid + 512; const bool k1ok = tid < 256;
    const int kr0 = kp0 / 12, kc0 = kp0 % 12, kr1 = k1ok ? kp1 / 12 : 0, kc1 = k1ok ? kp1 % 12 : 0;
    const int vr = tid >> 3, vc = tid & 7;
    const unsigned kdst0 = kr0 * AT_KPITCH + kc0 * 16, kdst1 = kr1 * AT_KPITCH + kc1 * 16, vdst = AT_KBYTES + (vc >> 2) * 4096 + vr * 64 + (vc & 3) * 16;
    u32x4 kgA0, kgA1, vgA;
    const int NT = 4 * qbA + 5, NTB = NT - 4;
#define AT_GLOAD(t, S) do { const size_t base_ = (t) == 0 ? (size_t)MR : (size_t)b * SEQ + 64 * ((t) - 1); \
        kg##S##0 = *(const u32x4*)(K + (base_ + kr0) * NQ + 8 * kc0); if (k1ok) kg##S##1 = *(const u32x4*)(K + (base_ + kr1) * NQ + 8 * kc1); \
        vg##S = *(const u32x4*)(V + (base_ + vr) * NV + 8 * vc); \
        if ((t) == 0) { const u32x4 z_ = (u32x4){0u, 0u, 0u, 0u}; if (kr0 >= NMETA) kg##S##0 = z_; if (kr1 >= NMETA) kg##S##1 = z_; if (vr >= NMETA) vg##S = z_; } } while (0)
#define AT_LWRITE(buf, S) do { LAS unsigned char* d_ = lds + (buf) * AT_BUF; *(LAS u32x4*)(d_ + kdst0) = kg##S##0; if (k1ok) *(LAS u32x4*)(d_ + kdst1) = kg##S##1; *(LAS u32x4*)(d_ + vdst) = vg##S; } while (0)
#define AT_BAR() do { asm volatile("s_waitcnt lgkmcnt(0)" ::: "memory"); __builtin_amdgcn_s_barrier(); asm volatile("" ::: "memory"); } while (0)
    f32x16 oA0, oA1, oB0, oB1;
#pragma unroll
    for (int r = 0; r < 16; ++r) { oA0[r] = 0.f; oA1[r] = 0.f; oB0[r] = 0.f; oB1[r] = 0.f; }
    float mA = 0.f, lA = 0.f, mB = 0.f, lB = 0.f;
    f32x16 nmA, nmB;
#pragma unroll
    for (int r = 0; r < 16; ++r) { nmA[r] = 0.f; nmB[r] = 0.f; }
    AT_GLOAD(0, A); AT_LWRITE(0, A);
    AT_BAR();
    const unsigned kfo = r32 * AT_KPITCH + hi * 16;
    const unsigned vfo = AT_KBYTES + ((lane >> 4) & 1) * 32 + (lane & 3) * 8 + (4 * hi + ((lane & 15) >> 2)) * 64;
#define AT_COMPUTE(t, X) do { \
        const int jb = (t) - 1 - 4 * qb##X; \
        if (jb < 0 || 64 * jb <= 32 * wid + 31) { \
            const LAS unsigned char* bufp = lds + ((t) & 1) * AT_BUF; \
            f32x16 p0, p1; \
            bf16x8 kfa[3], kfb[3]; \
            kfa[0] = *(const LAS bf16x8*)(bufp + kfo); kfb[0] = *(const LAS bf16x8*)(bufp + kfo + 32 * AT_KPITCH); \
            kfa[1] = *(const LAS bf16x8*)(bufp + kfo + 32); kfb[1] = *(const LAS bf16x8*)(bufp + kfo + 32 * AT_KPITCH + 32); \
            __builtin_amdgcn_sched_group_barrier(0x100, 4, 0); \
              \
            kfa[2] = *(const LAS bf16x8*)(bufp + kfo + 64); kfb[2] = *(const LAS bf16x8*)(bufp + kfo + 32 * AT_KPITCH + 64); \
            p0 = __builtin_amdgcn_mfma_f32_32x32x16_bf16(kfa[0], q##X[0], nm##X, 0, 0, 0); \
            p1 = __builtin_amdgcn_mfma_f32_32x32x16_bf16(kfb[0], q##X[0], nm##X, 0, 0, 0); \
            __builtin_amdgcn_sched_group_barrier(0x100, 2, 0); __builtin_amdgcn_sched_group_barrier(0x008, 2, 0); \
            _Pragma("unroll") for (int d0 = 1; d0 < 4; ++d0) { \
                kfa[(d0 + 2) % 3] = *(const LAS bf16x8*)(bufp + kfo + (d0 + 2) * 32); kfb[(d0 + 2) % 3] = *(const LAS bf16x8*)(bufp + kfo + 32 * AT_KPITCH + (d0 + 2) * 32); \
                p0 = __builtin_amdgcn_mfma_f32_32x32x16_bf16(kfa[d0 % 3], q##X[d0], p0, 0, 0, 0); \
                p1 = __builtin_amdgcn_mfma_f32_32x32x16_bf16(kfb[d0 % 3], q##X[d0], p1, 0, 0, 0); \
                __builtin_amdgcn_sched_group_barrier(0x100, 2, 0); __builtin_amdgcn_sched_group_barrier(0x008, 2, 0); } \
            _Pragma("unroll") for (int d0 = 4; d0 < 6; ++d0) { \
                p0 = __builtin_amdgcn_mfma_f32_32x32x16_bf16(kfa[d0 % 3], q##X[d0], p0, 0, 0, 0); \
                p1 = __builtin_amdgcn_mfma_f32_32x32x16_bf16(kfb[d0 % 3], q##X[d0], p1, 0, 0, 0); \
                __builtin_amdgcn_sched_group_barrier(0x008, 2, 0); } \
            if ((t) == 0) { asm volatile("" ::: "memory"); \
                _Pragma("unroll") for (int r = 0; r < 16; ++r) { if (crow(r, hi) >= NMETA) p0[r] = -1e30f; p1[r] = -1e30f; } \
            } else if (jb >= 0) { asm volatile("" ::: "memory"); \
                _Pragma("unroll") for (int r = 0; r < 16; ++r) { const int kv = 64 * jb + crow(r, hi); if (kv > qrel) p0[r] = -1e30f; if (kv + 32 > qrel) p1[r] = -1e30f; } } \
            float rmA_ = fmaxf(p0[0], p1[0]), rmB_ = fmaxf(p0[1], p1[1]); \
            _Pragma("unroll") for (int r = 2; r < 16; r += 2) { rmA_ = fmaxf(fmaxf(rmA_, p0[r]), p1[r]); rmB_ = fmaxf(fmaxf(rmB_, p0[r + 1]), p1[r + 1]); }        \
            float rm = fmaxf(rmA_, rmB_); \
            rm = max_x32(rm);                                                            \
              \
            if ((t) == 0 || !__all(rm <= 8.f)) { asm volatile("" ::: "memory"); \
                const float dl = (t) == 0 ? rm : fmaxf(rm, 0.f), f = (t) == 0 ? 1.f : __builtin_amdgcn_exp2f(-dl); m##X += dl; l##X *= f; \
                _Pragma("unroll") for (int r = 0; r < 16; ++r) { o##X##0[r] *= f; o##X##1[r] *= f; p0[r] -= dl; p1[r] -= dl; nm##X[r] = -m##X; } } \
            f32x2 ls2 = {0.f, 0.f};                                                      \
            _Pragma("unroll") for (int r = 0; r < 16; r += 2) { \
                const f32x2 e0 = {__builtin_amdgcn_exp2f(p0[r]), __builtin_amdgcn_exp2f(p0[r + 1])}, e1 = {__builtin_amdgcn_exp2f(p1[r]), __builtin_amdgcn_exp2f(p1[r + 1])}; \
                p0[r] = e0.x; p0[r + 1] = e0.y; p1[r] = e1.x; p1[r + 1] = e1.y; ls2 += e0; ls2 += e1; } \
            l##X += ls2.x + ls2.y; \
            u32x4 pw[4]; \
            _Pragma("unroll") for (int q4 = 0; q4 < 4; ++q4) { pw[0][q4] = pk2(p0[2 * q4], p0[2 * q4 + 1]); pw[1][q4] = pk2(p0[8 + 2 * q4], p0[9 + 2 * q4]); pw[2][q4] = pk2(p1[2 * q4], p1[2 * q4 + 1]); pw[3][q4] = pk2(p1[8 + 2 * q4], p1[9 + 2 * q4]); } \
            _Pragma("unroll") for (int s4 = 0; s4 < 4; ++s4) { \
                const bf16x8 pf = __builtin_bit_cast(bf16x8, pw[s4]); \
                const bf16x8 v0 = tr_pair(bufp + vfo + s4 * 1024, bufp + vfo + s4 * 1024 + 512); \
                const bf16x8 v1 = tr_pair(bufp + vfo + 4096 + s4 * 1024, bufp + vfo + 4096 + s4 * 1024 + 512); \
                o##X##0 = __builtin_amdgcn_mfma_f32_32x32x16_bf16(v0, pf, o##X##0, 0, 0, 0); \
                o##X##1 = __builtin_amdgcn_mfma_f32_32x32x16_bf16(v1, pf, o##X##1, 0, 0, 0); } \
        } } while (0)
    for (int t = 0; t < NT; ++t) {
        if (t + 1 < NT) AT_GLOAD(t + 1, A);
        AT_COMPUTE(t, A);
        if (t < NTB) AT_COMPUTE(t, B);
        if (t + 1 < NT) AT_LWRITE((t + 1) & 1, A);
        AT_BAR();
    }
    asm volatile("s_waitcnt vmcnt(0)" ::: "memory");
#undef AT_GLOAD
#undef AT_LWRITE
#undef AT_COMPUTE
#undef AT_BAR
#define AT_OUT_HALF(O, off_) do { u32x2 W_[4]; \
        _Pragma("unroll") for (int g = 0; g < 4; ++g) W_[g] = pk4((f32x4){O[4 * g] * inv, O[4 * g + 1] * inv, O[4 * g + 2] * inv, O[4 * g + 3] * inv}); \
        _Pragma("unroll") for (int q = 0; q < 2; ++q) { \
            const u32x2 r0 = __builtin_amdgcn_permlane32_swap(W_[q][0], W_[2 + q][0], false, false), r1 = __builtin_amdgcn_permlane32_swap(W_[q][1], W_[2 + q][1], false, false); \
            *(u32x4*)(orow + (off_) + 8 * q) = (u32x4){r0.x, r1.x, r0.y, r1.y}; } } while (0)
#define AT_OUT(X) do { const float inv = frcp(sum_x32(l##X)); bf16_t* orow = mix + qrow##X * DM + 512 + h * VD + 16 * hi; \
        AT_OUT_HALF(o##X##0, 0); AT_OUT_HALF(o##X##1, 32); } while (0)
    AT_OUT(A); AT_OUT(B);
#undef AT_OUT
#undef AT_OUT_HALF
}
__device__ __forceinline__ void phase_attn_fast(const Ctx& c, LAS unsigned char* lds, int bid, int nb) {
    const int vcu = (nb % 8 == 0) ? (bid % 8) * (nb / 8) + bid / 8 : bid;
    for (int slot = vcu; slot < 256; slot += nb) {
        const int bh = slot >> 1, p = slot & 1;
        attn_unit(c, lds, bh >> 3, bh & 7, 7 - 2 * p);
        attn_unit(c, lds, bh >> 3, bh & 7, 1 + 2 * p);
    }
}

__device__ __forceinline__ void phase_ret_naive(const Ctx& c, LAS unsigned char* lds, int bid, int nb) {
    const int tid = opaque_tid(), wid = tid >> 6, lane = tid & 63;
    const bf16_t* Q1 = c.b16(OFF_Q1); const bf16_t* K1 = c.b16(OFF_K1); const bf16_t* V1 = c.b16(OFF_V1); bf16_t* G1 = c.b16(OFF_G1);
    LAS float* qs = (LAS float*)(lds + wid * 1024);
    const long nitems = (long)NBATCH * RET_H * SEQ;
    for (long it = (long)bid * NWV + wid; it < nitems; it += (long)nb * NWV) {
        const int s = (int)(it & (SEQ - 1)), h = (int)((it >> 11) & 3), b = (int)(it >> 13), qrow = b * SEQ + s;
        { const u32x2 w = *(const u32x2*)(Q1 + (size_t)qrow * 1024 + h * RDK + 4 * lane); const f32x4 f = unpk4(w); qs[4 * lane] = f[0]; qs[4 * lane + 1] = f[1]; qs[4 * lane + 2] = f[2]; qs[4 * lane + 3] = f[3]; }
        asm volatile("s_waitcnt lgkmcnt(0)" ::: "memory");
        const float lg2 = log2f(1.f - exp2f(-5.f - (float)h));
        float o[8];
#pragma unroll
        for (int e = 0; e < 8; ++e) o[e] = 0.f;
        const int ntile = 2 + (s >> 6), qpos = NMETA + s;
        for (int t = 0; t < ntile; ++t) {
            int krow0, nvalid, kpos0;
            if (t == 0) { krow0 = MR; nvalid = NMETA; kpos0 = 0; } else { krow0 = b * SEQ + 64 * (t - 1); nvalid = min(64, s + 1 - 64 * (t - 1)); kpos0 = NMETA + 64 * (t - 1); }
            float sv = 0.f;
            { const bf16_t* kp = K1 + (size_t)(krow0 + lane) * 1024 + h * RDK;
#pragma unroll 4
              for (int j = 0; j < RDK / 8; ++j) { const u32x4 w = *(const u32x4*)(kp + 8 * j); const LAS float* qq = qs + 8 * j;
                sv += qq[0] * bf2f(w.x & 0xffffu) + qq[1] * bf2f(w.x >> 16) + qq[2] * bf2f(w.y & 0xffffu) + qq[3] * bf2f(w.y >> 16)
                    + qq[4] * bf2f(w.z & 0xffffu) + qq[5] * bf2f(w.z >> 16) + qq[6] * bf2f(w.w & 0xffffu) + qq[7] * bf2f(w.w >> 16); } }
            const float wv = lane < nvalid ? sv * exp2f(lg2 * (float)(qpos - kpos0 - lane)) : 0.f;
            for (int k = 0; k < nvalid; ++k) { const float wk = __shfl(wv, k); const u32x4 w = *(const u32x4*)(V1 + (size_t)(krow0 + k) * RMIX + h * RDV + 8 * lane);
                o[0] += wk * bf2f(w.x & 0xffffu); o[1] += wk * bf2f(w.x >> 16); o[2] += wk * bf2f(w.y & 0xffffu); o[3] += wk * bf2f(w.y >> 16);
                o[4] += wk * bf2f(w.z & 0xffffu); o[5] += wk * bf2f(w.z >> 16); o[6] += wk * bf2f(w.w & 0xffffu); o[7] += wk * bf2f(w.w >> 16); }
        }
        float ss = 0.f;
#pragma unroll
        for (int e = 0; e < 8; ++e) ss += o[e] * o[e];
        const float rstd = frsq(wave_sum(ss) * (1.f / RDV) + LN_EPS);
        bf16_t* gp = G1 + (size_t)qrow * RMIX + h * RDV + 8 * lane; const u32x4 gw = *(const u32x4*)gp;
        u32x4 r; r.x = pk2(bf2f(gw.x & 0xffffu) * o[0] * rstd, bf2f(gw.x >> 16) * o[1] * rstd); r.y = pk2(bf2f(gw.y & 0xffffu) * o[2] * rstd, bf2f(gw.y >> 16) * o[3] * rstd);
        r.z = pk2(bf2f(gw.z & 0xffffu) * o[4] * rstd, bf2f(gw.z >> 16) * o[5] * rstd); r.w = pk2(bf2f(gw.w & 0xffffu) * o[6] * rstd, bf2f(gw.w >> 16) * o[7] * rstd);
        *(u32x4*)gp = r;
    }
}

__device__ __forceinline__ unsigned off_b(unsigned row, unsigned ch) { return 256u * row + 16u * (ch ^ (((row & 3) << 2) | ((row >> 2) & 3))); }
constexpr int LDS_MISC = 161792, LDS_BYTES = 163840;
constexpr int RT_Q = 0, RT_K = 32768, RT_V = 65536, RT_ST = 81920, RT_P = 147456, RT_END = 163840;
__device__ __forceinline__ void ret_unit(const Ctx& c, LAS unsigned char* lds, int b, int h, int sl) {
    const int tid0 = opaque_tid(), wid = __builtin_amdgcn_readfirstlane(tid0 >> 6); int tid = tid0, lane = tid & 63, r32 = lane & 31, hi = lane >> 5;
    const int wi = wid >> 2, wdv = wid & 3;
    const int wd = (wid >> 1) & 1, wk = ((wid >> 2) << 1) | (wid & 1);
    const bf16_t* Q1 = c.b16(OFF_Q1) + h * RDK; const bf16_t* K1 = c.b16(OFF_K1) + h * RDK; bf16_t* V1 = c.b16(OFF_V1) + h * RDV + sl * 128;
    float* osq = c.out;
    const float lg2 = log2f(1.f - exp2f(-5.f - (float)h));
    const float g64 = exp2f(lg2 * 64.f);
    const int il = 32 * wi + r32;
    const float rowscale = exp2f(lg2 * (float)(il - 63));
    u32x4 gq[4], gk[4], gv[2];
    f32x16 S[2][2];
#pragma unroll
    for (int a = 0; a < 2; ++a)
#pragma unroll
        for (int bb = 0; bb < 2; ++bb)
#pragma unroll
            for (int r = 0; r < 16; ++r) S[a][bb][r] = 0.f;
#define RT_GLOAD(cc) do { const size_t base_ = (cc) == 0 ? (size_t)MR : (size_t)b * SEQ + 64 * ((cc) - 1); \
        _Pragma("unroll") for (int k_ = 0; k_ < 4; ++k_) { const int p_ = tid + 512 * k_; gq[k_] = *(const u32x4*)(Q1 + (base_ + (p_ >> 5)) * 1024 + 8 * (p_ & 31)); gk[k_] = *(const u32x4*)(K1 + (base_ + (p_ >> 5)) * 1024 + 8 * (p_ & 31)); } \
        _Pragma("unroll") for (int k_ = 0; k_ < 2; ++k_) { const int p_ = tid + 512 * k_; gv[k_] = *(const u32x4*)(V1 + (base_ + (p_ >> 4)) * RMIX + 8 * (p_ & 15)); } } while (0)
#define RT_LWRITE(cc) do { const int L_ = (cc) == 0 ? NMETA : 64; \
        _Pragma("unroll") for (int k_ = 0; k_ < 4; ++k_) { const int p_ = tid + 512 * k_, row_ = p_ >> 5, ch_ = p_ & 31; const unsigned o_ = (ch_ >> 4) * 16384 + off_b(row_, ch_ & 15); \
            const bool ok_ = row_ < L_; const u32x4 z_ = (u32x4){0u, 0u, 0u, 0u}; \
            *(LAS u32x4*)(lds + RT_Q + o_) = ok_ ? gq[k_] : z_; *(LAS u32x4*)(lds + RT_K + o_) = ok_ ? gk[k_] : z_; } \
        _Pragma("unroll") for (int k_ = 0; k_ < 2; ++k_) { const int p_ = tid + 512 * k_, row_ = p_ >> 4, ch_ = p_ & 15; \
            const float fc_ = (cc) == 0 ? (row_ < NMETA ? exp2f(lg2 * (float)(NMETA - 1 - row_)) : 0.f) : fcv[k_]; const u32x4 w_ = gv[k_]; u32x4 r_; \
            r_.x = pk2(bf2f(w_.x & 0xffffu) * fc_, bf2f(w_.x >> 16) * fc_); r_.y = pk2(bf2f(w_.y & 0xffffu) * fc_, bf2f(w_.y >> 16) * fc_); \
            r_.z = pk2(bf2f(w_.z & 0xffffu) * fc_, bf2f(w_.z >> 16) * fc_); r_.w = pk2(bf2f(w_.w & 0xffffu) * fc_, bf2f(w_.w >> 16) * fc_); \
            *(LAS u32x4*)(lds + RT_V + off_b(row_, ch_)) = r_; } } while (0)
    const float fcv[2] = {exp2f(lg2 * (float)(63 - (tid0 >> 4))), exp2f(lg2 * (float)(31 - (tid0 >> 4)))};
    for (int i = tid; i < 65536 / 16; i += 512) *(LAS u32x4*)(lds + RT_ST + i * 16) = (u32x4){0u, 0u, 0u, 0u};
    RT_GLOAD(0); RT_LWRITE(0);
    __syncthreads();
    u32x4 ga = (u32x4){0u, 0u, 0u, 0u}, gb = ga;
    const int jb = wdv & 1, dkh = wdv >> 1;
    const bool pact = wi == 1 || jb == 0;
    unsigned bq_own, bs_own, bs_oth, bk_own, bpw, bk0, bk1, bv0, bv1, bpr, bsw0, bsw1, blq, blv, voffq, voffv, voffg, voffo;
    {
        const unsigned l0 = tid0 & 63, r0 = l0 & 31, h50 = l0 >> 5, blk0 = (l0 >> 4) & 1, q40 = (l0 & 15) >> 2, p30 = l0 & 3;
        bq_own = RT_Q + dkh * 16384 + off_b(32 * wi + r0, h50);
        bs_own = RT_ST + dkh * 32768 + off_b(32 * wdv + r0, h50); bs_oth = RT_ST + (1 - dkh) * 32768 + off_b(32 * wdv + r0, h50);
        bk_own = RT_K + dkh * 16384 + off_b(32 * jb + r0, h50);
        bpw = RT_P + off_b(32 * wi + r0, 8 * dkh + 4 * jb) + 8 * h50;
        const unsigned c0 = 8 * (wk & 1) + 2 * blk0 + (p30 >> 1), cv0 = 8 * wd + 2 * blk0 + (p30 >> 1), sw = wdv & 1;
        bk0 = RT_K + (wk >> 1) * 16384 + off_b(8 * h50 + q40, c0) + 8 * (p30 & 1); bk1 = RT_K + (wk >> 1) * 16384 + off_b(8 * h50 + 4 + q40, c0) + 8 * (p30 & 1);
        bv0 = (RT_V + off_b(8 * h50 + q40, cv0) + 8 * (p30 & 1)) ^ (sw << 6); bv1 = (RT_V + off_b(8 * h50 + 4 + q40, cv0) + 8 * (p30 & 1)) ^ (sw << 6);
        bpr = RT_P + off_b(32 * wi + r0, h50);
        bsw0 = RT_ST + (wk >> 1) * 32768 + off_b(64 * wd + r0, 8 * (wk & 1)) + 8 * h50 + 8192 * sw; bsw1 = bsw0 + 8192 - 16384 * sw;
        blq = RT_Q + ((tid0 & 31) >> 4) * 16384 + off_b(tid0 >> 5, tid0 & 15);
        blv = RT_V + off_b(tid0 >> 4, tid0 & 15);
        voffq = (unsigned)(tid0 >> 5) * 2048u + (unsigned)(tid0 & 31) * 16u;
        voffv = (unsigned)(tid0 >> 4) * 4096u + (unsigned)(tid0 & 15) * 16u;
        voffg = (unsigned)(32 * wi + r0) * 4096u + (unsigned)(32 * wdv + 16 * h50) * 2u;
        voffo = (unsigned)(32 * wi + r0) * 256u + (unsigned)wdv * 4u;
    }
    const __amdgpu_buffer_rsrc_t rsQ = __builtin_amdgcn_make_buffer_rsrc((void*)Q1, 0, 0x7fffffff, 0x00020000), rsK = __builtin_amdgcn_make_buffer_rsrc((void*)K1, 0, 0x7fffffff, 0x00020000),
        rsV = __builtin_amdgcn_make_buffer_rsrc((void*)V1, 0, 0x7fffffff, 0x00020000), rsG = __builtin_amdgcn_make_buffer_rsrc((void*)(c.b16(OFF_G1) + h * RDV + sl * 128), 0, 0x7fffffff, 0x00020000);
    for (int cc = 0; cc <= 32; ++cc) {
        const bool more = cc < 32;
        tid = tid0; asm volatile("" : "+v"(tid)); lane = tid & 63; r32 = lane & 31; hi = lane >> 5;
        asm volatile("" : "+v"(bq_own), "+v"(bs_own), "+v"(bs_oth), "+v"(bk_own), "+v"(bpw), "+v"(bk0), "+v"(bk1), "+v"(bv0));
        asm volatile("" : "+v"(bv1), "+v"(bpr), "+v"(bsw0), "+v"(bsw1), "+v"(blq), "+v"(blv));
        asm volatile("" : "+v"(voffq), "+v"(voffv), "+v"(voffg), "+v"(voffo));
        f32x16 Pp, acc;
#pragma unroll
        for (int r = 0; r < 16; ++r) { Pp[r] = 0.f; acc[r] = 0.f; }
        {
            bf16x8 fq_[3], fk_[3], fs_[3];
#define RT_FR(u, slot) do { const unsigned x_ = (unsigned)((u) & 7) << 5; \
            fq_[slot] = *(const LAS bf16x8*)(lds + (bq_own ^ ((u) < 8 ? x_ : (x_ | 0x4000u)))); fs_[slot] = *(const LAS bf16x8*)(lds + (((u) < 8 ? bs_own : bs_oth) ^ x_)); \
            if ((u) < 8) fk_[slot] = *(const LAS bf16x8*)(lds + (bk_own ^ x_)); } while (0)
            RT_FR(0, 0); RT_FR(1, 1);
            __builtin_amdgcn_sched_group_barrier(0x100, 6, 0);
#define RT_ST1(u, nr, nm) do { if ((u) + 2 < 16) RT_FR((u) + 2, ((u) + 2) % 3); \
                if ((u) < 8) Pp = __builtin_amdgcn_mfma_f32_32x32x16_bf16(fk_[(u) % 3], fq_[(u) % 3], Pp, 0, 0, 0); \
                acc = __builtin_amdgcn_mfma_f32_32x32x16_bf16(fs_[(u) % 3], fq_[(u) % 3], acc, 0, 0, 0); \
                if ((nr) > 0) __builtin_amdgcn_sched_group_barrier(0x100, (nr), 0); \
                __builtin_amdgcn_sched_group_barrier(0x008, (nm), 0); } while (0)
#pragma unroll
            for (int u = 0; u < 6; ++u) RT_ST1(u, 3, 2);
#pragma unroll
            for (int u = 6; u < 8; ++u) RT_ST1(u, 2, 2);
#pragma unroll
            for (int u = 8; u < 14; ++u) RT_ST1(u, 2, 1);
#pragma unroll
            for (int u = 14; u < 16; ++u) RT_ST1(u, 0, 1);
#undef RT_ST1
#undef RT_FR
        }
        {
            const unsigned sq_ = (unsigned)(b * SEQ + 64 * cc) * 2048u, sv_ = (unsigned)(b * SEQ + 64 * cc) * 4096u;
#pragma unroll
            for (int k_ = 0; k_ < 4; ++k_) { gq[k_] = __builtin_amdgcn_raw_buffer_load_b128(rsQ, voffq, sq_ + k_ * 32768u, 0); gk[k_] = __builtin_amdgcn_raw_buffer_load_b128(rsK, voffq, sq_ + k_ * 32768u, 0); }
#pragma unroll
            for (int k_ = 0; k_ < 2; ++k_) gv[k_] = __builtin_amdgcn_raw_buffer_load_b128(rsV, voffv, sv_ + k_ * 131072u, 0);
        }
        if (pact) {
#pragma unroll
            for (int g = 0; g < 4; ++g) {
                f32x4 pv;
#pragma unroll
                for (int e = 0; e < 4; ++e) { const int j = 32 * jb + crow(4 * g + e, hi); pv[e] = j > il ? 0.f : Pp[4 * g + e]; }
                *(LAS u32x2*)(lds + (bpw ^ (unsigned)(g << 4))) = pk4(pv);
            }
        }
#pragma unroll
        for (int r = 0; r < 16; ++r) acc[r] *= g64;
        bf16x8 vf[4][2];
        {
            const float gl = cc == 0 ? 1.f : g64;
#pragma unroll
            for (int a = 0; a < 2; ++a)
#pragma unroll
                for (int bb = 0; bb < 2; ++bb)
#pragma unroll
                    for (int r = 0; r < 16; ++r) S[a][bb][r] *= gl;
            bf16x8 kf[2][2];
#define RT_SU_LD(ks, slot) do { _Pragma("unroll") for (int a = 0; a < 2; ++a) { \
                kf[slot][a] = tr_pair(lds + (bk0 ^ (unsigned)(a << 6)) + 4096 * (ks), lds + (bk1 ^ (unsigned)(a << 6)) + 4096 * (ks)); \
                vf[ks][a] = tr_pair(lds + (bv0 ^ (unsigned)(a << 6)) + 4096 * (ks), lds + (bv1 ^ (unsigned)(a << 6)) + 4096 * (ks)); } } while (0)
#define RT_SU_MM(ks, slot) do { _Pragma("unroll") for (int a = 0; a < 2; ++a) _Pragma("unroll") for (int bb = 0; bb < 2; ++bb) \
                S[a][bb] = __builtin_amdgcn_mfma_f32_32x32x16_bf16(kf[slot][a], vf[ks][bb], S[a][bb], 0, 0, 0); } while (0)
            RT_SU_LD(0, 0);
            __builtin_amdgcn_sched_group_barrier(0x100, 8, 0);
#pragma unroll
            for (int ks = 0; ks < 3; ++ks) {
                RT_SU_LD(ks + 1, (ks + 1) & 1); RT_SU_MM(ks, ks & 1);
                __builtin_amdgcn_sched_group_barrier(0x100, 8, 0);
                __builtin_amdgcn_sched_group_barrier(0x008, 4, 0);
            }
            RT_SU_MM(3, 1);
            __builtin_amdgcn_sched_group_barrier(0x008, 4, 0);
#undef RT_SU_LD
#undef RT_SU_MM
        }
        __syncthreads();
        {
            bf16x8 par[4], pbr[4];
#define RT_PV_LD(ks) do { par[ks] = *(const LAS bf16x8*)(lds + (bpr ^ (unsigned)((ks) << 5))); pbr[ks] = *(const LAS bf16x8*)(lds + (bpr ^ (unsigned)(128 + ((ks) << 5)))); } while (0)
#define RT_PV_MM(ks) do { acc = __builtin_amdgcn_mfma_f32_32x32x16_bf16(vf[ks][0], par[ks], acc, 0, 0, 0); acc = __builtin_amdgcn_mfma_f32_32x32x16_bf16(vf[ks][0], pbr[ks], acc, 0, 0, 0); } while (0)
            if (wi == 1) {
                RT_PV_LD(0); RT_PV_LD(1); RT_PV_LD(2); RT_PV_LD(3);
                RT_PV_MM(0); RT_PV_MM(1); RT_PV_MM(2); RT_PV_MM(3);
            } else {
                RT_PV_LD(0); RT_PV_LD(1);
                RT_PV_MM(0); RT_PV_MM(1);
            }
#undef RT_PV_LD
#undef RT_PV_MM
        }
        {
            const size_t rbase = cc > 0 ? (size_t)b * SEQ + 64 * (cc - 1) : (size_t)MR + 128;
            float ss = 0.f;
            char* orow = (char*)(V1 + rbase * RMIX) + voffg;
            u32x2 gg[4], W[4];
            asm volatile("" : "+v"(ga), "+v"(gb));
#pragma unroll
            for (int d = 0; d < 2; ++d) { const u32x2 ra = __builtin_amdgcn_permlane32_swap(ga[d], ga[2 + d], false, false), rb = __builtin_amdgcn_permlane32_swap(gb[d], gb[2 + d], false, false);
                gg[0][d] = ra.x; gg[2][d] = ra.y; gg[1][d] = rb.x; gg[3][d] = rb.y; }
#pragma unroll
            for (int g = 0; g < 4; ++g) {
                const f32x4 ov = (f32x4){acc[4 * g] * rowscale, acc[4 * g + 1] * rowscale, acc[4 * g + 2] * rowscale, acc[4 * g + 3] * rowscale};
                ss += ov[0] * ov[0] + ov[1] * ov[1] + ov[2] * ov[2] + ov[3] * ov[3];
                W[g] = pk4(ov * unpk4(gg[g]));
            }
#pragma unroll
            for (int q = 0; q < 2; ++q) {
                const u32x2 r0 = __builtin_amdgcn_permlane32_swap(W[q][0], W[2 + q][0], false, false), r1 = __builtin_amdgcn_permlane32_swap(W[q][1], W[2 + q][1], false, false);
                *(u32x4*)(orow + 16 * q) = (u32x4){r0.x, r1.x, r0.y, r1.y};
            }
            ss = sum_x32(ss);
            if (hi == 0) *(float*)((char*)(osq + (rbase * 4 + h) * 16 + sl * 4) + voffo) = ss;
        }
        if (more) {
#pragma unroll
            for (int a = 0; a < 2; ++a)
#pragma unroll
                for (int bb = 0; bb < 2; ++bb)
#pragma unroll
                    for (int g = 0; g < 4; ++g)
                        *(LAS u32x2*)(lds + ((bb ? bsw1 : bsw0) ^ (unsigned)((4 * a + g) << 4))) = pk4((f32x4){S[a][bb][4 * g], S[a][bb][4 * g + 1], S[a][bb][4 * g + 2], S[a][bb][4 * g + 3]});
#pragma unroll
            for (int k_ = 0; k_ < 4; ++k_) { *(LAS u32x4*)(lds + blq + 4096 * k_) = gq[k_]; *(LAS u32x4*)(lds + blq + (RT_K - RT_Q) + 4096 * k_) = gk[k_]; }
#pragma unroll
            for (int k_ = 0; k_ < 2; ++k_) { const float fc_ = fcv[k_]; const u32x4 w_ = gv[k_]; u32x4 r_;
                r_.x = pk2(bf2f(w_.x & 0xffffu) * fc_, bf2f(w_.x >> 16) * fc_); r_.y = pk2(bf2f(w_.y & 0xffffu) * fc_, bf2f(w_.y >> 16) * fc_);
                r_.z = pk2(bf2f(w_.z & 0xffffu) * fc_, bf2f(w_.z >> 16) * fc_); r_.w = pk2(bf2f(w_.w & 0xffffu) * fc_, bf2f(w_.w >> 16) * fc_);
                *(LAS u32x4*)(lds + blv + 8192 * k_) = r_; }
        }
        ga = __builtin_amdgcn_raw_buffer_load_b128(rsG, voffg, (unsigned)(b * SEQ + 64 * cc) * 4096u, 0); gb = __builtin_amdgcn_raw_buffer_load_b128(rsG, voffg + 16, (unsigned)(b * SEQ + 64 * cc) * 4096u, 0);
        __syncthreads();
    }
#undef RT_GLOAD
#undef RT_LWRITE
}
__device__ __forceinline__ void phase_ret_fast(const Ctx& c, LAS unsigned char* lds, int bid, int nb) {
    const int vcu = (nb % 8 == 0) ? (bid % 8) * (nb / 8) + bid / 8 : bid;
    const unsigned m0 = __builtin_amdgcn_readfirstlane(((volatile LAS unsigned*)(lds + LDS_MISC))[0]), m1 = __builtin_amdgcn_readfirstlane(((volatile LAS unsigned*)(lds + LDS_MISC))[1]);
    __syncthreads();
    for (int u = vcu; u < 256; u += nb) ret_unit(c, lds, u >> 4, (u >> 2) & 3, u & 3);
    __syncthreads();
    if (threadIdx.x == 0) { ((volatile LAS unsigned*)(lds + LDS_MISC))[0] = m0; ((volatile LAS unsigned*)(lds + LDS_MISC))[1] = m1; }
}
__device__ __forceinline__ void phase_gatepass(const Ctx& c, int bid, int nb) {
    const int tid = opaque_tid(), wid = tid >> 6, lane = tid & 63;
    const bf16_t* O = c.b16(OFF_V1); bf16_t* G1 = c.b16(OFF_G1); const float* osq = c.out;
    for (int row = bid * NWV + wid; row < MR; row += nb * NWV) {
        float sq = osq[(size_t)row * 64 + lane];
        sq += __shfl_xor(sq, 1); sq += __shfl_xor(sq, 2); sq += __shfl_xor(sq, 4); sq += __shfl_xor(sq, 8);
        const float rs = frsq(sq * (1.f / RDV) + LN_EPS);
#pragma unroll
        for (int k = 0; k < 4; ++k) {
            const float r = __shfl(rs, 16 * k);
            const size_t off = (size_t)row * RMIX + 512 * k + 8 * lane;
            const u32x4 ow = *(const u32x4*)(O + off), gw = *(const u32x4*)(G1 + off);
            u32x4 o;
            o.x = pk2(bf2f(gw.x & 0xffffu) * bf2f(ow.x & 0xffffu) * r, bf2f(gw.x >> 16) * bf2f(ow.x >> 16) * r);
            o.y = pk2(bf2f(gw.y & 0xffffu) * bf2f(ow.y & 0xffffu) * r, bf2f(gw.y >> 16) * bf2f(ow.y >> 16) * r);
            o.z = pk2(bf2f(gw.z & 0xffffu) * bf2f(ow.z & 0xffffu) * r, bf2f(gw.z >> 16) * bf2f(ow.z >> 16) * r);
            o.w = pk2(bf2f(gw.w & 0xffffu) * bf2f(ow.w & 0xffffu) * r, bf2f(gw.w >> 16) * bf2f(ow.w >> 16) * r);
            *(u32x4*)(G1 + off) = o;
        }
    }
}

__device__ __forceinline__ void phase_final(const Ctx& c, int bid, int nb) {
    const int tid = opaque_tid(), wid = tid >> 6, lane = tid & 63;
    const float* g = c.in[21] + 1024; const float* bv = c.in[22] + 1024;
    for (int row = bid * NWV + wid; row < MR; row += nb * NWV) {
        f32x4* zr = (f32x4*)(c.out + (size_t)row * DM) + lane;
        f32x4 v[4]; float s = 0.f;
#pragma unroll
        for (int j = 0; j < 4; ++j) { v[j] = zr[64 * j]; s += (v[j][0] + v[j][1]) + (v[j][2] + v[j][3]); }
        const float mean = wave_sum(s) * (1.f / DM); float s2 = 0.f;
#pragma unroll
        for (int j = 0; j < 4; ++j) { v[j] = v[j] - mean; s2 += (v[j][0] * v[j][0] + v[j][1] * v[j][1]) + (v[j][2] * v[j][2] + v[j][3] * v[j][3]); }
        const float rstd = frsq(wave_sum(s2) * (1.f / DM) + LN_EPS);
#pragma unroll
        for (int j = 0; j < 4; ++j) zr[64 * j] = v[j] * rstd * *(const f32x4*)(g + 256 * j + 4 * lane) + *(const f32x4*)(bv + 256 * j + 4 * lane);
    }
}


#define XB_TMO      128
#define XB_XCNT(j)  (256  + 64 * (j))
#define XB_XSUB(j)  (1280 + 64 * (j))
#define XB_XGEN(j)  (2304 + 64 * (j))
#define XB_TOP      3328
#define XB_TOPGEN   3392
#define XCD_BAR_WORDS 3456
#define XB_SPIN_CAP (1u << 18)
__device__ __forceinline__ unsigned xb_ld(unsigned* p)              { return __hip_atomic_load(p, __ATOMIC_RELAXED, __HIP_MEMORY_SCOPE_AGENT); }
__device__ __forceinline__ unsigned xb_add(unsigned* p, unsigned v) { return __hip_atomic_fetch_add(p, v, __ATOMIC_RELAXED, __HIP_MEMORY_SCOPE_AGENT); }
__device__ __forceinline__ unsigned xb_xcc_id() { return (unsigned)__builtin_amdgcn_s_getreg((3 << 11) | 20) & 0xFu; }
#define XB_SPIN(cond, bar) do { unsigned _sp = 0; while (cond) { __builtin_amdgcn_s_sleep(1); \
    if ((++_sp & 255u) == 0u) { if (xb_ld(&(bar)[XB_TMO])) break; if (_sp > XB_SPIN_CAP) { atomicAdd(&(bar)[XB_TMO], 1u); break; } } } } while (0)
struct XcdBarrier { unsigned* bar; unsigned x; volatile LAS unsigned* st; };
__device__ __forceinline__ XcdBarrier xcd_barrier_post(unsigned* bar, volatile LAS unsigned* st) {
    XcdBarrier b; b.bar = bar; b.x = xb_xcc_id(); b.st = st;
    if (threadIdx.x == 0) (void)xb_add(&bar[XB_XCNT(b.x)], 1u);
    return b;
}
__device__ __forceinline__ void xcd_barrier_complete(unsigned* bar, unsigned x, unsigned& nloc, unsigned& nx) {
    const unsigned G = gridDim.x * gridDim.y * gridDim.z;
    unsigned sum, cnt, mine, sp = 0u;
    for (;;) {
        sum = 0u; cnt = 0u; mine = 0u;
#pragma unroll
        for (unsigned j = 0; j < 16; ++j) { const unsigned c = xb_ld(&bar[XB_XCNT(j)]); sum += c; cnt += (c > 0u) ? 1u : 0u; mine = (j == x) ? c : mine; }
        if (sum == G) break;
        __builtin_amdgcn_s_sleep(1);
        if ((++sp & 255u) == 0u) { if (xb_ld(&bar[XB_TMO])) break; if (sp > XB_SPIN_CAP) { atomicAdd(&bar[XB_TMO], 1u); break; } }
    }
    nloc = mine > 0u ? mine : 1u; nx = cnt > 0u ? cnt : 1u;
}
__device__ __forceinline__ void xcd_barrier(const XcdBarrier& b) {
    asm volatile("s_waitcnt vmcnt(0)" ::: "memory");
    __syncthreads();
    if (threadIdx.x == 0) {
        unsigned* bar = b.bar;
        __builtin_amdgcn_s_waitcnt(0);
        unsigned nloc = b.st[0], nx = b.st[1];
        if (nloc == 0u) { xcd_barrier_complete(bar, b.x, nloc, nx); b.st[0] = nloc; b.st[1] = nx; }
        const unsigned old = xb_add(&bar[XB_XSUB(b.x)], 1u);
        const unsigned gen = old / nloc;
        if (old + 1u == (gen + 1u) * nloc) {
            __builtin_amdgcn_fence(__ATOMIC_RELEASE, "agent");
            asm volatile("s_waitcnt vmcnt(0)" ::: "memory");
            const unsigned og = xb_add(&bar[XB_TOP], 1u);
            const unsigned tg = og / nx;
            if (og + 1u == (tg + 1u) * nx) xb_add(&bar[XB_TOPGEN], 1u);
            else XB_SPIN(xb_ld(&bar[XB_TOPGEN]) == tg, bar);
            __builtin_amdgcn_fence(__ATOMIC_ACQUIRE, "agent");
            xb_add(&bar[XB_XGEN(b.x)], 1u);
            asm volatile("s_waitcnt vmcnt(0)" ::: "memory");
        } else {
            XB_SPIN(xb_ld(&bar[XB_XGEN(b.x)]) == gen, bar);
            __builtin_amdgcn_fence(__ATOMIC_ACQUIRE, "agent");
            asm volatile("s_waitcnt vmcnt(0)" ::: "memory");
        }
    }
    __syncthreads();
}

enum { PH_PRO = 0, PH_IN0, PH_PREP, PH_GATE, PH_ATTN, PH_OUT0, PH_UP0, PH_DOWN0, PH_IN1, PH_RET, PH_OUT1, PH_UP1, PH_DOWN1, NPH };
static_assert(NPH == 13, "phase list");

__device__ __forceinline__ void run_phase(int ph, const Ctx& c, const Params& p, LAS unsigned char* lds, int bid, int nb) {
    const float* stA = c.f32(OFF_STATA); const float* stB = c.f32(OFF_STATB); const float* cv = c.f32(OFF_C12);
    switch (ph) {
#ifdef PROBE_PRO_SPLIT
    case PH_PRO: { unsigned long long* pts = (unsigned long long*)(c.ws + OFF_CTL + 32768); const bool st = bid == 0 && threadIdx.x == 0;
        if (st) pts[0] = __builtin_amdgcn_s_memrealtime();
        phase_prologue(c, p, lds, bid, nb, 1); cg::this_grid().sync();
        if (st) pts[1] = __builtin_amdgcn_s_memrealtime();
        phase_prologue(c, p, lds, bid, nb, 2); cg::this_grid().sync();
        if (st) pts[2] = __builtin_amdgcn_s_memrealtime(); } break;
#else
    case PH_PRO: phase_prologue(c, p, lds, bid, nb); break;
#endif
    case PH_IN0: {
        Gemm g{c.b16(OFF_XB), c.b16(OFF_WIN0), MR, N_IN0, 1024, 1024, 1024, 0};
        EpiIn0 e{c.b16(OFF_P0), c.f32(OFF_SSQQ), c.f32(OFF_SSQKV)};
        run_gemm(lds, g, e, bid, nb);
    } break;
    case PH_PREP: {
        phase_conv(c, bid, nb);
        { Gemm g{c.b16(OFF_P0) + 1024, c.b16(OFF_WUQ), MR, NQ, QRANK, N_IN0, QRANK, 0};
          EpiQup e{c.b16(OFF_Q), c.f32(OFF_SSQQ), c.f32(OFF_ROPE0C), c.f32(OFF_ROPE0S)}; run_gemm(lds, g, e, bid, nb); }
        { Gemm g{c.b16(OFF_P0) + 1280, c.b16(OFF_WUKV), MR, 1024, KVRANK, N_IN0, KVRANK, 0};
          EpiKVup e{c.b16(OFF_K), c.b16(OFF_V), c.f32(OFF_SSQKV)}; run_gemm(lds, g, e, bid, nb); }
    } break;
    case PH_GATE: {
        Gemm g{c.b16(OFF_XC), c.b16(OFF_WGATE), MR, 1024, 128, LRUW, 128, 128};
        EpiGate e{c, c.b16(OFF_XC), c.f32(OFF_CCH), c.in[6], c.in[8]};
        run_gemm(lds, g, e, bid, nb);
        scan1_local(c, bid, nb);
    } break;
#if FAST_ATTN
    case PH_ATTN: phase_scan2(c, bid, nb); phase_attn_naive(c, bid, nb, true); phase_attn_fast(c, lds, bid, nb); break;
#else
    case PH_ATTN: phase_scan2(c, bid, nb); phase_attn_naive(c, bid, nb, false); break;
#endif
    case PH_OUT0: {
        Gemm g{c.b16(OFF_MIX), c.b16(OFF_WOUT0), MR, 1024, 1024, 1024, 1024, 0};
        EpiRes<0, false> e{c, c.b16(OFF_ZB), nullptr, c.f32(OFF_STATA), nullptr, nullptr, (const float*)c.b16(OFF_XB), nullptr};
        run_gemm(lds, g, e, bid, nb);
    } break;
    case PH_UP0: {
        Gemm g{c.b16(OFF_ZB), c.b16(OFF_W1_0), MR, FF, 1024, 1024, 1024, 0};
        EpiMlpUp e{{stA, cv + C1_UP0, cv + C2_UP0}, c.b16(OFF_HID)};
        run_gemm(lds, g, e, bid, nb);
#ifdef PROBE_NULLGEMM
        { EpiNull en; run_gemm(lds, g, en, bid, nb, false); }
#endif
    } break;
    case PH_DOWN0: {
        Gemm g{c.b16(OFF_HID), c.b16(OFF_W2_0), MR, 1024, FF, FF, FF, 0};
        EpiRes<1, false> e{c, c.b16(OFF_ZB), stA, c.f32(OFF_STATB), c.in[17], c.in[18], nullptr, nullptr};
        run_gemm(lds, g, e, bid, nb);
    } break;
    case PH_IN1: {
        Gemm g{c.b16(OFF_ZB), c.b16(OFF_WIN1), MR, N_IN1, 1024, 1024, 1024, 0};
        EpiIn1 e{{stB, cv + C1_IN1, cv + C2_IN1}, c.b16(OFF_Q1), c.b16(OFF_K1), c.b16(OFF_V1), c.b16(OFF_G1), c.f32(OFF_ROPE1C), c.f32(OFF_ROPE1S)};
        run_gemm(lds, g, e, bid, nb, true, 4, 16);
#ifdef PROBE_NULLGEMM2
        { EpiNull en; run_gemm(lds, g, en, bid, nb, false); }
#endif
    } break;
#if FAST_RET
    case PH_RET: phase_ret_fast(c, lds, bid, nb); break;
#else
    case PH_RET: phase_ret_naive(c, lds, bid, nb); break;
#endif
    case PH_OUT1: {
        Gemm g{c.b16(OFF_V1), c.b16(OFF_WOUT1), MR, 1024, RMIX, RMIX, RMIX, 0};
        EpiResRho e{{c, c.b16(OFF_ZB), stB, c.f32(OFF_STATA), c.in[21], c.in[22], nullptr, nullptr}, c.out};
        run_gemm(lds, g, e, bid, nb, false);
    } break;
    case PH_UP1: {
        Gemm g{c.b16(OFF_ZB), c.b16(OFF_W1_1), MR, FF, 1024, 1024, 1024, 0};
        EpiMlpUp e{{stA, cv + C1_UP1, cv + C2_UP1}, c.b16(OFF_HID)};
        run_gemm(lds, g, e, bid, nb, false);
    } break;
    case PH_DOWN1: {
        Gemm g{c.b16(OFF_HID), c.b16(OFF_W2_1), MR, 1024, FF, FF, FF, 0};
        EpiFinal e{{c, c.b16(OFF_ZB), stA, nullptr, c.in[17] + 1024, c.in[18] + 1024, nullptr, nullptr}, (unsigned long long*)(c.ws + OFF_ZMETA), (unsigned*)(c.ws + OFF_CTL + 32768), c.in[21] + 1024, c.in[22] + 1024};
        run_gemm(lds, g, e, bid, nb, false);
    } break;
    default: break;
    }
}

#if N_LAUNCH_MODE == 1
__global__ void __launch_bounds__(512, 2) k_fwd(Params p) {
    extern __shared__ __attribute__((aligned(16))) unsigned char lds_raw[];
    LAS unsigned char* lds = (LAS unsigned char*)lds_raw;
    Ctx c{p.in, p.out, p.ws};
    const int bid = blockIdx.x, nb = gridDim.x;
    const int lo = (int)p.ph_lo, hi = (int)p.ph_hi;
    volatile LAS unsigned* misc = (volatile LAS unsigned*)(lds + LDS_MISC);
    if (threadIdx.x < 64) misc[threadIdx.x] = 0u;
    __syncthreads();
    const XcdBarrier bar = xcd_barrier_post((unsigned*)(p.ws + OFF_CTL) + 1024, misc);
#ifdef PROBE_PHASE
    unsigned long long pt0 = 0, pt1 = 0;
#define PROBE_T0(k) if ((k) == PROBE_PHASE) pt0 = __builtin_amdgcn_s_memrealtime();
#define PROBE_T1(k) if ((k) == PROBE_PHASE) pt1 = __builtin_amdgcn_s_memrealtime();
#else
#define PROBE_T0(k)
#define PROBE_T1(k)
#endif
#define PHASE(k) if (lo <= (k) && (k) < hi) { PROBE_T0(k) run_phase((k), c, p, lds, bid, nb); if ((k) + 1 < hi) { if (hi > 1000) cg::this_grid().sync(); else xcd_barrier(bar); } PROBE_T1(k) }
    PHASE(0) PHASE(1) PHASE(2) PHASE(3) PHASE(4) PHASE(5) PHASE(6) PHASE(7) PHASE(8) PHASE(9) PHASE(10) PHASE(11) PHASE(12)
#undef PHASE
#ifdef PROBE_PRO_SPLIT
    if (bid == 0 && threadIdx.x == 0) { volatile unsigned long long* pts = (volatile unsigned long long*)(p.ws + OFF_CTL + 32768); const unsigned long long te = __builtin_amdgcn_s_memrealtime(), w = 16ull * (pts[PROBE_PRO_SPLIT] - pts[PROBE_PRO_SPLIT - 1]); while (__builtin_amdgcn_s_memrealtime() - te < w) __builtin_amdgcn_s_sleep(32); }
#endif
#ifdef PROBE_PHASE
    if (bid == 0 && threadIdx.x == 0) { const unsigned long long te = __builtin_amdgcn_s_memrealtime(), w = 16ull * (pt1 - pt0); while (__builtin_amdgcn_s_memrealtime() - te < w) __builtin_amdgcn_s_sleep(32); }
#endif
}
#else
template <int PH> __global__ void __launch_bounds__(512, 2) k_one(Params p) {
    extern __shared__ __attribute__((aligned(16))) unsigned char lds_raw[];
    LAS unsigned char* lds = (LAS unsigned char*)lds_raw;
    Ctx c{p.in, p.out, p.ws};
    run_phase(PH, c, p, lds, blockIdx.x, gridDim.x);
}
template <int PH> static void launch_one(int grid, const Params& p, hipStream_t stream) {
    static bool attr = false;
    if (!attr) { (void)hipFuncSetAttribute((const void*)k_one<PH>, hipFuncAttributeMaxDynamicSharedMemorySize, LDS_BYTES); attr = true; }
    hipLaunchKernelGGL(k_one<PH>, dim3(grid), dim3(512), LDS_BYTES, stream, p);
}
#endif

extern "C" void kernel_launch(void* const* d_in, const int* in_sizes, int n_in, void* d_out, int out_size, void* d_ws, size_t ws_size, hipStream_t stream) {
    static int grid = 0;
    if (grid == 0) {
        int dev = 0, cus = 0;
        if (hipGetDevice(&dev) != hipSuccess || hipDeviceGetAttribute(&cus, hipDeviceAttributeMultiprocessorCount, dev) != hipSuccess) { grid = -1; return; }
#if N_LAUNCH_MODE == 1
        if (hipFuncSetAttribute((const void*)k_fwd, hipFuncAttributeMaxDynamicSharedMemorySize, LDS_BYTES) != hipSuccess) { grid = -1; return; }
        int per_cu = 0;
        if (hipOccupancyMaxActiveBlocksPerMultiprocessor(&per_cu, (const void*)k_fwd, 512, LDS_BYTES) != hipSuccess || per_cu < 1) { fprintf(stderr, "occupancy query: %d\n", per_cu); }
        (void)hipGetLastError();
#endif
        grid = 256;
        if (cus < 256) { fprintf(stderr, "kernel_launch: %d CUs < 256\n", cus); grid = -1; return; }
        if (n_in != 23 || ws_size < WS_END) { fprintf(stderr, "kernel_launch: unexpected n_in %d / ws %zu\n", n_in, ws_size); grid = -1; return; }
    }
    if (grid < 0) return;
    (void)hipMemsetAsync((char*)d_ws + OFF_CTL, 0, SZ_CTL, stream);
    (void)hipMemsetAsync((char*)d_ws + OFF_C12, 0, 128 * KB, stream);
    Params p{};
    for (int i = 0; i < 23; ++i) p.in[i] = (const float*)d_in[i];
    p.out = (float*)d_out; p.ws = (unsigned char*)d_ws;
    for (int j = 0; j < 16; ++j) p.inv0[j] = pow(10000.0, -(double)j / 16.0);
    for (int j = 0; j < 128; ++j) p.inv1[j] = pow(10000.0, -(double)j / 128.0);
#if N_LAUNCH_MODE == 1
    p.ph_lo = 0; p.ph_hi = NPH;
    void* args[] = {&p};
    hipError_t e = hipLaunchCooperativeKernel((const void*)k_fwd, dim3(grid), dim3(512), args, LDS_BYTES, stream);
    if (e != hipSuccess) fprintf(stderr, "cooperative launch failed: %s (grid %d)\n", hipGetErrorString(e), grid);
#else
    launch_one<0>(grid, p, stream); launch_one<1>(grid, p, stream); launch_one<2>(grid, p, stream); launch_one<3>(grid, p, stream); launch_one<4>(grid, p, stream);
    launch_one<5>(grid, p, stream); launch_one<6>(grid, p, stream); launch_one<7>(grid, p, stream); launch_one<8>(grid, p, stream); launch_one<9>(grid, p, stream);
    launch_one<10>(grid, p, stream); launch_one<11>(grid, p, stream); launch_one<12>(grid, p, stream);
#endif
}
```
